# Optimizing an MI355X kernel written in HIP

```python
import math
import jax, jax.numpy as jnp
from jax import lax
import numpy as np

D_MODEL = 2048
BATCH = 1
SEQ = 8192
DEPTH = 2

Q_BLOCK = 128
ROPE_THETA = 500000.0
ROPE_FRACTION_DENOM = 4
NORM_EPS = 1e-6
A_HEADS = 4
A_QK_DIM = 64
A_V_DIM = 128
B_HEADS = 4
B_HEAD_DIM = 128
IDX_HEADS = 8
IDX_DIM = 64
IDX_TOPK_MAX = 256
C_HEADS = 8
C_NOPE_DIM = 128
C_ROPE_DIM = 64
C_QK_DIM = C_NOPE_DIM + C_ROPE_DIM
C_V_DIM = 128
C_KV_RANK = 512
N_BRANCHES = 3
A_OUT = A_HEADS * A_V_DIM
B_OUT = B_HEADS * B_HEAD_DIM
C_OUT = C_HEADS * C_V_DIM
MIX_WIDTH = A_OUT + B_OUT + C_OUT
IN_WIDTHS = (
    A_HEADS * 2 * A_QK_DIM,
    A_HEADS * 2 * A_QK_DIM,
    A_OUT,
    B_HEADS * B_HEAD_DIM,
    B_HEAD_DIM,
    B_HEAD_DIM,
    IDX_HEADS * IDX_DIM,
    IDX_DIM,
    IDX_HEADS,
    C_HEADS * C_QK_DIM,
    C_KV_RANK,
    C_ROPE_DIM,
    N_BRANCHES * D_MODEL,
)
IN_WIDTH = sum(IN_WIDTHS)
D_FF = ((8 * D_MODEL + 3 * 256 - 1) // (3 * 256)) * 256

kernel_name = 'hybrid_gated_diff_dsa_mla_block'


def _rmsnorm(x, g):
    xf = x.astype(jnp.float32)
    y = xf * lax.rsqrt(jnp.mean(xf * xf, axis=-1, keepdims=True) + NORM_EPS)
    return (y * g.astype(jnp.float32)).astype(x.dtype)


def _rope(x, rot_dim):
    seq = x.shape[1]
    half = rot_dim // 2
    pos = jnp.arange(seq, dtype=jnp.float32)
    inv_freq = ROPE_THETA ** (-jnp.arange(half, dtype=jnp.float32) * 2.0 / rot_dim)
    ang = pos[:, None] * inv_freq[None, :]
    cos = jnp.cos(ang)[None, :, None, :]
    sin = jnp.sin(ang)[None, :, None, :]
    xr = x[..., :rot_dim].astype(jnp.float32)
    x1, x2 = xr[..., :half], xr[..., half:]
    rot = jnp.concatenate([x1 * cos - x2 * sin, x2 * cos + x1 * sin], axis=-1).astype(x.dtype)
    return jnp.concatenate([rot, x[..., rot_dim:]], axis=-1)


def _split_cols(t, widths):
    cuts, acc = [], 0
    for w in widths[:-1]:
        acc += w
        cuts.append(acc)
    return jnp.split(t, cuts, axis=-1)


def _masked_softmax(s, scale, mask):
    s = jnp.where(mask, s.astype(jnp.float32) * scale, -jnp.inf)
    return jax.nn.softmax(s, axis=-1)


def _causal_mask(start, seq):
    qpos = start + jnp.arange(Q_BLOCK, dtype=jnp.int32)
    mask = jnp.arange(seq, dtype=jnp.int32)[None, :] <= qpos[:, None]
    return qpos, mask


def _sweep_query_blocks(block_fn, seq):
    starts = jnp.arange(seq // Q_BLOCK, dtype=jnp.int32) * Q_BLOCK
    out = lax.map(block_fn, starts)
    out = jnp.moveaxis(out, 0, 1)
    return out.reshape(out.shape[:1] + (seq,) + out.shape[3:])


def _diff_attention(q1, q2, k1, k2, v, lam):
    seq = q1.shape[1]
    scale = A_QK_DIM ** -0.5

    def block(start):
        _, mask = _causal_mask(start, seq)
        q1b = lax.dynamic_slice_in_dim(q1, start, Q_BLOCK, axis=1)
        q2b = lax.dynamic_slice_in_dim(q2, start, Q_BLOCK, axis=1)
        p1 = _masked_softmax(jnp.einsum('bqhd,bkhd->bhqk', q1b, k1), scale, mask)
        p2 = _masked_softmax(jnp.einsum('bqhd,bkhd->bhqk', q2b, k2), scale, mask)
        p = (p1 - lam * p2).astype(v.dtype)
        return jnp.einsum('bhqk,bkhd->bqhd', p, v)

    return _sweep_query_blocks(block, seq)


def _dense_attention(q, k, v, scale):
    seq = q.shape[1]

    def block(start):
        _, mask = _causal_mask(start, seq)
        qb = lax.dynamic_slice_in_dim(q, start, Q_BLOCK, axis=1)
        p = _masked_softmax(jnp.einsum('bqhd,bkhd->bhqk', qb, k), scale, mask)
        return jnp.einsum('bhqk,bkhd->bqhd', p.astype(v.dtype), v)

    return _sweep_query_blocks(block, seq)


def _dsa_attention(q, k, v, q_idx, k_idx, w_idx):
    seq = k.shape[1]
    top_k = min(IDX_TOPK_MAX, seq // 4)
    scale = B_HEAD_DIM ** -0.5
    gather = jax.vmap(lambda t, i: t[i])

    def block(start):
        qpos, mask = _causal_mask(start, seq)
        qib = lax.dynamic_slice_in_dim(q_idx, start, Q_BLOCK, axis=1)
        wb = lax.dynamic_slice_in_dim(w_idx, start, Q_BLOCK, axis=1)
        rel = jax.nn.relu(jnp.einsum('bqhd,bkd->bqhk', qib, k_idx).astype(jnp.float32))
        score = jnp.einsum('bqh,bqhk->bqk', wb.astype(jnp.float32), rel)
        score = jnp.where(mask, score, -jnp.inf)
        _, sel = lax.top_k(score, top_k)
        valid = sel <= qpos[None, :, None]
        kg = gather(k, sel)
        vg = gather(v, sel)
        qb = lax.dynamic_slice_in_dim(q, start, Q_BLOCK, axis=1)
        p = _masked_softmax(jnp.einsum('bqhd,bqkd->bqhk', qb, kg), scale, valid[:, :, None, :])
        return jnp.einsum('bqhk,bqkd->bqhd', p.astype(vg.dtype), vg)

    return _sweep_query_blocks(block, seq)


def _hybrid_mixer(h, lam_init, w_in, a_q_norm, a_k_norm, a_lambda, a_sub_norm, b_q_norm, b_k_norm,
                  idx_k_norm, c_q_norm, c_kv_norm, w_kv_b, c_k_norm, w_branch, w_out):
    bsz, seq, _ = h.shape
    (a_q, a_k, a_v, b_q, b_k, b_v, i_q, i_k, i_w, c_q, c_kv, c_kr, gates) = _split_cols(h @ w_in, IN_WIDTHS)

    a_rot = A_QK_DIM // ROPE_FRACTION_DENOM
    aq = _rope(_rmsnorm(a_q.reshape(bsz, seq, 2 * A_HEADS, A_QK_DIM), a_q_norm), a_rot)
    ak = _rope(_rmsnorm(a_k.reshape(bsz, seq, 2 * A_HEADS, A_QK_DIM), a_k_norm), a_rot)
    aq = aq.reshape(bsz, seq, A_HEADS, 2, A_QK_DIM)
    ak = ak.reshape(bsz, seq, A_HEADS, 2, A_QK_DIM)
    av = a_v.reshape(bsz, seq, A_HEADS, A_V_DIM)
    lf = a_lambda.astype(jnp.float32)
    lam = jnp.exp(jnp.sum(lf[0] * lf[1])) - jnp.exp(jnp.sum(lf[2] * lf[3])) + lam_init
    a_o = _diff_attention(aq[..., 0, :], aq[..., 1, :], ak[..., 0, :], ak[..., 1, :], av, lam)
    a_o = (_rmsnorm(a_o, a_sub_norm) * (1.0 - lam_init)).reshape(bsz, seq, A_OUT)

    b_rot = B_HEAD_DIM // ROPE_FRACTION_DENOM
    i_rot = IDX_DIM // ROPE_FRACTION_DENOM
    bq = _rope(_rmsnorm(b_q.reshape(bsz, seq, B_HEADS, B_HEAD_DIM), b_q_norm), b_rot)
    bk = _rope(_rmsnorm(b_k.reshape(bsz, seq, 1, B_HEAD_DIM), b_k_norm), b_rot)[:, :, 0]
    iq = _rope(i_q.reshape(bsz, seq, IDX_HEADS, IDX_DIM), i_rot)
    ik = _rope(_rmsnorm(i_k, idx_k_norm)[:, :, None, :], i_rot)[:, :, 0]
    iw = i_w * (IDX_HEADS ** -0.5 * IDX_DIM ** -0.5)
    b_o = _dsa_attention(bq, bk, b_v, iq, ik, iw).reshape(bsz, seq, B_OUT)

    cq = _rope(_rmsnorm(c_q.reshape(bsz, seq, C_HEADS, C_QK_DIM), c_q_norm), C_ROPE_DIM)
    kv = (_rmsnorm(c_kv, c_kv_norm) @ w_kv_b).reshape(bsz, seq, C_HEADS, C_NOPE_DIM + C_V_DIM)
    k_nope, c_v = kv[..., :C_NOPE_DIM], kv[..., C_NOPE_DIM:]
    k_rope = jnp.broadcast_to(c_kr[:, :, None, :], (bsz, seq, C_HEADS, C_ROPE_DIM))
    ck = _rope(_rmsnorm(jnp.concatenate([k_rope, k_nope], axis=-1), c_k_norm), C_ROPE_DIM)
    c_o = _dense_attention(cq, ck, c_v, C_QK_DIM ** -0.5).reshape(bsz, seq, C_OUT)

    g = jax.nn.sigmoid(gates.reshape(bsz, seq, N_BRANCHES, D_MODEL).astype(jnp.float32)).astype(h.dtype)
    w_a = w_branch[:A_OUT]
    w_b = w_branch[A_OUT:A_OUT + B_OUT]
    w_c = w_branch[A_OUT + B_OUT:]
    merged = g[:, :, 0] * (a_o @ w_a) + g[:, :, 1] * (b_o @ w_b) + g[:, :, 2] * (c_o @ w_c)
    return merged @ w_out


def setup_inputs(seed: int = 0) -> dict:
    key = jax.random.key(seed)
    ks = jax.random.split(key, 20)

    def nrm(k, shape, scale):
        return jax.random.normal(k, shape, jnp.float32) * scale

    def gain(k, n):
        return 1.0 + 0.02 * jax.random.normal(k, (DEPTH, n), jnp.float32)

    return {
        'x': nrm(ks[0], (BATCH, SEQ, D_MODEL), 1.0),
        'attn_norm': gain(ks[1], D_MODEL),
        'w_in': nrm(ks[2], (DEPTH, D_MODEL, IN_WIDTH), D_MODEL ** -0.5),
        'a_q_norm': gain(ks[3], A_QK_DIM),
        'a_k_norm': gain(ks[4], A_QK_DIM),
        'a_lambda': nrm(ks[5], (DEPTH, 4, A_QK_DIM), 0.1),
        'a_sub_norm': gain(ks[6], A_V_DIM),
        'b_q_norm': gain(ks[7], B_HEAD_DIM),
        'b_k_norm': gain(ks[8], B_HEAD_DIM),
        'idx_k_norm': gain(ks[9], IDX_DIM),
        'c_q_norm': gain(ks[10], C_QK_DIM),
        'c_kv_norm': gain(ks[11], C_KV_RANK),
        'w_kv_b': nrm(ks[12], (DEPTH, C_KV_RANK, C_HEADS * (C_NOPE_DIM + C_V_DIM)), C_KV_RANK ** -0.5),
        'c_k_norm': gain(ks[13], C_QK_DIM),
        'w_branch': nrm(ks[14], (DEPTH, MIX_WIDTH, D_MODEL), MIX_WIDTH ** -0.5),
        'w_out': nrm(ks[15], (DEPTH, D_MODEL, D_MODEL), D_MODEL ** -0.5),
        'ffn_norm': gain(ks[16], D_MODEL),
        'w_gate_up': nrm(ks[17], (DEPTH, D_MODEL, 2 * D_FF), D_MODEL ** -0.5),
        'w_down': nrm(ks[18], (DEPTH, D_FF, D_MODEL), D_FF ** -0.5),
    }


def reference(x, attn_norm, w_in, a_q_norm, a_k_norm, a_lambda, a_sub_norm, b_q_norm, b_k_norm,
              idx_k_norm, c_q_norm, c_kv_norm, w_kv_b, c_k_norm, w_branch, w_out, ffn_norm,
              w_gate_up, w_down):
    for l in range(DEPTH):
        lam_init = 0.8 - 0.6 * math.exp(-0.3 * l)
        h = _rmsnorm(x, attn_norm[l])
        x = x + _hybrid_mixer(h, lam_init, w_in[l], a_q_norm[l], a_k_norm[l], a_lambda[l], a_sub_norm[l],
                              b_q_norm[l], b_k_norm[l], idx_k_norm[l], c_q_norm[l], c_kv_norm[l],
                              w_kv_b[l], c_k_norm[l], w_branch[l], w_out[l])
        h = _rmsnorm(x, ffn_norm[l])
        gate, up = jnp.split(h @ w_gate_up[l], 2, axis=-1)
        x = x + (jax.nn.silu(gate) * up) @ w_down[l]
    return x
```

```cpp
#include <hip/hip_runtime.h>
#include <hip/hip_cooperative_groups.h>
#include <cstdio>
#include <cstdint>
namespace cg = cooperative_groups;

#define GAS __attribute__((address_space(1)))
#define LAS __attribute__((address_space(3)))
typedef unsigned short bf16_t;
typedef short bf16x8 __attribute__((ext_vector_type(8)));
typedef float f32x4 __attribute__((ext_vector_type(4)));
typedef float f32x16 __attribute__((ext_vector_type(16)));
typedef unsigned u32x4 __attribute__((ext_vector_type(4)));
typedef unsigned u32x2 __attribute__((ext_vector_type(2)));

constexpr int SEQ = 8192, DM = 2048, NIN = 11264, DFF = 5632, NGU = 11264, INW = 11144;
constexpr int C_AQ = 0, C_AK = 512, C_AV = 1024, C_BQ = 1536, C_BK = 2048, C_BV = 2176, C_IQ = 2304, C_IK = 2816, C_CKR = 2880,
              C_CQ = 2944, C_CKV = 4480, C_IW = 4992, C_G = 5120;
constexpr float NORM_EPS = 1e-6f;
constexpr float LOG2E = 1.4426950408889634f;
constexpr float LOG2_THETA = 18.931568569324174f;

constexpr size_t MiB = 1u << 20;
constexpr size_t WS_CTL = 0, CTL_BYTES = 1 * MiB;
constexpr size_t WS_WIN = 1 * MiB;
constexpr size_t WS_WKVB = WS_WIN + 44 * MiB;
constexpr size_t WS_WBR = WS_WKVB + 2 * MiB;
constexpr size_t WS_WOUT = WS_WBR + 8 * MiB;
constexpr size_t WS_WGU = WS_WOUT + 8 * MiB;
constexpr size_t WS_WDN = WS_WGU + 44 * MiB;
constexpr size_t WS_P = WS_WDN + 22 * MiB;
constexpr size_t WS_XB = WS_P + 176 * MiB;
constexpr size_t WS_AO = WS_XB + 32 * MiB;
constexpr size_t WS_KC = WS_AO + 32 * MiB;
constexpr size_t WS_VTC = WS_KC + 24 * MiB;
constexpr size_t WS_VTA = WS_VTC + 16 * MiB;
constexpr size_t WS_KVB = WS_VTA + 8 * MiB;
constexpr size_t WS_MG = WS_KVB + 32 * MiB;
constexpr size_t WS_OA32 = WS_MG + 32 * MiB;
constexpr size_t WS_SCR = WS_OA32 + 32 * MiB;
constexpr size_t WS_IKC = WS_SCR + 128 * MiB;
constexpr size_t WS_SCR16 = WS_KVB;
constexpr size_t WS_END = WS_IKC + 1 * MiB;
static_assert(WS_END <= 704 * MiB, "workspace");
constexpr int CW_BAR = 4096;
constexpr int CW_Q = 8192;
constexpr int CW_SSQ = 16384;

__device__ __forceinline__ unsigned f2bf(float f) { unsigned u = __builtin_bit_cast(unsigned, f); return (u + 0x7fffu + ((u >> 16) & 1u)) >> 16; }
__device__ __forceinline__ unsigned pk2(float lo, float hi) { return f2bf(lo) | (f2bf(hi) << 16); }
__device__ __forceinline__ float bf2f(unsigned short b) { return __builtin_bit_cast(float, (unsigned)b << 16); }
__device__ __forceinline__ unsigned cvt_pk_bf16(float lo, float hi) { unsigned r; asm volatile("v_cvt_pk_bf16_f32 %0, %1, %2" : "=v"(r) : "v"(lo), "v"(hi)); return r; }
__device__ __forceinline__ void unpack8(u32x4 w, float* x) {
    x[0] = __builtin_bit_cast(float, w.x << 16); x[1] = __builtin_bit_cast(float, w.x & 0xffff0000u);
    x[2] = __builtin_bit_cast(float, w.y << 16); x[3] = __builtin_bit_cast(float, w.y & 0xffff0000u);
    x[4] = __builtin_bit_cast(float, w.z << 16); x[5] = __builtin_bit_cast(float, w.z & 0xffff0000u);
    x[6] = __builtin_bit_cast(float, w.w << 16); x[7] = __builtin_bit_cast(float, w.w & 0xffff0000u);
}
__device__ __forceinline__ u32x4 pack8(const float* x) { u32x4 w; w.x = pk2(x[0], x[1]); w.y = pk2(x[2], x[3]); w.z = pk2(x[4], x[5]); w.w = pk2(x[6], x[7]); return w; }
__device__ __forceinline__ float wave_sum_dpp(float x);
__device__ __forceinline__ float wave_sum(float v) { return wave_sum_dpp(v); }


template <int CTRL> __device__ __forceinline__ float dppf(float x) { return __builtin_bit_cast(float, __builtin_amdgcn_update_dpp(0, __builtin_bit_cast(int, x), CTRL, 0xf, 0xf, false)); }
__device__ __forceinline__ float rdl(float x, int l) { return __builtin_bit_cast(float, __builtin_amdgcn_readlane(__builtin_bit_cast(int, x), l)); }
__device__ __forceinline__ float wave_max_dpp(float x) {
    x = fmaxf(x, dppf<0xB1>(x)); x = fmaxf(x, dppf<0x4E>(x)); x = fmaxf(x, dppf<0x141>(x)); x = fmaxf(x, dppf<0x140>(x));
    return fmaxf(fmaxf(rdl(x, 0), rdl(x, 16)), fmaxf(rdl(x, 32), rdl(x, 48)));
}
__device__ __forceinline__ float wave_sum_dpp(float x) {
    x += dppf<0xB1>(x); x += dppf<0x4E>(x); x += dppf<0x141>(x); x += dppf<0x140>(x);
    return (rdl(x, 0) + rdl(x, 16)) + (rdl(x, 32) + rdl(x, 48));
}
__device__ __forceinline__ float xhalf_max(float m) {
    unsigned a = __builtin_bit_cast(unsigned, m), b = a; asm volatile("" : "+v"(b));
    auto rr = __builtin_amdgcn_permlane32_swap(a, b, false, false);
    unsigned r0 = rr[0], r1 = rr[1]; asm volatile("" : "+v"(r0), "+v"(r1));
    return fmaxf(__builtin_bit_cast(float, r0), __builtin_bit_cast(float, r1)); }
__device__ __forceinline__ float xhalf_sum(float m) {
    unsigned a = __builtin_bit_cast(unsigned, m), b = a; asm volatile("" : "+v"(b));
    auto rr = __builtin_amdgcn_permlane32_swap(a, b, false, false);
    unsigned r0 = rr[0], r1 = rr[1]; asm volatile("" : "+v"(r0), "+v"(r1));
    return __builtin_bit_cast(float, r0) + __builtin_bit_cast(float, r1); }
template <int O> __device__ __forceinline__ float swz_xor(float x) { return __builtin_bit_cast(float, __builtin_amdgcn_ds_swizzle(__builtin_bit_cast(int, x), 0x1F | (O << 10))); }
__device__ __forceinline__ float fexp2(float x) { return __builtin_amdgcn_exp2f(x); }
__device__ __forceinline__ int tid_of(int wv) { int l = (int)__builtin_amdgcn_mbcnt_hi(~0u, __builtin_amdgcn_mbcnt_lo(~0u, 0u)); asm volatile("" : "+v"(l)); return wv * 64 + l; }
#define LDS_WAIT() asm volatile("s_waitcnt lgkmcnt(0)" ::: "memory")

namespace pg8 {
constexpr int BM = 256, BK = 64, HALF = 128, HTB = HALF * BK * 2, STAGE_BYTES = 8 * HTB, NXCD = 8, WGM = 8;
__host__ __device__ __forceinline__ int lds_byte(int r, int c) { const int st = (r >> 4) * 2 + (c >> 5), rr = r & 15, cc = c & 31, ob = rr * 64 + cc * 2; return st * 1024 + (ob ^ (((ob >> 9) & 1) << 5)); }
__host__ __device__ __forceinline__ void stage_rc(int b, int& R, int& C) { const int st = b / 1024, sb = b % 1024, swz = sb ^ (((sb >> 9) & 1) << 5); R = (st >> 1) * 16 + swz / 64; C = (st & 1) * 32 + (swz % 64) / 2; }
__host__ __device__ __forceinline__ int perm32(int rho) { const int n = rho >> 4, i = rho & 15; return 8 * (i >> 2) + 4 * n + (i & 3); }
struct Unit { int pm, pn; };
struct Gemm { const bf16_t* A; const bf16_t* Bt; int M, N, K, lda, ldb; };
struct StaticOrder {
    int nM, nN, nwg, G, c;
    __device__ void init(int M, int N, int G_, int c_) { nM = M / BM; nN = N / BM; nwg = nM * nN; G = G_; c = c_; }
    __device__ bool next(int i, Unit& u) const {
        const long L = (long)i * G + c; if (L >= nwg) return false;
        int wgid = (int)L; { const int q = nwg / NXCD, r = nwg % NXCD, xcd = wgid % NXCD, off = wgid / NXCD; wgid = (xcd < r ? xcd * (q + 1) : r * (q + 1) + (xcd - r) * q) + off; }
        const int nig = WGM * nN, gid = wgid / nig, fm = gid * WGM, gsz = (nM - fm) < WGM ? (nM - fm) : WGM;
        u.pm = fm + ((wgid % nig) % gsz); u.pn = (wgid % nig) / gsz; return true;
    }
};

enum { EPI_INPROJ = 0, EPI_PLAIN = 1, EPI_BR0 = 2, EPI_BR1 = 3, EPI_BR2 = 4, EPI_RESID = 5, EPI_SWIGLU = 6 };
struct Epi {
    int mode, ldo, ldg;
    bf16_t* obf;
    const bf16_t* gate;
    float* f0;
    const float* f1;
    float* f2;
    __device__ __forceinline__ void operator()(const f32x4 (&acc)[2][2][4][2], const Unit& u, int wr, int wc, int fr, int fq) const {
        const int row0 = u.pm * BM + wr * 64 + fr;
        const int colt = u.pn * BM + wc * 32 + 8 * fq;
        if (mode == EPI_INPROJ || mode == EPI_PLAIN) {
            const bool sg = (mode == EPI_INPROJ) && (u.pn * BM >= C_G);
            float rs[2][4];
#pragma unroll
            for (int ai = 0; ai < 2; ++ai)
#pragma unroll
                for (int m = 0; m < 4; ++m) rs[ai][m] = (mode == EPI_INPROJ) ? f1[row0 + ai * HALF + m * 16] : 0.f;
#pragma unroll
            for (int ai = 0; ai < 2; ++ai)
#pragma unroll
                for (int m = 0; m < 4; ++m) {
                    const int row = row0 + ai * HALF + m * 16;
                    float r = 1.f;
                    if (mode == EPI_INPROJ) r = __builtin_amdgcn_rsqf(rs[ai][m] * (1.f / DM) + NORM_EPS);
#pragma unroll
                    for (int bj = 0; bj < 2; ++bj) {
                        float v[8];
#pragma unroll
                        for (int j = 0; j < 4; ++j) { v[j] = acc[ai][bj][m][0][j] * r; v[4 + j] = acc[ai][bj][m][1][j] * r; }
                        if (sg) {
#pragma unroll
                            for (int j = 0; j < 8; ++j) v[j] = __builtin_amdgcn_rcpf(1.f + __expf(-v[j]));
                        }
                        u32x4 w; w.x = cvt_pk_bf16(v[0], v[1]); w.y = cvt_pk_bf16(v[2], v[3]); w.z = cvt_pk_bf16(v[4], v[5]); w.w = cvt_pk_bf16(v[6], v[7]);
                        *(u32x4*)(obf + (size_t)row * ldo + colt + bj * HALF) = w;
                    }
                }
        } else if (mode == EPI_BR0 || mode == EPI_BR1 || mode == EPI_BR2) {
#pragma unroll
            for (int ai = 0; ai < 2; ++ai)
#pragma unroll
                for (int mh = 0; mh < 2; ++mh) {
                    u32x4 gw[2][2], pw[2][2];
#pragma unroll
                    for (int mm = 0; mm < 2; ++mm)
#pragma unroll
                        for (int bj = 0; bj < 2; ++bj) {
                            const int row = row0 + ai * HALF + (2 * mh + mm) * 16, col = colt + bj * HALF;
                            gw[mm][bj] = *(const u32x4*)(gate + (size_t)row * ldg + col);
                            if (mode != EPI_BR0) pw[mm][bj] = *(const u32x4*)((const bf16_t*)f0 + (size_t)row * DM + col);
                        }
#pragma unroll
                    for (int mm = 0; mm < 2; ++mm)
#pragma unroll
                        for (int bj = 0; bj < 2; ++bj) {
                            const int m = 2 * mh + mm;
                            const int row = row0 + ai * HALF + m * 16, col = colt + bj * HALF;
                            float g[8]; unpack8(gw[mm][bj], g);
                            float v[8];
#pragma unroll
                            for (int j = 0; j < 4; ++j) { v[j] = acc[ai][bj][m][0][j] * g[j]; v[4 + j] = acc[ai][bj][m][1][j] * g[4 + j]; }
                            if (mode != EPI_BR0) {
                                float pp[8]; unpack8(pw[mm][bj], pp);
#pragma unroll
                                for (int j = 0; j < 8; ++j) v[j] += pp[j];
                            }
                            u32x4 w; w.x = cvt_pk_bf16(v[0], v[1]); w.y = cvt_pk_bf16(v[2], v[3]); w.z = cvt_pk_bf16(v[4], v[5]); w.w = cvt_pk_bf16(v[6], v[7]);
                            if (mode == EPI_BR2) *(u32x4*)(obf + (size_t)row * ldo + col) = w;
                            else *(u32x4*)((bf16_t*)f0 + (size_t)row * DM + col) = w;
                        }
                }
        } else if (mode == EPI_RESID) {
#pragma unroll
            for (int ai = 0; ai < 2; ++ai)
#pragma unroll
                for (int mh = 0; mh < 2; ++mh) {
                    f32x4 x0[2][2], x1[2][2];
#pragma unroll
                    for (int mm = 0; mm < 2; ++mm)
#pragma unroll
                        for (int bj = 0; bj < 2; ++bj) {
                            const float* xp = f1 + (size_t)(row0 + ai * HALF + (2 * mh + mm) * 16) * DM + colt + bj * HALF;
                            x0[mm][bj] = *(const f32x4*)xp; x1[mm][bj] = *(const f32x4*)(xp + 4);
                        }
#pragma unroll
                    for (int mm = 0; mm < 2; ++mm) {
                        const int m = 2 * mh + mm;
                        const int row = row0 + ai * HALF + m * 16;
                        float ss = 0.f;
#pragma unroll
                        for (int bj = 0; bj < 2; ++bj) {
                            const int col = colt + bj * HALF;
                            float v[8];
#pragma unroll
                            for (int j = 0; j < 4; ++j) { v[j] = acc[ai][bj][m][0][j] + x0[mm][bj][j]; v[4 + j] = acc[ai][bj][m][1][j] + x1[mm][bj][j]; }
#pragma unroll
                            for (int j = 0; j < 8; ++j) ss += v[j] * v[j];
                            float* op = f0 + (size_t)row * DM + col;
                            *(f32x4*)op = (f32x4){v[0], v[1], v[2], v[3]}; *(f32x4*)(op + 4) = (f32x4){v[4], v[5], v[6], v[7]};
                            u32x4 w; w.x = cvt_pk_bf16(v[0], v[1]); w.y = cvt_pk_bf16(v[2], v[3]); w.z = cvt_pk_bf16(v[4], v[5]); w.w = cvt_pk_bf16(v[6], v[7]);
                            *(u32x4*)(obf + (size_t)row * ldo + col) = w;
                        }
                        ss += swz_xor<16>(ss); ss = xhalf_sum(ss);
                        if (fq == 0) atomicAdd(f2 + row, ss);
                    }
                }
        } else {
            const int colh = u.pn * HALF + wc * 32 + 8 * fq;
            float rs[2][4];
#pragma unroll
            for (int ai = 0; ai < 2; ++ai)
#pragma unroll
                for (int m = 0; m < 4; ++m) rs[ai][m] = f1[row0 + ai * HALF + m * 16];
#pragma unroll
            for (int ai = 0; ai < 2; ++ai)
#pragma unroll
                for (int m = 0; m < 4; ++m) {
                    const int row = row0 + ai * HALF + m * 16;
                    const float r = __builtin_amdgcn_rsqf(rs[ai][m] * (1.f / DM) + NORM_EPS);
                    float v[8];
#pragma unroll
                    for (int n = 0; n < 2; ++n)
#pragma unroll
                        for (int j = 0; j < 4; ++j) {
                            const float g = acc[ai][0][m][n][j] * r, up = acc[ai][1][m][n][j] * r;
                            v[4 * n + j] = g * __builtin_amdgcn_rcpf(1.f + __expf(-g)) * up;
                        }
                    u32x4 w; w.x = cvt_pk_bf16(v[0], v[1]); w.y = cvt_pk_bf16(v[2], v[3]); w.z = cvt_pk_bf16(v[4], v[5]); w.w = cvt_pk_bf16(v[6], v[7]);
                    *(u32x4*)(obf + (size_t)row * ldo + colh) = w;
                }
        }
    }
};

__device__ __forceinline__ void gemm_phase(LAS unsigned char* lds, const Gemm g, const StaticOrder& S, const Epi& E, int wv) {
    const int tid = tid_of(wv);
    const int wid = __builtin_amdgcn_readfirstlane(tid >> 6), lane = tid & 63, wr = wid >> 2, wc = wid & 3, fr = lane & 15, fq = lane >> 4;
    const int K = g.K, nt = K / BK;
    unsigned voffA[2], voffB[2];
#pragma unroll
    for (int i = 0; i < 2; ++i) { int R, C; stage_rc(tid * 16 + i * 8192, R, C); const int Rb = (R & ~31) + perm32(R & 31);
        voffA[i] = (unsigned)(R * g.lda + C) * 2u; voffB[i] = (unsigned)(Rb * g.ldb + C) * 2u; }
    const size_t kstep = (size_t)(BK * 2);
    const size_t hstepA = (size_t)HALF * g.lda * 2, hstepB = (size_t)HALF * g.ldb * 2;
    const size_t tstepA = 2 * hstepA, tstepB = 2 * hstepB;
    const unsigned ldsw = (unsigned)wid * 1024u;
    const int aoff = lds_byte(wr * 64 + fr, fq * 8), boff = lds_byte(wc * 32 + fr, fq * 8);
#define PG8_SA(b, h) (((b) * 2 + (h)) * HTB)
#define PG8_SB(b, h) ((4 + (b) * 2 + (h)) * HTB)
#define PG8_STAGE(bufoff, gbase, voff) do { _Pragma("unroll") for (int _i = 0; _i < 2; ++_i) \
        __builtin_amdgcn_global_load_lds((const unsigned*)((const char*)(gbase) + (voff)[_i]), (LAS unsigned*)(lds + (bufoff) + ldsw + _i * 8192), 16, 0, 0); } while (0)
#define PG8_LDA(dst, b, h) do { _Pragma("unroll") for (int m = 0; m < 4; ++m) _Pragma("unroll") for (int k = 0; k < 2; ++k) dst[m][k] = *(const LAS bf16x8*)(lds + PG8_SA(b, h) + aoff + m * 2048 + k * 1024); } while (0)
#define PG8_LDB(dst, b, h) do { _Pragma("unroll") for (int n = 0; n < 2; ++n) _Pragma("unroll") for (int k = 0; k < 2; ++k) dst[n][k] = *(const LAS bf16x8*)(lds + PG8_SB(b, h) + boff + n * 2048 + k * 1024); } while (0)
#define PG8_MMA(ai, bj, At, Bt) do { __builtin_amdgcn_s_setprio(1); _Pragma("unroll") for (int m = 0; m < 4; ++m) _Pragma("unroll") for (int n = 0; n < 2; ++n) _Pragma("unroll") for (int k = 0; k < 2; ++k) \
        acc[ai][bj][m][n] = __builtin_amdgcn_mfma_f32_16x16x32_bf16(Bt[n][k], At[m][k], acc[ai][bj][m][n], 0, 0, 0); __builtin_amdgcn_s_setprio(0); } while (0)
#define PG8_WAIT_V(n) asm volatile("s_waitcnt vmcnt(" #n ")" ::: "memory")
#define PG8_WAIT_L(n) asm volatile("s_waitcnt lgkmcnt(" #n ")" ::: "memory")
#define PG8_BAR __builtin_amdgcn_s_barrier()
#define PG8_SCHED __builtin_amdgcn_sched_barrier(0)
    Unit cur, nxt; int ui = 0;
    if (!S.next(0, cur)) return;
    f32x4 acc[2][2][4][2];
#pragma unroll
    for (int a = 0; a < 2; ++a)
#pragma unroll
        for (int b = 0; b < 2; ++b)
#pragma unroll
            for (int m = 0; m < 4; ++m)
#pragma unroll
                for (int n = 0; n < 2; ++n) acc[a][b][m][n] = (f32x4){0.f, 0.f, 0.f, 0.f};
    bf16x8 At[4][2], B0[2][2], B1[2][2];
    const char* cA = (const char*)g.A + (size_t)cur.pm * tstepA; const char* cB = (const char*)g.Bt + (size_t)cur.pn * tstepB;
    PG8_STAGE(PG8_SB(0, 0), cB, voffB); PG8_STAGE(PG8_SB(0, 1), cB + hstepB, voffB); PG8_STAGE(PG8_SA(0, 0), cA, voffA); PG8_STAGE(PG8_SA(0, 1), cA + hstepA, voffA);
    if (wr == 1) PG8_BAR;
    PG8_WAIT_V(2); PG8_BAR;
    PG8_STAGE(PG8_SB(1, 0), cB + kstep, voffB); PG8_STAGE(PG8_SA(1, 0), cA + kstep, voffA); PG8_STAGE(PG8_SB(1, 1), cB + hstepB + kstep, voffB);
    PG8_WAIT_V(6); PG8_BAR;
    for (;;) {
        const bool has_next = S.next(ui + 1, nxt);
        const char* nA = has_next ? (const char*)g.A + (size_t)nxt.pm * tstepA : cA; const char* nB = has_next ? (const char*)g.Bt + (size_t)nxt.pn * tstepB : cB;
        for (int t = 0; t < nt; t += 2) {
            const bool last = (t == nt - 2);
            const char* a1 = cA + (size_t)(t + 1) * kstep;
            const char* a2 = last ? nA : cA + (size_t)(t + 2) * kstep; const char* b2 = last ? nB : cB + (size_t)(t + 2) * kstep;
            const char* a3 = a2 + kstep; const char* b3 = b2 + kstep;
            PG8_LDB(B0, 0, 0); PG8_LDB(B1, 0, 1); PG8_SCHED; PG8_LDA(At, 0, 0); PG8_STAGE(PG8_SA(1, 1), a1 + hstepA, voffA);
            PG8_WAIT_V(8); PG8_WAIT_L(0); PG8_BAR; PG8_MMA(0, 0, At, B0); PG8_MMA(0, 1, At, B1); PG8_BAR; PG8_SCHED;
            PG8_LDA(At, 0, 1); PG8_STAGE(PG8_SB(0, 0), b2, voffB); PG8_STAGE(PG8_SB(0, 1), b2 + hstepB, voffB); PG8_STAGE(PG8_SA(0, 0), a2, voffA);
            PG8_WAIT_V(8); PG8_WAIT_L(0); PG8_BAR; PG8_MMA(1, 0, At, B0); PG8_MMA(1, 1, At, B1); PG8_BAR; PG8_SCHED;
            PG8_LDB(B0, 1, 0); PG8_LDB(B1, 1, 1); PG8_SCHED; PG8_LDA(At, 1, 0); PG8_STAGE(PG8_SA(0, 1), a2 + hstepA, voffA);
            PG8_WAIT_V(8); PG8_WAIT_L(0); PG8_BAR; PG8_MMA(0, 0, At, B0); PG8_MMA(0, 1, At, B1); PG8_BAR; PG8_SCHED;
            PG8_LDA(At, 1, 1); PG8_STAGE(PG8_SB(1, 0), b3, voffB); PG8_STAGE(PG8_SB(1, 1), b3 + hstepB, voffB); PG8_STAGE(PG8_SA(1, 0), a3, voffA);
            PG8_WAIT_V(8); PG8_WAIT_L(0); PG8_BAR; PG8_MMA(1, 0, At, B0); PG8_MMA(1, 1, At, B1); PG8_BAR; PG8_SCHED;
        }
        if (wr == 0) PG8_BAR;
        E(acc, cur, wr, wc, fr, fq);
        if (!has_next) break;
#pragma unroll
        for (int a = 0; a < 2; ++a)
#pragma unroll
            for (int b = 0; b < 2; ++b)
#pragma unroll
                for (int m = 0; m < 4; ++m)
#pragma unroll
                    for (int n = 0; n < 2; ++n) acc[a][b][m][n] = (f32x4){0.f, 0.f, 0.f, 0.f};
        cur = nxt; cA = nA; cB = nB; ++ui;
        if (wr == 1) PG8_BAR;
    }
    PG8_WAIT_V(0);
    PG8_BAR;
#undef PG8_SA
#undef PG8_SB
#undef PG8_STAGE
#undef PG8_LDA
#undef PG8_LDB
#undef PG8_MMA
#undef PG8_WAIT_V
#undef PG8_WAIT_L
#undef PG8_BAR
#undef PG8_SCHED
}
}

#define XB_TMO      128
#define XB_XCNT(j)  (256  + 64 * (j))
#define XB_XSUB(j)  (1280 + 64 * (j))
#define XB_XGEN(j)  (2304 + 64 * (j))
#define XB_TOP      3328
#define XB_TOPGEN   3392
#define XCD_BAR_WORDS 3456
#define XB_SPIN_CAP (1u << 22)
__device__ __forceinline__ unsigned xb_ld(unsigned* p)              { return __hip_atomic_load(p, __ATOMIC_RELAXED, __HIP_MEMORY_SCOPE_AGENT); }
__device__ __forceinline__ unsigned xb_add(unsigned* p, unsigned v) { return __hip_atomic_fetch_add(p, v, __ATOMIC_RELAXED, __HIP_MEMORY_SCOPE_AGENT); }
__device__ __forceinline__ unsigned xb_xcc_id() { return (unsigned)__builtin_amdgcn_s_getreg((3 << 11) | 20) & 0xFu; }
#define XB_SPIN(cond, bar) do { unsigned _sp = 0; while (cond) { __builtin_amdgcn_s_sleep(1); \
    if ((++_sp & 255u) == 0u) { if (xb_ld(&(bar)[XB_TMO])) break; if (_sp > XB_SPIN_CAP) { atomicAdd(&(bar)[XB_TMO], 1u); break; } } } } while (0)
struct XcdBarrier { unsigned* bar; unsigned x; volatile LAS unsigned* st; };

__device__ __forceinline__ XcdBarrier xcd_barrier_post(unsigned* bar, volatile LAS unsigned* st) {
    XcdBarrier b; b.bar = bar; b.x = xb_xcc_id(); b.st = st;
    if (threadIdx.x == 0) (void)xb_add(&bar[XB_XCNT(b.x)], 1u);
    return b;
}
__device__ __forceinline__ void xcd_barrier_complete(unsigned* bar, unsigned x, unsigned& nloc, unsigned& nx) {
    const unsigned G = gridDim.x * gridDim.y * gridDim.z;
    unsigned sum, cnt, mine, sp = 0u;
    for (;;) {
        sum = 0u; cnt = 0u; mine = 0u;
#pragma unroll
        for (unsigned j = 0; j < 16; ++j) { const unsigned c = xb_ld(&bar[XB_XCNT(j)]); sum += c; cnt += (c > 0u) ? 1u : 0u; mine = (j == x) ? c : mine; }
        if (sum == G) break;
        __builtin_amdgcn_s_sleep(1);
        if ((++sp & 255u) == 0u) { if (xb_ld(&bar[XB_TMO])) break; if (sp > XB_SPIN_CAP) { atomicAdd(&bar[XB_TMO], 1u); break; } }
    }
    nloc = mine > 0u ? mine : 1u; nx = cnt > 0u ? cnt : 1u;
}
__device__ __forceinline__ void xcd_barrier(const XcdBarrier& b, int wv) {
    asm volatile("s_waitcnt vmcnt(0)" ::: "memory");
    __syncthreads();
    if (tid_of(wv) == 0) {
        unsigned* bar = b.bar;
        __builtin_amdgcn_s_waitcnt(0);
        unsigned nloc = b.st[0], nx = b.st[1];
        if (nloc == 0u) { xcd_barrier_complete(bar, b.x, nloc, nx); b.st[0] = nloc; b.st[1] = nx; }
        const unsigned old = xb_add(&bar[XB_XSUB(b.x)], 1u);
        const unsigned gen = old / nloc;
        if (old + 1u == (gen + 1u) * nloc) {
            __builtin_amdgcn_fence(__ATOMIC_RELEASE, "agent");
            asm volatile("s_waitcnt vmcnt(0)" ::: "memory");
            const unsigned og = xb_add(&bar[XB_TOP], 1u);
            const unsigned tg = og / nx;
            if (og + 1u == (tg + 1u) * nx) xb_add(&bar[XB_TOPGEN], 1u);
            else XB_SPIN(xb_ld(&bar[XB_TOPGEN]) == tg, bar);
            __builtin_amdgcn_fence(__ATOMIC_ACQUIRE, "agent");
            xb_add(&bar[XB_XGEN(b.x)], 1u);
            asm volatile("s_waitcnt vmcnt(0)" ::: "memory");
        } else {
            XB_SPIN(xb_ld(&bar[XB_XGEN(b.x)]) == gen, bar);
            __builtin_amdgcn_fence(__ATOMIC_ACQUIRE, "agent");
            asm volatile("s_waitcnt vmcnt(0)" ::: "memory");
        }
    }
    __syncthreads();
}

constexpr int RING_BYTES = 131072, MISC_OFF = RING_BYTES, LDS_BYTES = 147456;

__device__ __forceinline__ int srccol(int cmode, int nd) {
    if (cmode == 0) return nd;
    if (cmode == 1) {
        if (nd < 2880) return nd;
        if (nd < 2944) return 4936 + (nd - 2880);
        if (nd < 4480) return 2888 + (nd - 2944);
        if (nd < 4992) return 4424 + (nd - 4480);
        if (nd < 5000) return 2880 + (nd - 4992);
        if (nd < 5120) return -1;
        return 5000 + (nd - 5120);
    }
    const int p = nd >> 8, j = nd & 255;
    return (j < 128) ? (128 * p + j) : (DFF + 128 * p + (j - 128));
}
__device__ __forceinline__ void tr_item(const float* W, int ldw, int K, bf16_t* WT, int cmode, const float* gain, LAS float* scr, int item, int nblk, int lane) {
    const int kb = item / nblk, nb = item % nblk, k0 = 64 * kb, n0 = 32 * nb;
    const int sc = srccol(cmode, n0 + (lane & 31));
    float v[32];
    const float* wp = W + (size_t)(k0 + (lane >> 5)) * ldw + (sc >= 0 ? sc : 0);
#pragma unroll
    for (int i = 0; i < 32; ++i) v[i] = __builtin_nontemporal_load(wp + (size_t)(2 * i) * ldw);
    if (gain) {
        const float* gp = gain + k0 + (lane >> 5);
#pragma unroll
        for (int i = 0; i < 32; ++i) v[i] *= gp[2 * i];
    }
    if (sc < 0) {
#pragma unroll
        for (int i = 0; i < 32; ++i) v[i] = 0.f;
    }
#pragma unroll
    for (int i = 0; i < 32; ++i) scr[(2 * i + (lane >> 5)) * 33 + (lane & 31)] = v[i];
    LDS_WAIT(); asm volatile("" ::: "memory");
    const int c = lane & 7;
#pragma unroll
    for (int j = 0; j < 4; ++j) { const int n = (lane >> 3) + 8 * j; const LAS float* s = scr + (8 * c) * 33 + n;
        u32x4 o; o.x = pk2(s[0 * 33], s[1 * 33]); o.y = pk2(s[2 * 33], s[3 * 33]); o.z = pk2(s[4 * 33], s[5 * 33]); o.w = pk2(s[6 * 33], s[7 * 33]);
        *(u32x4*)(WT + (size_t)(n0 + n) * K + k0 + 8 * c) = o; }
    LDS_WAIT(); asm volatile("" ::: "memory");
}
__device__ __forceinline__ void trb_item(const bf16_t* src, int lds_, bf16_t* dst, int ldd, LAS unsigned short* scr, int lane) {
#pragma unroll
    for (int i = 0; i < 8; ++i) {
        const int id = lane + 64 * i, row = id >> 3, cc = id & 7;
        const u32x4 w = *(const u32x4*)(src + (size_t)row * lds_ + 8 * cc);
        LAS unsigned* d = (LAS unsigned*)(scr + row * 66 + 8 * cc);
        d[0] = w.x; d[1] = w.y; d[2] = w.z; d[3] = w.w;
    }
    LDS_WAIT(); asm volatile("" ::: "memory");
#pragma unroll
    for (int i = 0; i < 8; ++i) {
        const int id = lane + 64 * i, c = id >> 3, tc = id & 7;
        const LAS unsigned short* s = scr + (8 * tc) * 66 + c;
        u32x4 o;
        o.x = (unsigned)s[0] | ((unsigned)s[66] << 16); o.y = (unsigned)s[2 * 66] | ((unsigned)s[3 * 66] << 16);
        o.z = (unsigned)s[4 * 66] | ((unsigned)s[5 * 66] << 16); o.w = (unsigned)s[6 * 66] | ((unsigned)s[7 * 66] << 16);
        *(u32x4*)(dst + (size_t)c * ldd + 8 * tc) = o;
    }
    LDS_WAIT(); asm volatile("" ::: "memory");
}

__device__ __forceinline__ float inv_freq(int fi, int rot) { return exp2f(-((float)fi * 2.0f / (float)rot) * LOG2_THETA); }
template <int HD, int ROT, bool NORM>
__device__ __forceinline__ void pp_chunk(u32x4 xin, bf16_t* dst, int ci, bool act, const float* gain, const LAS float* tab, float oscale) {
    float x[8]; unpack8(xin, x);
    if (NORM) {
        float ss = 0.f;
#pragma unroll
        for (int j = 0; j < 8; ++j) ss += x[j] * x[j];
        if (HD == 512) ss = wave_sum_dpp(ss);
        else { ss += dppf<0xB1>(ss); ss += dppf<0x4E>(ss); ss += dppf<0x141>(ss); if (HD == 128) ss += dppf<0x140>(ss); }
        const float r = 1.0f / sqrtf(ss * (1.f / HD) + NORM_EPS);
#pragma unroll
        for (int j = 0; j < 8; ++j) x[j] = x[j] * r * gain[8 * ci + j];
    }
    if (ROT > 0) {
        float oth[8];
#pragma unroll
        for (int j = 0; j < 8; ++j) oth[j] = swz_xor<(ROT / 16)>(x[j]);
        if (ci < ROT / 8) {
            const bool first = ci < ROT / 16;
#pragma unroll
            for (int j = 0; j < 8; ++j) {
                const int fi = 8 * (ci & (ROT / 16 - 1)) + j;
                const float cs = tab[fi], sn = tab[64 + fi];
                x[j] = first ? (x[j] * cs - oth[j] * sn) : (x[j] * cs + oth[j] * sn);
            }
        }
    }
#pragma unroll
    for (int j = 0; j < 8; ++j) x[j] *= oscale;
    if (act) *(u32x4*)dst = pack8(x);
}
__device__ __forceinline__ void pp_head192(u32x4 a0, u32x4 a1, u32x4 a2, bf16_t* d, int ci, const float* gain, const LAS float* tab, float oscale) {
    float x0[8], x1[8], x2[8];
    unpack8(a0, x0); unpack8(a1, x1); unpack8(a2, x2);
    float ss = 0.f;
#pragma unroll
    for (int j = 0; j < 8; ++j) ss += x0[j] * x0[j] + x1[j] * x1[j] + x2[j] * x2[j];
    ss += dppf<0xB1>(ss); ss += dppf<0x4E>(ss); ss += dppf<0x141>(ss);
    const float r = 1.0f / sqrtf(ss * (1.f / 192.f) + NORM_EPS);
#pragma unroll
    for (int j = 0; j < 8; ++j) { x0[j] = x0[j] * r * gain[8 * ci + j]; x1[j] = x1[j] * r * gain[64 + 8 * ci + j]; x2[j] = x2[j] * r * gain[128 + 8 * ci + j]; }
    float oth[8];
#pragma unroll
    for (int j = 0; j < 8; ++j) oth[j] = swz_xor<4>(x0[j]);
    const bool first = ci < 4;
#pragma unroll
    for (int j = 0; j < 8; ++j) {
        const int fi = 8 * (ci & 3) + j;
        const float cs = tab[fi], sn = tab[64 + fi];
        x0[j] = first ? (x0[j] * cs - oth[j] * sn) : (x0[j] * cs + oth[j] * sn);
    }
#pragma unroll
    for (int j = 0; j < 8; ++j) { x0[j] *= oscale; x1[j] *= oscale; x2[j] *= oscale; }
    *(u32x4*)(d + 8 * ci) = pack8(x0); *(u32x4*)(d + 64 + 8 * ci) = pack8(x1); *(u32x4*)(d + 128 + 8 * ci) = pack8(x2);
}
__device__ __forceinline__ void rope_table(LAS float* tab, float pos, int lane) {
    int rot = 64, fi = lane - 24;
    if (lane < 8) { rot = 16; fi = lane; } else if (lane < 24) { rot = 32; fi = lane - 8; }
    if (fi > 31) fi = 31;
    float sn, cs; sincosf(pos * inv_freq(fi, rot), &sn, &cs);
    tab[lane] = cs; tab[64 + lane] = sn;
    LDS_WAIT(); asm volatile("" ::: "memory");
}

__device__ __forceinline__ float max3f(float a, float b, float c) { float r; asm("v_max3_f32 %0, %1, %2, %3" : "=v"(r) : "v"(a), "v"(b), "v"(c)); return r; }
__device__ __forceinline__ float max2f(float a, float b) { float r; asm("v_max_f32_e32 %0, %1, %2" : "=v"(r) : "v"(a), "v"(b)); return r; }
__device__ __forceinline__ int pi32(int r) { return (r & ~12) | ((r & 4) << 1) | ((r & 8) >> 1); }
template <int DQK>
__device__ __forceinline__ void attn_unit(LAS unsigned char* lds, const bf16_t* Q, int ldq, const bf16_t* K, int ldk, const bf16_t* VT, int qb,
                                          float* of32, int ldo32, bf16_t* obf, int ldo, int wv) {
    constexpr int KS = DQK * 2 + 16, VS = 144, KBYTES = 64 * KS, BUF = KBYTES + 128 * VS, NDS = DQK / 16, CPR = DQK / 8, NKC = 64 * CPR / 512;
    const int tid = tid_of(wv);
    const int lane = tid & 63, w = wv, qi = lane & 31, hh = lane >> 5;
    const int q0 = qb * 256 + w * 32, NT = 4 * qb + 4, ntw = (q0 + 31) / 64 + 1;
    bf16x8 qf[NDS];
#pragma unroll
    for (int ds = 0; ds < NDS; ++ds) qf[ds] = *(const bf16x8*)(Q + (size_t)(q0 + qi) * ldq + 16 * ds + 8 * hh);
    f32x16 o[4];
#pragma unroll
    for (int d = 0; d < 4; ++d)
#pragma unroll
        for (int r = 0; r < 16; ++r) o[d][r] = 0.f;
    float mrun = 0.f, lsum = 0.f;
    u32x4 kst[NKC], vst[2];
    int krow[NKC], kcc[NKC];
#pragma unroll
    for (int i = 0; i < NKC; ++i) { const int id = tid + 512 * i; krow[i] = id / CPR; kcc[i] = id % CPR; }
    const int vd0 = tid >> 3, vcc = tid & 7;
#define ATT_LOAD(kt) do { _Pragma("unroll") for (int i = 0; i < NKC; ++i) kst[i] = *(const u32x4*)(K + (size_t)(64 * (kt) + krow[i]) * ldk + 8 * kcc[i]); \
        _Pragma("unroll") for (int i = 0; i < 2; ++i) vst[i] = *(const u32x4*)(VT + (size_t)(vd0 + 64 * i) * SEQ + 64 * (kt) + 8 * vcc); } while (0)
#define ATT_WRITE(b) do { LAS unsigned char* base = lds + (b) * BUF; \
        _Pragma("unroll") for (int i = 0; i < NKC; ++i) *(LAS u32x4*)(base + krow[i] * KS + 16 * kcc[i]) = kst[i]; \
        _Pragma("unroll") for (int i = 0; i < 2; ++i) *(LAS u32x4*)(base + KBYTES + (vd0 + 64 * i) * VS + 16 * vcc) = vst[i]; } while (0)
    ATT_LOAD(0); ATT_WRITE(0);
    __syncthreads();
    const int kro = pi32(qi) * KS + 16 * hh;
    const int vro = KBYTES + qi * VS + 16 * hh;
    for (int kt = 0; kt < NT; ++kt) {
        const bool more = (kt + 1 < NT);
        if (more) ATT_LOAD(kt + 1);
        if (kt < ntw) {
            const LAS unsigned char* base = lds + (kt & 1) * BUF;
#pragma unroll
            for (int kb = 0; kb < 2; ++kb) {
                f32x16 s;
#pragma unroll
                for (int r = 0; r < 16; ++r) s[r] = 0.f;
#pragma unroll
                for (int ds = 0; ds < NDS; ++ds) {
                    const bf16x8 kf = *(const LAS bf16x8*)(base + kro + kb * 32 * KS + ds * 32);
                    s = __builtin_amdgcn_mfma_f32_32x32x16_bf16(kf, qf[ds], s, 0, 0, 0);
                }
#pragma unroll
                for (int r = 0; r < 16; ++r) s[r] -= mrun;
                const int kbase = 64 * kt + 32 * kb;
                if (kbase + 31 > q0) {
                    const int qq = q0 + qi;
#pragma unroll
                    for (int r = 0; r < 16; ++r) { const int key = kbase + (r & 7) + 8 * hh + 16 * (r >> 3); if (key > qq) s[r] = -INFINITY; }
                }
                float mx = fmaxf(s[0], s[1]);
#pragma unroll
                for (int r = 2; r < 16; ++r) mx = fmaxf(mx, s[r]);
                mx = xhalf_max(mx);
                const bool first = (kb == 0) && (kt == 0);
                if (first || __builtin_amdgcn_ballot_w64(mx > 8.f) != 0ull) {
                    const float d = first ? mx : fmaxf(mx, 0.f);
                    const float alpha = first ? 1.f : fexp2(-d);
                    mrun += d;
                    lsum *= alpha;
#pragma unroll
                    for (int dd = 0; dd < 4; ++dd)
#pragma unroll
                        for (int r = 0; r < 16; ++r) o[dd][r] *= alpha;
#pragma unroll
                    for (int r = 0; r < 16; ++r) s[r] -= d;
                }
                float ps = 0.f;
#pragma unroll
                for (int r = 0; r < 16; ++r) { s[r] = fexp2(s[r]); ps += s[r]; }
                lsum += ps;
                bf16x8 pf[2];
#pragma unroll
                for (int s2 = 0; s2 < 2; ++s2) {
                    u32x4 pw; pw.x = cvt_pk_bf16(s[8 * s2 + 0], s[8 * s2 + 1]); pw.y = cvt_pk_bf16(s[8 * s2 + 2], s[8 * s2 + 3]);
                    pw.z = cvt_pk_bf16(s[8 * s2 + 4], s[8 * s2 + 5]); pw.w = cvt_pk_bf16(s[8 * s2 + 6], s[8 * s2 + 7]);
                    pf[s2] = __builtin_bit_cast(bf16x8, pw);
                }
#pragma unroll
                for (int d = 0; d < 4; ++d)
#pragma unroll
                    for (int s2 = 0; s2 < 2; ++s2) {
                        const bf16x8 vf = *(const LAS bf16x8*)(base + vro + d * 32 * VS + (32 * kb + 16 * s2) * 2);
                        o[d] = __builtin_amdgcn_mfma_f32_32x32x16_bf16(vf, pf[s2], o[d], 0, 0, 0);
                    }
            }
        }
        if (more) ATT_WRITE((kt + 1) & 1);
        __syncthreads();
    }
#undef ATT_LOAD
#undef ATT_WRITE
    const float l = xhalf_sum(lsum);
    const float inv = 1.f / l;
    const size_t row = (size_t)(q0 + qi);
#pragma unroll
    for (int d = 0; d < 4; ++d)
#pragma unroll
        for (int g = 0; g < 4; ++g) {
            const int dim = 32 * d + 8 * g + 4 * hh;
            const float v0 = o[d][4 * g] * inv, v1 = o[d][4 * g + 1] * inv, v2 = o[d][4 * g + 2] * inv, v3 = o[d][4 * g + 3] * inv;
            if (of32) *(f32x4*)(of32 + row * ldo32 + dim) = (f32x4){v0, v1, v2, v3};
            else { u32x2 wv; wv.x = cvt_pk_bf16(v0, v1); wv.y = cvt_pk_bf16(v2, v3); *(u32x2*)(obf + row * ldo + dim) = wv; }
        }
}

__device__ __forceinline__ unsigned fkey(float f) { const unsigned u = __builtin_bit_cast(unsigned, f); return (u & 0x80000000u) ? ~u : (u | 0x80000000u); }
template <int NR>
__device__ __forceinline__ void topk_select(const float* sc, int t, LAS unsigned short* sel, int lane) {
    unsigned key[NR];
    const float* scl = sc + lane;
#pragma unroll
    for (int i = 0; i < NR; ++i) { const int e = 64 * i + lane; const unsigned kv = fkey(scl[64 * i]); key[i] = kv & (unsigned)((e - t - 1) >> 31); }
    unsigned thr = 0u;
    for (int b = 31; b >= 0; --b) {
        const unsigned cand = thr | (1u << b);
        int c = 0;
#pragma unroll
        for (int i = 0; i < NR; ++i) c += __popcll(__ballot(key[i] >= cand));
        if (c >= 256) thr = cand;
        if (c == 256) break;
    }
    int cgt = 0;
    unsigned thr1 = thr + 1u; asm volatile("" : "+v"(thr1));
#pragma unroll
    for (int i = 0; i < NR; ++i) cgt += __popcll(__ballot(key[i] >= thr1));
    const int need = 256 - cgt;
    int base = 0, eqbase = 0;
#pragma unroll
    for (int i = 0; i < NR; ++i) {
        const bool gt = key[i] > thr, eq = key[i] == thr;
        const unsigned long long em = __ballot(eq);
        const int erank = eqbase + (int)__builtin_amdgcn_mbcnt_hi((unsigned)(em >> 32), __builtin_amdgcn_mbcnt_lo((unsigned)em, 0u));
        const bool take = gt || (eq && erank < need);
        const unsigned long long tm = __ballot(take);
        const int pos = base + (int)__builtin_amdgcn_mbcnt_hi((unsigned)(tm >> 32), __builtin_amdgcn_mbcnt_lo((unsigned)tm, 0u));
        if (take) sel[pos & 255] = (unsigned short)(64 * i + lane);
        base += __popcll(tm); eqbase += __popcll(em);
        __builtin_amdgcn_sched_barrier(0);
    }
}

__device__ __forceinline__ unsigned lo16(unsigned x) { return __builtin_amdgcn_ubfe(x, 0u, 16u); }
__device__ __forceinline__ int row_sum16(int x) {
    x += __builtin_amdgcn_update_dpp(0, x, 0xB1, 0xf, 0xf, false);
    x += __builtin_amdgcn_update_dpp(0, x, 0x4E, 0xf, 0xf, false);
    x += __builtin_amdgcn_update_dpp(0, x, 0x141, 0xf, 0xf, false);
    x += __builtin_amdgcn_update_dpp(0, x, 0x140, 0xf, 0xf, false);
    return x;
}
__device__ __forceinline__ int wave_total(int x) {
    x = row_sum16(x);
    return __builtin_amdgcn_readlane(x, 0) + __builtin_amdgcn_readlane(x, 16) + __builtin_amdgcn_readlane(x, 32) + __builtin_amdgcn_readlane(x, 48);
}
__device__ __forceinline__ unsigned pk_cnt(unsigned acc, unsigned R, unsigned C, unsigned ONE) {
    unsigned d, f;
    asm("v_pk_sub_u16 %0, %1, %2 clamp" : "=v"(d) : "v"(R), "s"(C));
    asm("v_pk_min_u16 %0, %1, %2" : "=v"(f) : "v"(d), "s"(ONE));
    asm("v_pk_add_u16 %0, %0, %1" : "+v"(acc) : "v"(f));
    return acc;
}
template <int NR2>
__device__ __forceinline__ void topk_select16(const unsigned* sc16, const float* sc32, int t, LAS unsigned short* sel, LAS unsigned short* bl, int lane) {
    unsigned R[NR2];
    const unsigned* p16 = sc16 + lane;
#pragma unroll
    for (int i = 0; i < NR2; ++i) {
        const int e0 = 128 * i + 2 * lane;
        const unsigned m = lo16((unsigned)((e0 - t - 1) >> 31)) | ((unsigned)((e0 - t) >> 31) << 16);
        R[i] = p16[64 * i] & m;
    }
    const unsigned ONE = 0x00010001u;
    unsigned thr = 0u;
#pragma unroll 1
    for (int b = 15; b >= 0; --b) {
        const unsigned cand = thr | (1u << b), cm1 = cand - 1u, C = cm1 | (cm1 << 16);
        unsigned acc = 0u;
#pragma unroll
        for (int i = 0; i < NR2; ++i) acc = pk_cnt(acc, R[i], C, ONE);
        const int c = wave_total((int)(lo16(acc) + (acc >> 16)));
        if (c >= 256) thr = cand;
        if (c == 256) break;
    }
    unsigned ag = 0u, ae = 0u;
    {
        const unsigned Cg = thr | (thr << 16), tm1 = thr - 1u, Ce = tm1 | (tm1 << 16);
#pragma unroll
        for (int i = 0; i < NR2; ++i) { ag = pk_cnt(ag, R[i], Cg, ONE); ae = pk_cnt(ae, R[i], Ce, ONE); }
    }
    const int cg_l = (int)(lo16(ag) + (ag >> 16)), ce_l = (int)(lo16(ae) + (ae >> 16)) - cg_l;
    int sc = cg_l | (ce_l << 16);
    const int mine = sc;
    sc += __builtin_amdgcn_update_dpp(0, sc, 0x111, 0xf, 0xf, false);
    sc += __builtin_amdgcn_update_dpp(0, sc, 0x112, 0xf, 0xf, false);
    sc += __builtin_amdgcn_update_dpp(0, sc, 0x114, 0xf, 0xf, false);
    sc += __builtin_amdgcn_update_dpp(0, sc, 0x118, 0xf, 0xf, false);
    const int r0 = __builtin_amdgcn_readlane(sc, 15), r1 = __builtin_amdgcn_readlane(sc, 31), r2 = __builtin_amdgcn_readlane(sc, 47), r3 = __builtin_amdgcn_readlane(sc, 63);
    const int rowi = lane >> 4;
    sc += (rowi > 0 ? r0 : 0) + (rowi > 1 ? r1 : 0) + (rowi > 2 ? r2 : 0);
    const int tot = r0 + r1 + r2 + r3;
    const int cgt = (int)lo16((unsigned)tot), meq = tot >> 16, need = 256 - cgt;
    sc -= mine;
    int og = (int)lo16((unsigned)sc), oe = sc >> 16;
#pragma unroll
    for (int i = 0; i < NR2; ++i) {
        const int e0 = 128 * i + 2 * lane;
        const unsigned lo = lo16(R[i]), hi = R[i] >> 16;
        if (lo > thr) { sel[og & 255] = (unsigned short)e0; ++og; }
        else if (lo == thr) { if (oe < 256) bl[oe] = (unsigned short)e0; ++oe; }
        if (hi > thr) { sel[og & 255] = (unsigned short)(e0 + 1); ++og; }
        else if (hi == thr) { if (oe < 256) bl[oe] = (unsigned short)(e0 + 1); ++oe; }
    }
    LDS_WAIT(); asm volatile("" ::: "memory");
    const int mc = meq < 256 ? meq : 256;
    unsigned v[4]; int vi[4];
#pragma unroll
    for (int r = 0; r < 4; ++r) {
        const int ci = lane + 64 * r;
        const int idx = (int)bl[ci < mc ? ci : mc - 1];
        const unsigned k32 = fkey(sc32[idx]);
        vi[r] = idx;
        v[r] = (ci < mc) ? (((lo16(k32) << 13) | (unsigned)(8191 - idx)) + 1u) : 0u;
    }
    unsigned tv = 1u;
    if (mc != need) {
        tv = 0u;
#pragma unroll 1
        for (int b = 29; b >= 0; --b) {
            const unsigned cand = tv | (1u << b);
            int c = 0;
#pragma unroll
            for (int r = 0; r < 4; ++r) c += __popcll(__ballot(v[r] >= cand));
            if (c >= need) tv = cand;
            if (c == need) break;
        }
    }
    int base = cgt;
#pragma unroll
    for (int r = 0; r < 4; ++r) {
        const bool take = v[r] >= tv;
        const unsigned long long tm = __ballot(take);
        const int pos = base + (int)__builtin_amdgcn_mbcnt_hi((unsigned)(tm >> 32), __builtin_amdgcn_mbcnt_lo((unsigned)tm, 0u));
        if (take) sel[pos & 255] = (unsigned short)vi[r];
        base += __popcll(tm);
    }
}

template <int MODE>
__device__ __forceinline__ void dsa_item(LAS unsigned char* lds, const bf16_t* P, const bf16_t* IKC, float* scr, unsigned short* scr16, bf16_t* AOb, int t0, int wv) {
    const int tid = tid_of(wv);
    const int lane = tid & 63, w = wv; (void)tid;
    const bool need_sel = (t0 >= 256);
    if (need_sel && (MODE & 1)) {
        const int g = w & 3, c = lane & 31, hh = lane >> 5;
        const int nkb = (t0 + 16 + 31) / 32;
        const int qiA = 2 * ((c >> 2) & 1) + (c >> 4), hdA = 4 * ((c >> 3) & 1) + (c & 3);
        bf16x8 af[4];
#pragma unroll
        for (int ds = 0; ds < 4; ++ds) af[ds] = *(const bf16x8*)(P + (size_t)(t0 + 4 * g + qiA) * NIN + C_IQ + hdA * 64 + 16 * ds + 8 * hh);
        float wq[2][8];
#pragma unroll
        for (int qq = 0; qq < 2; ++qq) {
            float tmp[8]; unpack8(*(const u32x4*)(P + (size_t)(t0 + 4 * g + 2 * hh + qq) * NIN + C_IW), tmp);
#pragma unroll
            for (int h = 0; h < 8; ++h) wq[qq][h] = tmp[h] * 0.044194173824159216f;
        }
        const bf16_t* ikp = IKC + (size_t)lane * 8;
        bf16x8 bc[4], bn[4], bm[4];
        const int kbw = (w >> 2);
        {
            const int kb1 = min(kbw + 2, nkb - 1);
#pragma unroll
            for (int ds = 0; ds < 4; ++ds) { bc[ds] = *(const bf16x8*)(ikp + (size_t)kbw * 2048 + 512 * ds); bn[ds] = *(const bf16x8*)(ikp + (size_t)kb1 * 2048 + 512 * ds); }
        }
#pragma unroll 1
        for (int kc = kbw; kc < nkb; kc += 16) {
            float ra[8][2];
#pragma unroll
            for (int i = 0; i < 8; ++i) {
                const int kn = min(kc + 2 * i + 4, nkb - 1);
#pragma unroll
                for (int ds = 0; ds < 4; ++ds) bm[ds] = *(const bf16x8*)(ikp + (size_t)kn * 2048 + 512 * ds);
                f32x16 s;
#pragma unroll
                for (int r = 0; r < 16; ++r) s[r] = 0.f;
#pragma unroll
                for (int ds = 0; ds < 4; ++ds) s = __builtin_amdgcn_mfma_f32_32x32x16_bf16(af[ds], bc[ds], s, 0, 0, 0);
#pragma unroll
                for (int qq = 0; qq < 2; ++qq) {
                    float a = 0.f;
#pragma unroll
                    for (int h = 0; h < 8; ++h) a += wq[qq][h] * fmaxf(s[8 * qq + h], 0.f);
                    ra[i][qq] = a;
                }
#pragma unroll
                for (int ds = 0; ds < 4; ++ds) { bc[ds] = bn[ds]; bn[ds] = bm[ds]; }
            }
#pragma unroll
            for (int i = 0; i < 8; ++i) {
                const int kb = kc + 2 * i;
                if (kb < nkb) {
#pragma unroll
                    for (int qq = 0; qq < 2; ++qq) {
                        const size_t o = (size_t)(4 * g + 2 * hh + qq) * SEQ + 32 * kb + c;
                        scr[o] = ra[i][qq];
                        scr16[o] = (unsigned short)(fkey(ra[i][qq]) >> 16);
                    }
                }
            }
        }
    }
    __syncthreads();
    LAS unsigned char* wl = lds + w * 8192;
    LAS float* pl = (LAS float*)wl;
    LAS unsigned short* sel = (LAS unsigned short*)(wl + 4096);
    LAS unsigned short* bl = (LAS unsigned short*)(wl + 4096 + 512);
    typedef float f32x4_t __attribute__((ext_vector_type(4)));
    const int n16 = lane & 15, g4 = lane >> 4;
#pragma unroll 1
    for (int qq = 0; qq < 2; ++qq) {
        const int ql = 2 * w + qq, t = t0 + ql;
        int nsel;
        if (need_sel && (MODE & 2)) {
            const float* sc = scr + (size_t)ql * SEQ;
            const unsigned* sc16 = (const unsigned*)(scr16 + (size_t)ql * SEQ);
            const int nr2 = (t >> 7) + 1;
            if (nr2 <= 16) topk_select16<16>(sc16, sc, t, sel, bl, lane);
            else if (nr2 <= 32) topk_select16<32>(sc16, sc, t, sel, bl, lane);
            else if (nr2 <= 48) topk_select16<48>(sc16, sc, t, sel, bl, lane);
            else topk_select16<64>(sc16, sc, t, sel, bl, lane);
            nsel = 256;
        } else {
            nsel = t + 1;
#pragma unroll
            for (int i = 0; i < 4; ++i) sel[lane + 64 * i] = (unsigned short)(lane + 64 * i);
        }
        if (!(MODE & 4)) { if (lane == 0) AOb[(size_t)t * DM] = sel[17]; continue; }
        LDS_WAIT(); asm volatile("" ::: "memory");
        bf16x8 qa[4];
#pragma unroll
        for (int ks = 0; ks < 4; ++ks) qa[ks] = *(const bf16x8*)(P + (size_t)t * NIN + C_BQ + (n16 & 3) * 128 + 32 * ks + 8 * g4);
        float sl[4][4];
#pragma unroll
        for (int i = 0; i < 4; ++i)
#pragma unroll
            for (int h = 0; h < 4; ++h) sl[i][h] = 0.f;
#pragma unroll
        for (int kb = 0; kb < 16; ++kb) {
            const int idx = (int)sel[16 * kb + n16];
            const bf16_t* kr = P + (size_t)idx * NIN + C_BK + 8 * g4;
            bf16x8 kf[4];
#pragma unroll
            for (int ks = 0; ks < 4; ++ks) kf[ks] = *(const bf16x8*)(kr + 32 * ks);
            f32x4 acc = (f32x4){0.f, 0.f, 0.f, 0.f};
#pragma unroll
            for (int ks = 0; ks < 4; ++ks) acc = __builtin_amdgcn_mfma_f32_16x16x32_bf16(qa[ks], kf[ks], acc, 0, 0, 0);
            const bool mine = (g4 == (kb & 3));
#pragma unroll
            for (int h = 0; h < 4; ++h) sl[kb >> 2][h] = mine ? acc[h] : sl[kb >> 2][h];
            if ((kb & 3) == 3) __builtin_amdgcn_sched_barrier(0);
        }
        float linv[4];
#pragma unroll
        for (int i = 0; i < 4; ++i) {
            const bool val = (16 * (4 * i + g4) + n16) < nsel;
#pragma unroll
            for (int h = 0; h < 4; ++h) sl[i][h] = val ? sl[i][h] : -INFINITY;
        }
#pragma unroll
        for (int h = 0; h < 4; ++h) {
            float mx = fmaxf(fmaxf(sl[0][h], sl[1][h]), fmaxf(sl[2][h], sl[3][h]));
            mx = wave_max_dpp(mx);
            float ps = 0.f;
#pragma unroll
            for (int i = 0; i < 4; ++i) { sl[i][h] = fexp2(sl[i][h] - mx); ps += sl[i][h]; }
            ps = wave_sum_dpp(ps);
            linv[h] = 1.f / ps;
        }
#pragma unroll
        for (int i = 0; i < 4; ++i) *(LAS f32x4*)(pl + 4 * (16 * (4 * i + g4) + n16)) = (f32x4){sl[i][0], sl[i][1], sl[i][2], sl[i][3]};
        LDS_WAIT(); asm volatile("" ::: "memory");
        typedef float f32x2_t __attribute__((ext_vector_type(2)));
        f32x2_t oacc[4][4];
#pragma unroll
        for (int h = 0; h < 4; ++h)
#pragma unroll
            for (int d = 0; d < 4; ++d) oacc[h][d] = (f32x2_t){0.f, 0.f};
        const bf16_t* vb = P + C_BV + 8 * n16;
        const int nj = (nsel + 15) & ~15;
        u32x4 vw[4], vn[4];
#pragma unroll
        for (int u = 0; u < 4; ++u) vw[u] = *(const u32x4*)(vb + (size_t)((int)sel[4 * u + g4]) * NIN);
#pragma unroll 1
        for (int j0 = 0; j0 < nj; j0 += 16) {
            const int jn = (j0 + 16 < nj) ? j0 + 16 : j0;
#pragma unroll
            for (int u = 0; u < 4; ++u) vn[u] = *(const u32x4*)(vb + (size_t)((int)sel[jn + 4 * u + g4]) * NIN);
#pragma unroll
            for (int u = 0; u < 4; ++u) {
                const f32x4 pq = *(const LAS f32x4*)(pl + 4 * (j0 + 4 * u + g4));
                float vx[8]; unpack8(vw[u], vx);
#pragma unroll
                for (int h = 0; h < 4; ++h)
#pragma unroll
                    for (int d = 0; d < 4; ++d) oacc[h][d] += (f32x2_t){vx[2 * d], vx[2 * d + 1]} * pq[h];
            }
#pragma unroll
            for (int u = 0; u < 4; ++u) vw[u] = vn[u];
        }
#pragma unroll
        for (int h = 0; h < 4; ++h) {
            float r[8];
#pragma unroll
            for (int d = 0; d < 4; ++d) {
                float a0 = oacc[h][d].x, a1 = oacc[h][d].y;
                a0 += swz_xor<16>(a0); a1 += swz_xor<16>(a1);
                a0 = xhalf_sum(a0); a1 = xhalf_sum(a1);
                r[2 * d] = a0 * linv[h]; r[2 * d + 1] = a1 * linv[h];
            }
            if (g4 == 0) {
                u32x4 w; w.x = cvt_pk_bf16(r[0], r[1]); w.y = cvt_pk_bf16(r[2], r[3]); w.z = cvt_pk_bf16(r[4], r[5]); w.w = cvt_pk_bf16(r[6], r[7]);
                *(u32x4*)(AOb + (size_t)t * DM + h * 128 + 8 * n16) = w;
            }
        }
        LDS_WAIT(); asm volatile("" ::: "memory");
    }
    __syncthreads();
}

struct Args { const float* in[19]; float* out; unsigned char* ws; };
constexpr int TAB_OFF = MISC_OFF + 256;
__device__ __forceinline__ unsigned long long tabp_(LAS unsigned char* lds, int i) {
    volatile LAS unsigned* p = (volatile LAS unsigned*)(lds + TAB_OFF + 8 * i);
    const unsigned lo = __builtin_amdgcn_readfirstlane(p[0]), hi = __builtin_amdgcn_readfirstlane(p[1]);
    return ((unsigned long long)hi << 32) | lo;
}
#define tabp(i) tabp_(lds, (i))
#define INP(i) ((const float*)(const GAS float*)tabp(i))
#define WSP(T, off) ((T*)(GAS T*)(tabp(20) + (off)))
#define GRID_BAR() do { XcdBarrier b_; b_.bar = WSP(unsigned, WS_CTL) + CW_BAR; b_.x = xb_xcc_id(); b_.st = (volatile LAS unsigned*)(lds + MISC_OFF) + 8; xcd_barrier(b_, wv); } while (0)

#define PHASE_VARS const int tid = tid_of(wv); const int lane = tid & 63, wave = wv; \
    int bx = blockIdx.x; asm volatile("" : "+s"(bx)); const int GW = bx * 8 + wave, NGW = (int)gridDim.x * 8; LAS float* wscr = (LAS float*)(lds + wave * 8448); \
    (void)lane; (void)GW; (void)NGW; (void)wscr; (void)tid;
template <int L> __device__ __forceinline__ void layer_fwd(LAS unsigned char* lds, const int wv) {

        {
            PHASE_VARS
            constexpr int I_IN = 32 * 352, I_KVB = 8 * 64, I_BR = 32 * 64, I_OUT = 32 * 64, I_GU = 32 * 352, I_DN = 88 * 64;
            constexpr int NITEMS = I_IN + I_KVB + I_BR + I_OUT + I_GU + I_DN;
#pragma unroll 1
            for (int it = GW; it < NITEMS; it += NGW) {
                int r = it;
                if (r < I_IN) { tr_item(INP(2) + (size_t)L * DM * INW, INW, DM, WSP(bf16_t, WS_WIN), 1, INP(1) + (size_t)L * DM, wscr, r, 352, lane); continue; } r -= I_IN;
                if (r < I_KVB) { tr_item(INP(12) + (size_t)L * 512 * 2048, 2048, 512, WSP(bf16_t, WS_WKVB), 0, nullptr, wscr, r, 64, lane); continue; } r -= I_KVB;
                if (r < I_BR) { tr_item(INP(14) + (size_t)L * DM * DM, DM, DM, WSP(bf16_t, WS_WBR), 0, nullptr, wscr, r, 64, lane); continue; } r -= I_BR;
                if (r < I_OUT) { tr_item(INP(15) + (size_t)L * DM * DM, DM, DM, WSP(bf16_t, WS_WOUT), 0, nullptr, wscr, r, 64, lane); continue; } r -= I_OUT;
                if (r < I_GU) { tr_item(INP(17) + (size_t)L * DM * 2 * DFF, 2 * DFF, DM, WSP(bf16_t, WS_WGU), 2, INP(16) + (size_t)L * DM, wscr, r, 352, lane); continue; } r -= I_GU;
                tr_item(INP(18) + (size_t)L * DFF * DM, DM, DFF, WSP(bf16_t, WS_WDN), 0, nullptr, wscr, r, 64, lane);
            }
            if (L == 0) {
                const float* x_in = INP(0); bf16_t* XB = WSP(bf16_t, WS_XB); float* ssq_attn = WSP(float, WS_CTL) + CW_SSQ;
#pragma unroll 1
                for (int t = GW; t < SEQ; t += NGW) {
                    const float* xr = x_in + (size_t)t * DM; float ss = 0.f;
#pragma unroll
                    for (int j = 0; j < 4; ++j) {
                        const int e = 8 * (lane + 64 * j);
                        const f32x4 a = *(const f32x4*)(xr + e), b = *(const f32x4*)(xr + e + 4);
                        ss += a[0] * a[0] + a[1] * a[1] + a[2] * a[2] + a[3] * a[3] + b[0] * b[0] + b[1] * b[1] + b[2] * b[2] + b[3] * b[3];
                        u32x4 wv; wv.x = pk2(a[0], a[1]); wv.y = pk2(a[2], a[3]); wv.z = pk2(b[0], b[1]); wv.w = pk2(b[2], b[3]);
                        *(u32x4*)(XB + (size_t)t * DM + e) = wv;
                    }
                    ss = wave_sum(ss);
                    if (lane == 0) ssq_attn[t] = ss;
                }
            }
        }
        if (L == 0) { asm volatile("s_waitcnt vmcnt(0)" ::: "memory"); __threadfence(); cg::this_grid().sync(); } else GRID_BAR();

        {
            pg8::Gemm g{WSP(bf16_t, WS_XB), WSP(bf16_t, WS_WIN), SEQ, NIN, DM, DM, DM}; pg8::StaticOrder S; { int bx_ = blockIdx.x; asm volatile("" : "+s"(bx_)); S.init(SEQ, NIN, gridDim.x, bx_); }
            pg8::Epi E{}; E.mode = pg8::EPI_INPROJ; E.obf = WSP(bf16_t, WS_P); E.ldo = NIN; E.f1 = WSP(float, WS_CTL) + CW_SSQ + (2 * L) * SEQ;
            pg8::gemm_phase(lds, g, S, E, wv);
        }
        GRID_BAR();

#ifdef PROBE_P1
        {
            pg8::Gemm g{WSP(bf16_t, WS_XB), WSP(bf16_t, WS_WIN), SEQ, NIN, DM, DM, DM}; pg8::StaticOrder S; { int bx_ = blockIdx.x; asm volatile("" : "+s"(bx_)); S.init(SEQ, NIN, gridDim.x, bx_); }
            pg8::Epi E{}; E.mode = pg8::EPI_INPROJ; E.obf = WSP(bf16_t, WS_P); E.ldo = NIN; E.f1 = WSP(float, WS_CTL) + CW_SSQ + (2 * L) * SEQ;
            pg8::gemm_phase(lds, g, S, E, wv);
        }
        GRID_BAR();

#endif
        {
            PHASE_VARS
            bf16_t* P = WSP(bf16_t, WS_P);
#pragma unroll 1
            for (int t = GW; t < SEQ; t += NGW) {
                bf16_t* pr = P + (size_t)t * NIN;
                LAS float* tab = wscr;
                bf16_t* hb = pr + C_CQ + (lane >> 3) * 192; const int c8 = lane & 7;
                const u32x4 l_aq = *(const u32x4*)(pr + C_AQ + 8 * lane), l_ak = *(const u32x4*)(pr + C_AK + 8 * lane), l_bq = *(const u32x4*)(pr + C_BQ + 8 * lane);
                const u32x4 l_bk = *(const u32x4*)(pr + C_BK + 8 * (lane & 15)), l_iq = *(const u32x4*)(pr + C_IQ + 8 * lane), l_ik = *(const u32x4*)(pr + C_IK + 8 * c8);
                const u32x4 l_kv = *(const u32x4*)(pr + C_CKV + 8 * lane);
                const u32x4 l_c0 = *(const u32x4*)(hb + 8 * c8), l_c1 = *(const u32x4*)(hb + 64 + 8 * c8), l_c2 = *(const u32x4*)(hb + 128 + 8 * c8);
                rope_table(tab, (float)t, lane);
                pp_chunk<64, 16, true>(l_aq, pr + C_AQ + 8 * lane, lane & 7, true, INP(3) + L * 64, tab, 0.125f * LOG2E);
                pp_chunk<64, 16, true>(l_ak, pr + C_AK + 8 * lane, lane & 7, true, INP(4) + L * 64, tab, 1.f);
                pp_chunk<128, 32, true>(l_bq, pr + C_BQ + 8 * lane, lane & 15, true, INP(7) + L * 128, tab + 8, 0.08838834764831845f * LOG2E);
                pp_chunk<128, 32, true>(l_bk, pr + C_BK + 8 * (lane & 15), lane & 15, lane < 16, INP(8) + L * 128, tab + 8, 1.f);
                pp_chunk<64, 16, false>(l_iq, pr + C_IQ + 8 * lane, lane & 7, true, nullptr, tab, 1.f);
                pp_chunk<64, 16, true>(l_ik, WSP(bf16_t, WS_IKC) + ((size_t)(((t >> 5) * 4 + (c8 >> 1)) * 64 + (c8 & 1) * 32 + (t & 31))) * 8, c8, lane < 8, INP(9) + L * 64, tab, 1.f);
                pp_chunk<512, 0, true>(l_kv, pr + C_CKV + 8 * lane, lane, true, INP(11) + L * 512, tab, 1.f);
                pp_head192(l_c0, l_c1, l_c2, hb, c8, INP(10) + L * 192, tab + 24, 0.07216878364870323f * LOG2E);
                LDS_WAIT(); asm volatile("" ::: "memory");
            }
            bf16_t* VTA = WSP(bf16_t, WS_VTA);
#pragma unroll 1
            for (int it = GW; it < 128 * 8; it += NGW) {
                const int tb = it >> 3, cb = it & 7;
                trb_item(P + (size_t)(64 * tb) * NIN + C_AV + 64 * cb, NIN, VTA + (size_t)(64 * cb) * SEQ + 64 * tb, SEQ, (LAS unsigned short*)wscr, lane);
            }
        }
        GRID_BAR();

        {
            pg8::Gemm g{WSP(bf16_t, WS_P) + C_CKV, WSP(bf16_t, WS_WKVB), SEQ, 2048, 512, NIN, 512}; pg8::StaticOrder S; { int bx_ = blockIdx.x; asm volatile("" : "+s"(bx_)); S.init(SEQ, 2048, gridDim.x, bx_); }
            pg8::Epi E{}; E.mode = pg8::EPI_PLAIN; E.obf = WSP(bf16_t, WS_KVB); E.ldo = 2048;
            pg8::gemm_phase(lds, g, S, E, wv);
        }
        GRID_BAR();

        {
            PHASE_VARS
            const bf16_t* P = WSP(bf16_t, WS_P); const bf16_t* KVB = WSP(bf16_t, WS_KVB); bf16_t* KC = WSP(bf16_t, WS_KC); bf16_t* VTC = WSP(bf16_t, WS_VTC);
            const float* c_k_norm = INP(13) + L * 192;
#pragma unroll 1
            for (int t = GW; t < SEQ; t += NGW) {
                const int h = lane >> 3, ci = lane & 7;
                const bf16_t* kv = KVB + (size_t)t * 2048 + h * 256;
                const u32x4 a0 = *(const u32x4*)(P + (size_t)t * NIN + C_CKR + 8 * ci), a1 = *(const u32x4*)(kv + 8 * ci), a2 = *(const u32x4*)(kv + 64 + 8 * ci);
                LAS float* tab = wscr;
                rope_table(tab, (float)t, lane);
                pp_head192(a0, a1, a2, KC + (size_t)t * 1536 + h * 192, ci, c_k_norm, tab + 24, 1.f);
                LDS_WAIT(); asm volatile("" ::: "memory");
            }
#pragma unroll 1
            for (int it = GW; it < 128 * 16; it += NGW) {
                const int tb = it >> 4, cb = it & 15, h = cb >> 1, d0 = (cb & 1) * 64;
                trb_item(KVB + (size_t)(64 * tb) * 2048 + h * 256 + 128 + d0, 2048, VTC + (size_t)(h * 128 + d0) * SEQ + 64 * tb, SEQ, (LAS unsigned short*)wscr, lane);
            }
        }
        GRID_BAR();

#define RUN_P5(QSLOT, ITEM_LO, ITEM_HI, DSAMODE) { \
            _Pragma("unroll 1") for (;;) { \
                PHASE_VARS \
                volatile LAS unsigned* MISC = (volatile LAS unsigned*)(lds + MISC_OFF); \
                __syncthreads(); \
                if (tid == 0) MISC[16] = atomicAdd(WSP(unsigned, WS_CTL) + CW_Q + 64 * (QSLOT), 1u); \
                __syncthreads(); \
                const int item = (ITEM_LO) + (int)__builtin_amdgcn_readfirstlane(MISC[16]); \
                if (item >= (ITEM_HI)) break; \
                bf16_t* P = WSP(bf16_t, WS_P); bf16_t* AO = WSP(bf16_t, WS_AO); \
                if (item < 512) { \
                    const int qb = 31 - (item >> 4), j = item & 15; \
                    if (j < 8) attn_unit<192>(lds, P + C_CQ + j * 192, NIN, WSP(bf16_t, WS_KC) + j * 192, 1536, WSP(bf16_t, WS_VTC) + (size_t)j * 128 * SEQ, qb, nullptr, 0, AO + 1024 + j * 128, DM, wv); \
                    else { const int hm = j - 8; attn_unit<64>(lds, P + C_AQ + hm * 64, NIN, P + C_AK + hm * 64, NIN, WSP(bf16_t, WS_VTA) + (size_t)(hm >> 1) * 128 * SEQ, qb, WSP(float, WS_OA32) + hm * 128, 1024, nullptr, 0, wv); } \
                } else { \
                    const int t0 = (511 - (item - 512)) * 16; \
                    dsa_item<DSAMODE>(lds, P, WSP(bf16_t, WS_IKC), WSP(float, WS_SCR) + (size_t)bx * 16 * SEQ, WSP(unsigned short, WS_SCR16) + (size_t)bx * 16 * SEQ, (DSAMODE == 15 ? AO + 512 : WSP(bf16_t, WS_OA32)), t0, wv); \
                } \
            } \
        }
        RUN_P5(L, 0, 1024, 15)
#ifdef PROBE_DENSE
        GRID_BAR();
        RUN_P5(L + 2, 0, 512, 15)
#endif
#ifdef PROBE_P5
        GRID_BAR();
        RUN_P5(L + 6, 0, 1024, 15)
#endif
#ifdef PROBE_DSA
        GRID_BAR();
        RUN_P5(L + 4, 512, 1024, PROBE_DSA)
#endif
        GRID_BAR();

        {
            PHASE_VARS
            const float lam_init = (L == 0) ? 0.2f : (0.8f - 0.6f * 0.7408182206817179f);
            const float* a_lambda = INP(5) + L * 256; const float* a_sub_norm = INP(6) + L * 128;
            const float* OA32 = WSP(float, WS_OA32); bf16_t* AO = WSP(bf16_t, WS_AO);
            float lam;
            { const float a = a_lambda[lane] * a_lambda[64 + lane], b = a_lambda[128 + lane] * a_lambda[192 + lane];
              lam = expf(wave_sum(a)) - expf(wave_sum(b)) + lam_init; }
            const float g0 = a_sub_norm[2 * lane], g1 = a_sub_norm[2 * lane + 1];
#pragma unroll 1
            for (int t = GW; t < SEQ; t += NGW) {
                float a1[4][2], a2[4][2];
#pragma unroll
                for (int h = 0; h < 4; ++h) {
                    const float* o1 = OA32 + (size_t)t * 1024 + (2 * h) * 128 + 2 * lane;
                    a1[h][0] = o1[0]; a1[h][1] = o1[1]; a2[h][0] = o1[128]; a2[h][1] = o1[129];
                }
#pragma unroll
                for (int h = 0; h < 4; ++h) {
                    const float d0 = a1[h][0] - lam * a2[h][0], d1 = a1[h][1] - lam * a2[h][1];
                    const float ss = wave_sum(d0 * d0 + d1 * d1);
                    const float r = (1.0f / sqrtf(ss * (1.f / 128.f) + NORM_EPS)) * (1.f - lam_init);
                    *(unsigned*)(AO + (size_t)t * DM + h * 128 + 2 * lane) = pk2(d0 * r * g0, d1 * r * g1);
                }
            }
        }
        GRID_BAR();

#pragma unroll 1
        for (int br = 0; br < 3; ++br) {
            pg8::StaticOrder S; { int bx_ = blockIdx.x; asm volatile("" : "+s"(bx_)); S.init(SEQ, DM, gridDim.x, bx_); }
            const int ko = (br == 2) ? 1024 : 512 * br;
            pg8::Gemm g{WSP(bf16_t, WS_AO) + ko, WSP(bf16_t, WS_WBR) + ko, SEQ, DM, (br == 2) ? 1024 : 512, DM, DM};
            pg8::Epi E{}; E.mode = pg8::EPI_BR0 + br; E.gate = WSP(bf16_t, WS_P) + C_G + br * DM; E.ldg = NIN; E.f0 = WSP(float, WS_SCR); E.obf = WSP(bf16_t, WS_MG); E.ldo = DM;
            pg8::gemm_phase(lds, g, S, E, wv);
        }
        GRID_BAR();

        {
            pg8::Gemm g{WSP(bf16_t, WS_MG), WSP(bf16_t, WS_WOUT), SEQ, DM, DM, DM, DM}; pg8::StaticOrder S; { int bx_ = blockIdx.x; asm volatile("" : "+s"(bx_)); S.init(SEQ, DM, gridDim.x, bx_); }
            pg8::Epi E{}; E.mode = pg8::EPI_RESID; E.f1 = (L == 0) ? INP(0) : (const float*)(const GAS float*)tabp(19); E.f0 = (float*)(GAS float*)tabp(19); E.obf = WSP(bf16_t, WS_XB); E.ldo = DM;
            E.f2 = WSP(float, WS_CTL) + CW_SSQ + (2 * L + 1) * SEQ;
            pg8::gemm_phase(lds, g, S, E, wv);
        }
        GRID_BAR();

        {
            pg8::Gemm g{WSP(bf16_t, WS_XB), WSP(bf16_t, WS_WGU), SEQ, NGU, DM, DM, DM}; pg8::StaticOrder S; { int bx_ = blockIdx.x; asm volatile("" : "+s"(bx_)); S.init(SEQ, NGU, gridDim.x, bx_); }
            pg8::Epi E{}; E.mode = pg8::EPI_SWIGLU; E.obf = WSP(bf16_t, WS_P); E.ldo = DFF; E.f1 = WSP(float, WS_CTL) + CW_SSQ + (2 * L + 1) * SEQ;
            pg8::gemm_phase(lds, g, S, E, wv);
        }
        GRID_BAR();

#ifdef PROBE_P9
        {
            pg8::Gemm g{WSP(bf16_t, WS_XB), WSP(bf16_t, WS_WGU), SEQ, NGU, DM, DM, DM}; pg8::StaticOrder S; { int bx_ = blockIdx.x; asm volatile("" : "+s"(bx_)); S.init(SEQ, NGU, gridDim.x, bx_); }
            pg8::Epi E{}; E.mode = pg8::EPI_SWIGLU; E.obf = WSP(bf16_t, WS_P); E.ldo = DFF; E.f1 = WSP(float, WS_CTL) + CW_SSQ + (2 * L + 1) * SEQ;
            pg8::gemm_phase(lds, g, S, E, wv);
        }
        GRID_BAR();

#endif
        {
            pg8::Gemm g{WSP(bf16_t, WS_P), WSP(bf16_t, WS_WDN), SEQ, DM, DFF, DFF, DFF}; pg8::StaticOrder S; { int bx_ = blockIdx.x; asm volatile("" : "+s"(bx_)); S.init(SEQ, DM, gridDim.x, bx_); }
            pg8::Epi E{}; E.mode = pg8::EPI_RESID; E.f1 = (const float*)(const GAS float*)tabp(19); E.f0 = (float*)(GAS float*)tabp(19); E.obf = WSP(bf16_t, WS_XB); E.ldo = DM;
            E.f2 = WSP(float, WS_CTL) + CW_SSQ + (2 * L + 2) * SEQ;
            pg8::gemm_phase(lds, g, S, E, wv);
        }
        GRID_BAR();

}

__global__ void __launch_bounds__(512) fwd_kernel(Args args) {
    extern __shared__ __attribute__((aligned(16))) unsigned char lds_raw[];
    LAS unsigned char* lds = (LAS unsigned char*)lds_raw;
    const int wv = __builtin_amdgcn_readfirstlane((int)(threadIdx.x >> 6));
    {
        const int tid = tid_of(wv);
        volatile LAS unsigned* MISC = (volatile LAS unsigned*)(lds + MISC_OFF);
        for (int u = tid; u < 64; u += 512) MISC[u] = 0u;
        if (tid < 21) {
            const unsigned long long v = (tid < 19) ? (unsigned long long)args.in[tid] : (tid == 19 ? (unsigned long long)args.out : (unsigned long long)args.ws);
            volatile LAS unsigned* p = (volatile LAS unsigned*)(lds + TAB_OFF + 8 * tid);
            p[0] = (unsigned)v; p[1] = (unsigned)(v >> 32);
        }
        __syncthreads();
        (void)xcd_barrier_post(WSP(unsigned, WS_CTL) + CW_BAR, MISC + 8);
    }

    layer_fwd<0>(lds, wv);
    layer_fwd<1>(lds, wv);
}

extern "C" void kernel_launch(void* const* d_in, const int* in_sizes, int n_in, void* d_out, int out_size, void* d_ws, size_t ws_size, hipStream_t stream) {
    static int grid = 0;
    if (grid == 0) {
        if (n_in != 19 || ws_size < WS_END) { fprintf(stderr, "kernel_launch: unexpected inputs (n_in %d, ws %zu, need %zu)\n", n_in, ws_size, (size_t)WS_END); grid = -1; return; }
        int dev = 0, cus = 0, per_cu = 0;
        hipGetDevice(&dev);
        hipDeviceGetAttribute(&cus, hipDeviceAttributeMultiprocessorCount, dev);
        hipFuncSetAttribute((const void*)fwd_kernel, hipFuncAttributeMaxDynamicSharedMemorySize, LDS_BYTES);
        hipOccupancyMaxActiveBlocksPerMultiprocessor(&per_cu, (const void*)fwd_kernel, 512, LDS_BYTES);
        (void)hipGetLastError();
        if (per_cu < 1) per_cu = 1;
        grid = cus;
        if (grid > 256) grid = 256;
    }
    if (grid < 0) return;
    hipMemsetAsync((char*)d_ws + WS_CTL, 0, CTL_BYTES, stream);
    Args a{};
    for (int i = 0; i < 19; ++i) a.in[i] = (const float*)d_in[i];
    a.out = (float*)d_out; a.ws = (unsigned char*)d_ws;
    void* kargs[] = {&a};
    hipError_t e = hipLaunchCooperativeKernel((const void*)fwd_kernel, dim3(grid), dim3(512), kargs, LDS_BYTES, stream);
    if (e != hipSuccess) fprintf(stderr, "cooperative launch failed: %s (grid %d)\n", hipGetErrorString(e), grid);
}
```

```cpp
#include <hip/hip_runtime.h>
#include <hip/hip_cooperative_groups.h>
#include <cstdio>
#include <cstdint>
namespace cg = cooperative_groups;

#define GAS __attribute__((address_space(1)))
#define LAS __attribute__((address_space(3)))
typedef unsigned short bf16_t;
typedef short bf16x8 __attribute__((ext_vector_type(8)));
typedef float f32x4 __attribute__((ext_vector_type(4)));
typedef float f32x16 __attribute__((ext_vector_type(16)));
typedef unsigned u32x4 __attribute__((ext_vector_type(4)));
typedef unsigned u32x2 __attribute__((ext_vector_type(2)));

constexpr int SEQ = 8192, DM = 2048, NIN = 11264, DFF = 5632, NGU = 11264, INW = 11144;
constexpr int C_AQ = 0, C_AK = 512, C_AV = 1024, C_BQ = 1536, C_BK = 2048, C_BV = 2176, C_IQ = 2304, C_IK = 2816, C_CKR = 2880,
              C_CQ = 2944, C_CKV = 4480, C_IW = 4992, C_G = 5120;
constexpr float NORM_EPS = 1e-6f;
constexpr float LOG2E = 1.4426950408889634f;
constexpr float LOG2_THETA = 18.931568569324174f;

constexpr size_t MiB = 1u << 20;
constexpr size_t WS_CTL = 0, CTL_BYTES = 1 * MiB;
constexpr size_t WS_WIN = 1 * MiB;
constexpr size_t WS_WKVB = WS_WIN + 44 * MiB;
constexpr size_t WS_WBR = WS_WKVB + 2 * MiB;
constexpr size_t WS_WOUT = WS_WBR + 8 * MiB;
constexpr size_t WS_WGU = WS_WOUT + 8 * MiB;
constexpr size_t WS_WDN = WS_WGU + 44 * MiB;
constexpr size_t WS_P = WS_WDN + 22 * MiB;
constexpr size_t WS_XB = WS_P + 176 * MiB;
constexpr size_t WS_AO = WS_XB + 32 * MiB;
constexpr size_t WS_KC = WS_AO + 32 * MiB;
constexpr size_t WS_VTC = WS_KC + 24 * MiB;
constexpr size_t WS_VTA = WS_VTC + 16 * MiB;
constexpr size_t WS_KVB = WS_VTA + 8 * MiB;
constexpr size_t WS_MG = WS_KVB + 32 * MiB;
constexpr size_t WS_OA32 = WS_MG + 32 * MiB;
constexpr size_t WS_SCR = WS_OA32 + 32 * MiB;
constexpr size_t WS_IKC = WS_SCR + 128 * MiB;
constexpr size_t WS_SCR16 = WS_KVB;
constexpr size_t WS_END = WS_IKC + 1 * MiB;
static_assert(WS_END <= 704 * MiB, "workspace");
constexpr int CW_BAR = 4096;
constexpr int CW_Q = 8192;
constexpr int CW_SSQ = 16384;

__device__ __forceinline__ unsigned f2bf(float f) { unsigned u = __builtin_bit_cast(unsigned, f); return (u + 0x7fffu + ((u >> 16) & 1u)) >> 16; }
__device__ __forceinline__ unsigned pk2(float lo, float hi) { return f2bf(lo) | (f2bf(hi) << 16); }
__device__ __forceinline__ float bf2f(unsigned short b) { return __builtin_bit_cast(float, (unsigned)b << 16); }
__device__ __forceinline__ unsigned cvt_pk_bf16(float lo, float hi) { unsigned r; asm volatile("v_cvt_pk_bf16_f32 %0, %1, %2" : "=v"(r) : "v"(lo), "v"(hi)); return r; }
__device__ __forceinline__ void unpack8(u32x4 w, float* x) {
    x[0] = __builtin_bit_cast(float, w.x << 16); x[1] = __builtin_bit_cast(float, w.x & 0xffff0000u);
    x[2] = __builtin_bit_cast(float, w.y << 16); x[3] = __builtin_bit_cast(float, w.y & 0xffff0000u);
    x[4] = __builtin_bit_cast(float, w.z << 16); x[5] = __builtin_bit_cast(float, w.z & 0xffff0000u);
    x[6] = __builtin_bit_cast(float, w.w << 16); x[7] = __builtin_bit_cast(float, w.w & 0xffff0000u);
}
__device__ __forceinline__ u32x4 pack8(const float* x) { u32x4 w; w.x = pk2(x[0], x[1]); w.y = pk2(x[2], x[3]); w.z = pk2(x[4], x[5]); w.w = pk2(x[6], x[7]); return w; }
__device__ __forceinline__ float wave_sum_dpp(float x);
__device__ __forceinline__ float wave_sum(float v) { return wave_sum_dpp(v); }


template <int CTRL> __device__ __forceinline__ float dppf(float x) { return __builtin_bit_cast(float, __builtin_amdgcn_update_dpp(0, __builtin_bit_cast(int, x), CTRL, 0xf, 0xf, false)); }
__device__ __forceinline__ float rdl(float x, int l) { return __builtin_bit_cast(float, __builtin_amdgcn_readlane(__builtin_bit_cast(int, x), l)); }
__device__ __forceinline__ float wave_max_dpp(float x) {
    x = fmaxf(x, dppf<0xB1>(x)); x = fmaxf(x, dppf<0x4E>(x)); x = fmaxf(x, dppf<0x141>(x)); x = fmaxf(x, dppf<0x140>(x));
    return fmaxf(fmaxf(rdl(x, 0), rdl(x, 16)), fmaxf(rdl(x, 32), rdl(x, 48)));
}
__device__ __forceinline__ float wave_sum_dpp(float x) {
    x += dppf<0xB1>(x); x += dppf<0x4E>(x); x += dppf<0x141>(x); x += dppf<0x140>(x);
    return (rdl(x, 0) + rdl(x, 16)) + (rdl(x, 32) + rdl(x, 48));
}
__device__ __forceinline__ float xhalf_max(float m) {
    unsigned a = __builtin_bit_cast(unsigned, m), b = a; asm volatile("" : "+v"(b));
    auto rr = __builtin_amdgcn_permlane32_swap(a, b, false, false);
    unsigned r0 = rr[0], r1 = rr[1]; asm volatile("" : "+v"(r0), "+v"(r1));
    return fmaxf(__builtin_bit_cast(float, r0), __builtin_bit_cast(float, r1)); }
__device__ __forceinline__ float xhalf_sum(float m) {
    unsigned a = __builtin_bit_cast(unsigned, m), b = a; asm volatile("" : "+v"(b));
    auto rr = __builtin_amdgcn_permlane32_swap(a, b, false, false);
    unsigned r0 = rr[0], r1 = rr[1]; asm volatile("" : "+v"(r0), "+v"(r1));
    return __builtin_bit_cast(float, r0) + __builtin_bit_cast(float, r1); }
template <int O> __device__ __forceinline__ float swz_xor(float x) { return __builtin_bit_cast(float, __builtin_amdgcn_ds_swizzle(__builtin_bit_cast(int, x), 0x1F | (O << 10))); }
__device__ __forceinline__ float fexp2(float x) { return __builtin_amdgcn_exp2f(x); }
__device__ __forceinline__ int tid_of(int wv) { int l = (int)__builtin_amdgcn_mbcnt_hi(~0u, __builtin_amdgcn_mbcnt_lo(~0u, 0u)); asm volatile("" : "+v"(l)); return wv * 64 + l; }
#define LDS_WAIT() asm volatile("s_waitcnt lgkmcnt(0)" ::: "memory")

namespace pg8 {
constexpr int BM = 256, BK = 64, HALF = 128, HTB = HALF * BK * 2, STAGE_BYTES = 8 * HTB, NXCD = 8, WGM = 8;
__host__ __device__ __forceinline__ int lds_byte(int r, int c) { const int st = (r >> 4) * 2 + (c >> 5), rr = r & 15, cc = c & 31, ob = rr * 64 + cc * 2; return st * 1024 + (ob ^ (((ob >> 9) & 1) << 5)); }
__host__ __device__ __forceinline__ void stage_rc(int b, int& R, int& C) { const int st = b / 1024, sb = b % 1024, swz = sb ^ (((sb >> 9) & 1) << 5); R = (st >> 1) * 16 + swz / 64; C = (st & 1) * 32 + (swz % 64) / 2; }
__host__ __device__ __forceinline__ int perm32(int rho) { const int n = rho >> 4, i = rho & 15; return 8 * (i >> 2) + 4 * n + (i & 3); }
struct Unit { int pm, pn; };
struct Gemm { const bf16_t* A; const bf16_t* Bt; int M, N, K, lda, ldb; };
struct StaticOrder {
    int nM, nN, nwg, G, c;
    __device__ void init(int M, int N, int G_, int c_) { nM = M / BM; nN = N / BM; nwg = nM * nN; G = G_; c = c_; }
    __device__ bool next(int i, Unit& u) const {
        const long L = (long)i * G + c; if (L >= nwg) return false;
        int wgid = (int)L; { const int q = nwg / NXCD, r = nwg % NXCD, xcd = wgid % NXCD, off = wgid / NXCD; wgid = (xcd < r ? xcd * (q + 1) : r * (q + 1) + (xcd - r) * q) + off; }
        const int nig = WGM * nN, gid = wgid / nig, fm = gid * WGM, gsz = (nM - fm) < WGM ? (nM - fm) : WGM;
        u.pm = fm + ((wgid % nig) % gsz); u.pn = (wgid % nig) / gsz; return true;
    }
};

enum { EPI_INPROJ = 0, EPI_PLAIN = 1, EPI_BR0 = 2, EPI_BR1 = 3, EPI_BR2 = 4, EPI_RESID = 5, EPI_SWIGLU = 6 };
struct Epi {
    int mode, ldo, ldg;
    bf16_t* obf;
    const bf16_t* gate;
    float* f0;
    const float* f1;
    float* f2;
    __device__ __forceinline__ void operator()(const f32x4 (&acc)[2][2][4][2], const Unit& u, int wr, int wc, int fr, int fq) const {
        const int row0 = u.pm * BM + wr * 64 + fr;
        const int colt = u.pn * BM + wc * 32 + 8 * fq;
        if (mode == EPI_INPROJ || mode == EPI_PLAIN) {
            const bool sg = (mode == EPI_INPROJ) && (u.pn * BM >= C_G);
            float rs[2][4];
#pragma unroll
            for (int ai = 0; ai < 2; ++ai)
#pragma unroll
                for (int m = 0; m < 4; ++m) rs[ai][m] = (mode == EPI_INPROJ) ? f1[row0 + ai * HALF + m * 16] : 0.f;
#pragma unroll
            for (int ai = 0; ai < 2; ++ai)
#pragma unroll
                for (int m = 0; m < 4; ++m) {
                    const int row = row0 + ai * HALF + m * 16;
                    float r = 1.f;
                    if (mode == EPI_INPROJ) r = __builtin_amdgcn_rsqf(rs[ai][m] * (1.f / DM) + NORM_EPS);
#pragma unroll
                    for (int bj = 0; bj < 2; ++bj) {
                        float v[8];
#pragma unroll
                        for (int j = 0; j < 4; ++j) { v[j] = acc[ai][bj][m][0][j] * r; v[4 + j] = acc[ai][bj][m][1][j] * r; }
                        if (sg) {
#pragma unroll
                            for (int j = 0; j < 8; ++j) v[j] = __builtin_amdgcn_rcpf(1.f + __expf(-v[j]));
                        }
                        u32x4 w; w.x = cvt_pk_bf16(v[0], v[1]); w.y = cvt_pk_bf16(v[2], v[3]); w.z = cvt_pk_bf16(v[4], v[5]); w.w = cvt_pk_bf16(v[6], v[7]);
                        *(u32x4*)(obf + (size_t)row * ldo + colt + bj * HALF) = w;
                    }
                }
        } else if (mode == EPI_BR0 || mode == EPI_BR1 || mode == EPI_BR2) {
#pragma unroll
            for (int ai = 0; ai < 2; ++ai)
#pragma unroll
                for (int mh = 0; mh < 2; ++mh) {
                    u32x4 gw[2][2], pw[2][2];
#pragma unroll
                    for (int mm = 0; mm < 2; ++mm)
#pragma unroll
                        for (int bj = 0; bj < 2; ++bj) {
                            const int row = row0 + ai * HALF + (2 * mh + mm) * 16, col = colt + bj * HALF;
                            gw[mm][bj] = *(const u32x4*)(gate + (size_t)row * ldg + col);
                            if (mode != EPI_BR0) pw[mm][bj] = *(const u32x4*)((const bf16_t*)f0 + (size_t)row * DM + col);
                        }
#pragma unroll
                    for (int mm = 0; mm < 2; ++mm)
#pragma unroll
                        for (int bj = 0; bj < 2; ++bj) {
                            const int m = 2 * mh + mm;
                            const int row = row0 + ai * HALF + m * 16, col = colt + bj * HALF;
                            float g[8]; unpack8(gw[mm][bj], g);
                            float v[8];
#pragma unroll
                            for (int j = 0; j < 4; ++j) { v[j] = acc[ai][bj][m][0][j] * g[j]; v[4 + j] = acc[ai][bj][m][1][j] * g[4 + j]; }
                            if (mode != EPI_BR0) {
                                float pp[8]; unpack8(pw[mm][bj], pp);
#pragma unroll
                                for (int j = 0; j < 8; ++j) v[j] += pp[j];
                            }
                            u32x4 w; w.x = cvt_pk_bf16(v[0], v[1]); w.y = cvt_pk_bf16(v[2], v[3]); w.z = cvt_pk_bf16(v[4], v[5]); w.w = cvt_pk_bf16(v[6], v[7]);
                            if (mode == EPI_BR2) *(u32x4*)(obf + (size_t)row * ldo + col) = w;
                            else *(u32x4*)((bf16_t*)f0 + (size_t)row * DM + col) = w;
                        }
                }
        } else if (mode == EPI_RESID) {
#pragma unroll
            for (int ai = 0; ai < 2; ++ai)
#pragma unroll
                for (int mh = 0; mh < 2; ++mh) {
                    f32x4 x0[2][2], x1[2][2];
#pragma unroll
                    for (int mm = 0; mm < 2; ++mm)
#pragma unroll
                        for (int bj = 0; bj < 2; ++bj) {
                            const float* xp = f1 + (size_t)(row0 + ai * HALF + (2 * mh + mm) * 16) * DM + colt + bj * HALF;
                            x0[mm][bj] = *(const f32x4*)xp; x1[mm][bj] = *(const f32x4*)(xp + 4);
                        }
#pragma unroll
                    for (int mm = 0; mm < 2; ++mm) {
                        const int m = 2 * mh + mm;
                        const int row = row0 + ai * HALF + m * 16;
                        float ss = 0.f;
#pragma unroll
                        for (int bj = 0; bj < 2; ++bj) {
                            const int col = colt + bj * HALF;
                            float v[8];
#pragma unroll
                            for (int j = 0; j < 4; ++j) { v[j] = acc[ai][bj][m][0][j] + x0[mm][bj][j]; v[4 + j] = acc[ai][bj][m][1][j] + x1[mm][bj][j]; }
#pragma unroll
                            for (int j = 0; j < 8; ++j) ss += v[j] * v[j];
                            float* op = f0 + (size_t)row * DM + col;
                            *(f32x4*)op = (f32x4){v[0], v[1], v[2], v[3]}; *(f32x4*)(op + 4) = (f32x4){v[4], v[5], v[6], v[7]};
                            u32x4 w; w.x = cvt_pk_bf16(v[0], v[1]); w.y = cvt_pk_bf16(v[2], v[3]); w.z = cvt_pk_bf16(v[4], v[5]); w.w = cvt_pk_bf16(v[6], v[7]);
                            *(u32x4*)(obf + (size_t)row * ldo + col) = w;
                        }
                        ss += swz_xor<16>(ss); ss = xhalf_sum(ss);
                        if (fq == 0) atomicAdd(f2 + row, ss);
                    }
                }
        } else {
            const int colh = u.pn * HALF + wc * 32 + 8 * fq;
            float rs[2][4];
#pragma unroll
            for (int ai = 0; ai < 2; ++ai)
#pragma unroll
                for (int m = 0; m < 4; ++m) rs[ai][m] = f1[row0 + ai * HALF + m * 16];
#pragma unroll
            for (int ai = 0; ai < 2; ++ai)
#pragma unroll
                for (int m = 0; m < 4; ++m) {
                    const int row = row0 + ai * HALF + m * 16;
                    const float r = __builtin_amdgcn_rsqf(rs[ai][m] * (1.f / DM) + NORM_EPS);
                    float v[8];
#pragma unroll
                    for (int n = 0; n < 2; ++n)
#pragma unroll
                        for (int j = 0; j < 4; ++j) {
                            const float g = acc[ai][0][m][n][j] * r, up = acc[ai][1][m][n][j] * r;
                            v[4 * n + j] = g * __builtin_amdgcn_rcpf(1.f + __expf(-g)) * up;
                        }
                    u32x4 w; w.x = cvt_pk_bf16(v[0], v[1]); w.y = cvt_pk_bf16(v[2], v[3]); w.z = cvt_pk_bf16(v[4], v[5]); w.w = cvt_pk_bf16(v[6], v[7]);
                    *(u32x4*)(obf + (size_t)row * ldo + colh) = w;
                }
        }
    }
};

__device__ __forceinline__ void gemm_phase(LAS unsigned char* lds, const Gemm g, const StaticOrder& S, const Epi& E, int wv) {
    const int tid = tid_of(wv);
    const int wid = __builtin_amdgcn_readfirstlane(tid >> 6), lane = tid & 63, wr = wid >> 2, wc = wid & 3, fr = lane & 15, fq = lane >> 4;
    const int K = g.K, nt = K / BK;
    unsigned voffA[2], voffB[2];
#pragma unroll
    for (int i = 0; i < 2; ++i) { int R, C; stage_rc(tid * 16 + i * 8192, R, C); const int Rb = (R & ~31) + perm32(R & 31);
        voffA[i] = (unsigned)(R * g.lda + C) * 2u; voffB[i] = (unsigned)(Rb * g.ldb + C) * 2u; }
    const size_t kstep = (size_t)(BK * 2);
    const size_t hstepA = (size_t)HALF * g.lda * 2, hstepB = (size_t)HALF * g.ldb * 2;
    const size_t tstepA = 2 * hstepA, tstepB = 2 * hstepB;
    const unsigned ldsw = (unsigned)wid * 1024u;
    const int aoff = lds_byte(wr * 64 + fr, fq * 8), boff = lds_byte(wc * 32 + fr, fq * 8);
#define PG8_SA(b, h) (((b) * 2 + (h)) * HTB)
#define PG8_SB(b, h) ((4 + (b) * 2 + (h)) * HTB)
#define PG8_STAGE(bufoff, gbase, voff) do { _Pragma("unroll") for (int _i = 0; _i < 2; ++_i) \
        __builtin_amdgcn_global_load_lds((const unsigned*)((const char*)(gbase) + (voff)[_i]), (LAS unsigned*)(lds + (bufoff) + ldsw + _i * 8192), 16, 0, 0); } while (0)
#define PG8_LDA(dst, b, h) do { _Pragma("unroll") for (int m = 0; m < 4; ++m) _Pragma("unroll") for (int k = 0; k < 2; ++k) dst[m][k] = *(const LAS bf16x8*)(lds + PG8_SA(b, h) + aoff + m * 2048 + k * 1024); } while (0)
#define PG8_LDB(dst, b, h) do { _Pragma("unroll") for (int n = 0; n < 2; ++n) _Pragma("unroll") for (int k = 0; k < 2; ++k) dst[n][k] = *(const LAS bf16x8*)(lds + PG8_SB(b, h) + boff + n * 2048 + k * 1024); } while (0)
#define PG8_MMA(ai, bj, At, Bt) do { __builtin_amdgcn_s_setprio(1); _Pragma("unroll") for (int m = 0; m < 4; ++m) _Pragma("unroll") for (int n = 0; n < 2; ++n) _Pragma("unroll") for (int k = 0; k < 2; ++k) \
        acc[ai][bj][m][n] = __builtin_amdgcn_mfma_f32_16x16x32_bf16(Bt[n][k], At[m][k], acc[ai][bj][m][n], 0, 0, 0); __builtin_amdgcn_s_setprio(0); } while (0)
#define PG8_WAIT_V(n) asm volatile("s_waitcnt vmcnt(" #n ")" ::: "memory")
#define PG8_WAIT_L(n) asm volatile("s_waitcnt lgkmcnt(" #n ")" ::: "memory")
#define PG8_BAR __builtin_amdgcn_s_barrier()
#define PG8_SCHED __builtin_amdgcn_sched_barrier(0)
    Unit cur, nxt; int ui = 0;
    if (!S.next(0, cur)) return;
    f32x4 acc[2][2][4][2];
#pragma unroll
    for (int a = 0; a < 2; ++a)
#pragma unroll
        for (int b = 0; b < 2; ++b)
#pragma unroll
            for (int m = 0; m < 4; ++m)
#pragma unroll
                for (int n = 0; n < 2; ++n) acc[a][b][m][n] = (f32x4){0.f, 0.f, 0.f, 0.f};
    bf16x8 At[4][2], B0[2][2], B1[2][2];
    const char* cA = (const char*)g.A + (size_t)cur.pm * tstepA; const char* cB = (const char*)g.Bt + (size_t)cur.pn * tstepB;
    PG8_STAGE(PG8_SB(0, 0), cB, voffB); PG8_STAGE(PG8_SB(0, 1), cB + hstepB, voffB); PG8_STAGE(PG8_SA(0, 0), cA, voffA); PG8_STAGE(PG8_SA(0, 1), cA + hstepA, voffA);
    if (wr == 1) PG8_BAR;
    PG8_WAIT_V(2); PG8_BAR;
    PG8_STAGE(PG8_SB(1, 0), cB + kstep, voffB); PG8_STAGE(PG8_SA(1, 0), cA + kstep, voffA); PG8_STAGE(PG8_SB(1, 1), cB + hstepB + kstep, voffB);
    PG8_WAIT_V(6); PG8_BAR;
    for (;;) {
        const bool has_next = S.next(ui + 1, nxt);
        const char* nA = has_next ? (const char*)g.A + (size_t)nxt.pm * tstepA : cA; const char* nB = has_next ? (const char*)g.Bt + (size_t)nxt.pn * tstepB : cB;
        for (int t = 0; t < nt; t += 2) {
            const bool last = (t == nt - 2);
            const char* a1 = cA + (size_t)(t + 1) * kstep;
            const char* a2 = last ? nA : cA + (size_t)(t + 2) * kstep; const char* b2 = last ? nB : cB + (size_t)(t + 2) * kstep;
            const char* a3 = a2 + kstep; const char* b3 = b2 + kstep;
            PG8_LDB(B0, 0, 0); PG8_LDB(B1, 0, 1); PG8_SCHED; PG8_LDA(At, 0, 0); PG8_STAGE(PG8_SA(1, 1), a1 + hstepA, voffA);
            PG8_WAIT_V(8); PG8_WAIT_L(0); PG8_BAR; PG8_MMA(0, 0, At, B0); PG8_MMA(0, 1, At, B1); PG8_BAR; PG8_SCHED;
            PG8_LDA(At, 0, 1); PG8_STAGE(PG8_SB(0, 0), b2, voffB); PG8_STAGE(PG8_SB(0, 1), b2 + hstepB, voffB); PG8_STAGE(PG8_SA(0, 0), a2, voffA);
            PG8_WAIT_V(8); PG8_WAIT_L(0); PG8_BAR; PG8_MMA(1, 0, At, B0); PG8_MMA(1, 1, At, B1); PG8_BAR; PG8_SCHED;
            PG8_LDB(B0, 1, 0); PG8_LDB(B1, 1, 1); PG8_SCHED; PG8_LDA(At, 1, 0); PG8_STAGE(PG8_SA(0, 1), a2 + hstepA, voffA);
            PG8_WAIT_V(8); PG8_WAIT_L(0); PG8_BAR; PG8_MMA(0, 0, At, B0); PG8_MMA(0, 1, At, B1); PG8_BAR; PG8_SCHED;
            PG8_LDA(At, 1, 1); PG8_STAGE(PG8_SB(1, 0), b3, voffB); PG8_STAGE(PG8_SB(1, 1), b3 + hstepB, voffB); PG8_STAGE(PG8_SA(1, 0), a3, voffA);
            PG8_WAIT_V(8); PG8_WAIT_L(0); PG8_BAR; PG8_MMA(1, 0, At, B0); PG8_MMA(1, 1, At, B1); PG8_BAR; PG8_SCHED;
        }
        if (wr == 0) PG8_BAR;
        E(acc, cur, wr, wc, fr, fq);
        if (!has_next) break;
#pragma unroll
        for (int a = 0; a < 2; ++a)
#pragma unroll
            for (int b = 0; b < 2; ++b)
#pragma unroll
                for (int m = 0; m < 4; ++m)
#pragma unroll
                    for (int n = 0; n < 2; ++n) acc[a][b][m][n] = (f32x4){0.f, 0.f, 0.f, 0.f};
        cur = nxt; cA = nA; cB = nB; ++ui;
        if (wr == 1) PG8_BAR;
    }
    PG8_WAIT_V(0);
    PG8_BAR;
#undef PG8_SA
#undef PG8_SB
#undef PG8_STAGE
#undef PG8_LDA
#undef PG8_LDB
#undef PG8_MMA
#undef PG8_WAIT_V
#undef PG8_WAIT_L
#undef PG8_BAR
#undef PG8_SCHED
}
}

#define XB_TMO      128
#define XB_XCNT(j)  (256  + 64 * (j))
#define XB_XSUB(j)  (1280 + 64 * (j))
#define XB_XGEN(j)  (2304 + 64 * (j))
#define XB_TOP      3328
#define XB_TOPGEN   3392
#define XCD_BAR_WORDS 3456
#define XB_SPIN_CAP (1u << 22)
__device__ __forceinline__ unsigned xb_ld(unsigned* p)              { return __hip_atomic_load(p, __ATOMIC_RELAXED, __HIP_MEMORY_SCOPE_AGENT); }
__device__ __forceinline__ unsigned xb_add(unsigned* p, unsigned v) { return __hip_atomic_fetch_add(p, v, __ATOMIC_RELAXED, __HIP_MEMORY_SCOPE_AGENT); }
__device__ __forceinline__ unsigned xb_xcc_id() { return (unsigned)__builtin_amdgcn_s_getreg((3 << 11) | 20) & 0xFu; }
#define XB_SPIN(cond, bar) do { unsigned _sp = 0; while (cond) { __builtin_amdgcn_s_sleep(1); \
    if ((++_sp & 255u) == 0u) { if (xb_ld(&(bar)[XB_TMO])) break; if (_sp > XB_SPIN_CAP) { atomicAdd(&(bar)[XB_TMO], 1u); break; } } } } while (0)
struct XcdBarrier { unsigned* bar; unsigned x; volatile LAS unsigned* st; };

__device__ __forceinline__ XcdBarrier xcd_barrier_post(unsigned* bar, volatile LAS unsigned* st) {
    XcdBarrier b; b.bar = bar; b.x = xb_xcc_id(); b.st = st;
    if (threadIdx.x == 0) (void)xb_add(&bar[XB_XCNT(b.x)], 1u);
    return b;
}
__device__ __forceinline__ void xcd_barrier_complete(unsigned* bar, unsigned x, unsigned& nloc, unsigned& nx) {
    const unsigned G = gridDim.x * gridDim.y * gridDim.z;
    unsigned sum, cnt, mine, sp = 0u;
    for (;;) {
        sum = 0u; cnt = 0u; mine = 0u;
#pragma unroll
        for (unsigned j = 0; j < 16; ++j) { const unsigned c = xb_ld(&bar[XB_XCNT(j)]); sum += c; cnt += (c > 0u) ? 1u : 0u; mine = (j == x) ? c : mine; }
        if (sum == G) break;
        __builtin_amdgcn_s_sleep(1);
        if ((++sp & 255u) == 0u) { if (xb_ld(&bar[XB_TMO])) break; if (sp > XB_SPIN_CAP) { atomicAdd(&bar[XB_TMO], 1u); break; } }
    }
    nloc = mine > 0u ? mine : 1u; nx = cnt > 0u ? cnt : 1u;
}
__device__ __forceinline__ void xcd_barrier(const XcdBarrier& b, int wv) {
    asm volatile("s_waitcnt vmcnt(0)" ::: "memory");
    __syncthreads();
    if (tid_of(wv) == 0) {
        unsigned* bar = b.bar;
        __builtin_amdgcn_s_waitcnt(0);
        unsigned nloc = b.st[0], nx = b.st[1];
        if (nloc == 0u) { xcd_barrier_complete(bar, b.x, nloc, nx); b.st[0] = nloc; b.st[1] = nx; }
        const unsigned old = xb_add(&bar[XB_XSUB(b.x)], 1u);
        const unsigned gen = old / nloc;
        if (old + 1u == (gen + 1u) * nloc) {
            __builtin_amdgcn_fence(__ATOMIC_RELEASE, "agent");
            asm volatile("s_waitcnt vmcnt(0)" ::: "memory");
            const unsigned og = xb_add(&bar[XB_TOP], 1u);
            const unsigned tg = og / nx;
            if (og + 1u == (tg + 1u) * nx) xb_add(&bar[XB_TOPGEN], 1u);
            else XB_SPIN(xb_ld(&bar[XB_TOPGEN]) == tg, bar);
            __builtin_amdgcn_fence(__ATOMIC_ACQUIRE, "agent");
            xb_add(&bar[XB_XGEN(b.x)], 1u);
            asm volatile("s_waitcnt vmcnt(0)" ::: "memory");
        } else {
            XB_SPIN(xb_ld(&bar[XB_XGEN(b.x)]) == gen, bar);
            __builtin_amdgcn_fence(__ATOMIC_ACQUIRE, "agent");
            asm volatile("s_waitcnt vmcnt(0)" ::: "memory");
        }
    }
    __syncthreads();
}

constexpr int RING_BYTES = 131072, MISC_OFF = RING_BYTES, LDS_BYTES = 147456;

__device__ __forceinline__ int srccol(int cmode, int nd) {
    if (cmode == 0) return nd;
    if (cmode == 1) {
        if (nd < 2880) return nd;
        if (nd < 2944) return 4936 + (nd - 2880);
        if (nd < 4480) return 2888 + (nd - 2944);
        if (nd < 4992) return 4424 + (nd - 4480);
        if (nd < 5000) return 2880 + (nd - 4992);
        if (nd < 5120) return -1;
        return 5000 + (nd - 5120);
    }
    const int p = nd >> 8, j = nd & 255;
    return (j < 128) ? (128 * p + j) : (DFF + 128 * p + (j - 128));
}
__device__ __forceinline__ void tr_item(const float* W, int ldw, int K, bf16_t* WT, int cmode, const float* gain, LAS float* scr, int item, int nblk, int lane) {
    const int kb = item / nblk, nb = item % nblk, k0 = 64 * kb, n0 = 32 * nb;
    const int sc = srccol(cmode, n0 + (lane & 31));
    float v[32];
    const float* wp = W + (size_t)(k0 + (lane >> 5)) * ldw + (sc >= 0 ? sc : 0);
#pragma unroll
    for (int i = 0; i < 32; ++i) v[i] = __builtin_nontemporal_load(wp + (size_t)(2 * i) * ldw);
    if (gain) {
        const float* gp = gain + k0 + (lane >> 5);
#pragma unroll
        for (int i = 0; i < 32; ++i) v[i] *= gp[2 * i];
    }
    if (sc < 0) {
#pragma unroll
        for (int i = 0; i < 32; ++i) v[i] = 0.f;
    }
#pragma unroll
    for (int i = 0; i < 32; ++i) scr[(2 * i + (lane >> 5)) * 33 + (lane & 31)] = v[i];
    LDS_WAIT(); asm volatile("" ::: "memory");
    const int c = lane & 7;
#pragma unroll
    for (int j = 0; j < 4; ++j) { const int n = (lane >> 3) + 8 * j; const LAS float* s = scr + (8 * c) * 33 + n;
        u32x4 o; o.x = pk2(s[0 * 33], s[1 * 33]); o.y = pk2(s[2 * 33], s[3 * 33]); o.z = pk2(s[4 * 33], s[5 * 33]); o.w = pk2(s[6 * 33], s[7 * 33]);
        *(u32x4*)(WT + (size_t)(n0 + n) * K + k0 + 8 * c) = o; }
    LDS_WAIT(); asm volatile("" ::: "memory");
}
__device__ __forceinline__ void trb_item(const bf16_t* src, int lds_, bf16_t* dst, int ldd, LAS unsigned short* scr, int lane) {
#pragma unroll
    for (int i = 0; i < 8; ++i) {
        const int id = lane + 64 * i, row = id >> 3, cc = id & 7;
        const u32x4 w = *(const u32x4*)(src + (size_t)row * lds_ + 8 * cc);
        LAS unsigned* d = (LAS unsigned*)(scr + row * 66 + 8 * cc);
        d[0] = w.x; d[1] = w.y; d[2] = w.z; d[3] = w.w;
    }
    LDS_WAIT(); asm volatile("" ::: "memory");
#pragma unroll
    for (int i = 0; i < 8; ++i) {
        const int id = lane + 64 * i, c = id >> 3, tc = id & 7;
        const LAS unsigned short* s = scr + (8 * tc) * 66 + c;
        u32x4 o;
        o.x = (unsigned)s[0] | ((unsigned)s[66] << 16); o.y = (unsigned)s[2 * 66] | ((unsigned)s[3 * 66] << 16);
        o.z = (unsigned)s[4 * 66] | ((unsigned)s[5 * 66] << 16); o.w = (unsigned)s[6 * 66] | ((unsigned)s[7 * 66] << 16);
        *(u32x4*)(dst + (size_t)c * ldd + 8 * tc) = o;
    }
    LDS_WAIT(); asm volatile("" ::: "memory");
}

__device__ __forceinline__ float inv_freq(int fi, int rot) { return exp2f(-((float)fi * 2.0f / (float)rot) * LOG2_THETA); }
template <int HD, int ROT, bool NORM>
__device__ __forceinline__ void pp_chunk(u32x4 xin, bf16_t* dst, int ci, bool act, const float* gain, const LAS float* tab, float oscale) {
    float x[8]; unpack8(xin, x);
    if (NORM) {
        float ss = 0.f;
#pragma unroll
        for (int j = 0; j < 8; ++j) ss += x[j] * x[j];
        if (HD == 512) ss = wave_sum_dpp(ss);
        else { ss += dppf<0xB1>(ss); ss += dppf<0x4E>(ss); ss += dppf<0x141>(ss); if (HD == 128) ss += dppf<0x140>(ss); }
        const float r = 1.0f / sqrtf(ss * (1.f / HD) + NORM_EPS);
#pragma unroll
        for (int j = 0; j < 8; ++j) x[j] = x[j] * r * gain[8 * ci + j];
    }
    if (ROT > 0) {
        float oth[8];
#pragma unroll
        for (int j = 0; j < 8; ++j) oth[j] = swz_xor<(ROT / 16)>(x[j]);
        if (ci < ROT / 8) {
            const bool first = ci < ROT / 16;
#pragma unroll
            for (int j = 0; j < 8; ++j) {
                const int fi = 8 * (ci & (ROT / 16 - 1)) + j;
                const float cs = tab[fi], sn = tab[64 + fi];
                x[j] = first ? (x[j] * cs - oth[j] * sn) : (x[j] * cs + oth[j] * sn);
            }
        }
    }
#pragma unroll
    for (int j = 0; j < 8; ++j) x[j] *= oscale;
    if (act) *(u32x4*)dst = pack8(x);
}
__device__ __forceinline__ void pp_head192(u32x4 a0, u32x4 a1, u32x4 a2, bf16_t* d, int ci, const float* gain, const LAS float* tab, float oscale) {
    float x0[8], x1[8], x2[8];
    unpack8(a0, x0); unpack8(a1, x1); unpack8(a2, x2);
    float ss = 0.f;
#pragma unroll
    for (int j = 0; j < 8; ++j) ss += x0[j] * x0[j] + x1[j] * x1[j] + x2[j] * x2[j];
    ss += dppf<0xB1>(ss); ss += dppf<0x4E>(ss); ss += dppf<0x141>(ss);
    const float r = 1.0f / sqrtf(ss * (1.f / 192.f) + NORM_EPS);
#pragma unroll
    for (int j = 0; j < 8; ++j) { x0[j] = x0[j] * r * gain[8 * ci + j]; x1[j] = x1[j] * r * gain[64 + 8 * ci + j]; x2[j] = x2[j] * r * gain[128 + 8 * ci + j]; }
    float oth[8];
#pragma unroll
    for (int j = 0; j < 8; ++j) oth[j] = swz_xor<4>(x0[j]);
    const bool first = ci < 4;
#pragma unroll
    for (int j = 0; j < 8; ++j) {
        const int fi = 8 * (ci & 3) + j;
        const float cs = tab[fi], sn = tab[64 + fi];
        x0[j] = first ? (x0[j] * cs - oth[j] * sn) : (x0[j] * cs + oth[j] * sn);
    }
#pragma unroll
    for (int j = 0; j < 8; ++j) { x0[j] *= oscale; x1[j] *= oscale; x2[j] *= oscale; }
    *(u32x4*)(d + 8 * ci) = pack8(x0); *(u32x4*)(d + 64 + 8 * ci) = pack8(x1); *(u32x4*)(d + 128 + 8 * ci) = pack8(x2);
}
__device__ __forceinline__ void rope_table(LAS float* tab, float pos, int lane) {
    int rot = 64, fi = lane - 24;
    if (lane < 8) { rot = 16; fi = lane; } else if (lane < 24) { rot = 32; fi = lane - 8; }
    if (fi > 31) fi = 31;
    float sn, cs; sincosf(pos * inv_freq(fi, rot), &sn, &cs);
    tab[lane] = cs; tab[64 + lane] = sn;
    LDS_WAIT(); asm volatile("" ::: "memory");
}

__device__ __forceinline__ int pi32(int r) { return (r & ~12) | ((r & 4) << 1) | ((r & 8) >> 1); }
template <int DQK>
__device__ __forceinline__ void attn_unit(LAS unsigned char* lds, const bf16_t* Q, int ldq, const bf16_t* K, int ldk, const bf16_t* VT, int qb,
                                          float* of32, int ldo32, bf16_t* obf, int ldo, int wv) {
    constexpr int KS = DQK * 2 + 16, VS = 144, KBYTES = 64 * KS, BUF = KBYTES + 128 * VS, NDS = DQK / 16, CPR = DQK / 8, NKC = 64 * CPR / 512;
    const int tid = tid_of(wv);
    const int lane = tid & 63, w = wv, qi = lane & 31, hh = lane >> 5;
    const int q0 = qb * 256 + w * 32, NT = 4 * qb + 4, ntw = (q0 + 31) / 64 + 1;
    bf16x8 qf[NDS];
#pragma unroll
    for (int ds = 0; ds < NDS; ++ds) qf[ds] = *(const bf16x8*)(Q + (size_t)(q0 + qi) * ldq + 16 * ds + 8 * hh);
    f32x16 o[4];
#pragma unroll
    for (int d = 0; d < 4; ++d)
#pragma unroll
        for (int r = 0; r < 16; ++r) o[d][r] = 0.f;
    float mrun = -INFINITY, lsum = 0.f;
    u32x4 kst[NKC], vst[2];
    int krow[NKC], kcc[NKC];
#pragma unroll
    for (int i = 0; i < NKC; ++i) { const int id = tid + 512 * i; krow[i] = id / CPR; kcc[i] = id % CPR; }
    const int vd0 = tid >> 3, vcc = tid & 7;
#define ATT_LOAD(kt) do { _Pragma("unroll") for (int i = 0; i < NKC; ++i) kst[i] = *(const u32x4*)(K + (size_t)(64 * (kt) + krow[i]) * ldk + 8 * kcc[i]); \
        _Pragma("unroll") for (int i = 0; i < 2; ++i) vst[i] = *(const u32x4*)(VT + (size_t)(vd0 + 64 * i) * SEQ + 64 * (kt) + 8 * vcc); } while (0)
#define ATT_WRITE(b) do { LAS unsigned char* base = lds + (b) * BUF; \
        _Pragma("unroll") for (int i = 0; i < NKC; ++i) *(LAS u32x4*)(base + krow[i] * KS + 16 * kcc[i]) = kst[i]; \
        _Pragma("unroll") for (int i = 0; i < 2; ++i) *(LAS u32x4*)(base + KBYTES + (vd0 + 64 * i) * VS + 16 * vcc) = vst[i]; } while (0)
    ATT_LOAD(0); ATT_WRITE(0);
    __syncthreads();
    const int kro = pi32(qi) * KS + 16 * hh;
    const int vro = KBYTES + qi * VS + 16 * hh;
    for (int kt = 0; kt < NT; ++kt) {
        const bool more = (kt + 1 < NT);
        if (more) ATT_LOAD(kt + 1);
        if (kt < ntw) {
            const LAS unsigned char* base = lds + (kt & 1) * BUF;
#pragma unroll
            for (int kb = 0; kb < 2; ++kb) {
                f32x16 s;
#pragma unroll
                for (int r = 0; r < 16; ++r) s[r] = 0.f;
#pragma unroll
                for (int ds = 0; ds < NDS; ++ds) {
                    const bf16x8 kf = *(const LAS bf16x8*)(base + kro + kb * 32 * KS + ds * 32);
                    s = __builtin_amdgcn_mfma_f32_32x32x16_bf16(kf, qf[ds], s, 0, 0, 0);
                }
                const int kbase = 64 * kt + 32 * kb;
                if (kbase + 31 > q0) {
                    const int qq = q0 + qi;
#pragma unroll
                    for (int r = 0; r < 16; ++r) { const int key = kbase + (r & 7) + 8 * hh + 16 * (r >> 3); if (key > qq) s[r] = -INFINITY; }
                }
                float mx = s[0];
#pragma unroll
                for (int r = 1; r < 16; ++r) mx = fmaxf(mx, s[r]);
                mx = xhalf_max(mx);
                if (__builtin_amdgcn_ballot_w64(mx > mrun + 8.f) != 0ull) {
                    const float mnew = fmaxf(mrun, mx);
                    const float alpha = fexp2(mrun - mnew);
                    mrun = mnew;
                    lsum *= alpha;
#pragma unroll
                    for (int d = 0; d < 4; ++d)
#pragma unroll
                        for (int r = 0; r < 16; ++r) o[d][r] *= alpha;
                }
                float ps = 0.f;
#pragma unroll
                for (int r = 0; r < 16; ++r) { s[r] = fexp2(s[r] - mrun); ps += s[r]; }
                lsum += ps;
                __builtin_amdgcn_iglp_opt(0);
                bf16x8 pf[2];
#pragma unroll
                for (int s2 = 0; s2 < 2; ++s2) {
                    u32x4 pw; pw.x = cvt_pk_bf16(s[8 * s2 + 0], s[8 * s2 + 1]); pw.y = cvt_pk_bf16(s[8 * s2 + 2], s[8 * s2 + 3]);
                    pw.z = cvt_pk_bf16(s[8 * s2 + 4], s[8 * s2 + 5]); pw.w = cvt_pk_bf16(s[8 * s2 + 6], s[8 * s2 + 7]);
                    pf[s2] = __builtin_bit_cast(bf16x8, pw);
                }
#pragma unroll
                for (int d = 0; d < 4; ++d)
#pragma unroll
                    for (int s2 = 0; s2 < 2; ++s2) {
                        const bf16x8 vf = *(const LAS bf16x8*)(base + vro + d * 32 * VS + (32 * kb + 16 * s2) * 2);
                        o[d] = __builtin_amdgcn_mfma_f32_32x32x16_bf16(vf, pf[s2], o[d], 0, 0, 0);
                    }
            }
        }
        if (more) ATT_WRITE((kt + 1) & 1);
        __syncthreads();
    }
#undef ATT_LOAD
#undef ATT_WRITE
    const float l = xhalf_sum(lsum);
    const float inv = 1.f / l;
    const size_t row = (size_t)(q0 + qi);
#pragma unroll
    for (int d = 0; d < 4; ++d)
#pragma unroll
        for (int g = 0; g < 4; ++g) {
            const int dim = 32 * d + 8 * g + 4 * hh;
            const float v0 = o[d][4 * g] * inv, v1 = o[d][4 * g + 1] * inv, v2 = o[d][4 * g + 2] * inv, v3 = o[d][4 * g + 3] * inv;
            if (of32) *(f32x4*)(of32 + row * ldo32 + dim) = (f32x4){v0, v1, v2, v3};
            else { u32x2 wv; wv.x = cvt_pk_bf16(v0, v1); wv.y = cvt_pk_bf16(v2, v3); *(u32x2*)(obf + row * ldo + dim) = wv; }
        }
}

__device__ __forceinline__ unsigned fkey(float f) { const unsigned u = __builtin_bit_cast(unsigned, f); return (u & 0x80000000u) ? ~u : (u | 0x80000000u); }
template <int NR>
__device__ __forceinline__ void topk_select(const float* sc, int t, LAS unsigned short* sel, int lane) {
    unsigned key[NR];
    const float* scl = sc + lane;
#pragma unroll
    for (int i = 0; i < NR; ++i) { const int e = 64 * i + lane; const unsigned kv = fkey(scl[64 * i]); key[i] = kv & (unsigned)((e - t - 1) >> 31); }
    unsigned thr = 0u;
    for (int b = 31; b >= 0; --b) {
        const unsigned cand = thr | (1u << b);
        int c = 0;
#pragma unroll
        for (int i = 0; i < NR; ++i) c += __popcll(__ballot(key[i] >= cand));
        if (c >= 256) thr = cand;
        if (c == 256) break;
    }
    int cgt = 0;
    unsigned thr1 = thr + 1u; asm volatile("" : "+v"(thr1));
#pragma unroll
    for (int i = 0; i < NR; ++i) cgt += __popcll(__ballot(key[i] >= thr1));
    const int need = 256 - cgt;
    int base = 0, eqbase = 0;
#pragma unroll
    for (int i = 0; i < NR; ++i) {
        const bool gt = key[i] > thr, eq = key[i] == thr;
        const unsigned long long em = __ballot(eq);
        const int erank = eqbase + (int)__builtin_amdgcn_mbcnt_hi((unsigned)(em >> 32), __builtin_amdgcn_mbcnt_lo((unsigned)em, 0u));
        const bool take = gt || (eq && erank < need);
        const unsigned long long tm = __ballot(take);
        const int pos = base + (int)__builtin_amdgcn_mbcnt_hi((unsigned)(tm >> 32), __builtin_amdgcn_mbcnt_lo((unsigned)tm, 0u));
        if (take) sel[pos & 255] = (unsigned short)(64 * i + lane);
        base += __popcll(tm); eqbase += __popcll(em);
        __builtin_amdgcn_sched_barrier(0);
    }
}

__device__ __forceinline__ unsigned lo16(unsigned x) { return __builtin_amdgcn_ubfe(x, 0u, 16u); }
__device__ __forceinline__ int row_sum16(int x) {
    x += __builtin_amdgcn_update_dpp(0, x, 0xB1, 0xf, 0xf, false);
    x += __builtin_amdgcn_update_dpp(0, x, 0x4E, 0xf, 0xf, false);
    x += __builtin_amdgcn_update_dpp(0, x, 0x141, 0xf, 0xf, false);
    x += __builtin_amdgcn_update_dpp(0, x, 0x140, 0xf, 0xf, false);
    return x;
}
__device__ __forceinline__ int wave_total(int x) {
    x = row_sum16(x);
    return __builtin_amdgcn_readlane(x, 0) + __builtin_amdgcn_readlane(x, 16) + __builtin_amdgcn_readlane(x, 32) + __builtin_amdgcn_readlane(x, 48);
}
__device__ __forceinline__ unsigned pk_cnt(unsigned acc, unsigned R, unsigned C, unsigned ONE) {
    unsigned d, f;
    asm("v_pk_sub_u16 %0, %1, %2 clamp" : "=v"(d) : "v"(R), "s"(C));
    asm("v_pk_min_u16 %0, %1, %2" : "=v"(f) : "v"(d), "s"(ONE));
    asm("v_pk_add_u16 %0, %0, %1" : "+v"(acc) : "v"(f));
    return acc;
}
template <int NR2>
__device__ __forceinline__ void topk_select16(const unsigned* sc16, const float* sc32, int t, LAS unsigned short* sel, LAS unsigned short* bl, int lane) {
    unsigned R[NR2];
    const unsigned* p16 = sc16 + lane;
#pragma unroll
    for (int i = 0; i < NR2; ++i) {
        const int e0 = 128 * i + 2 * lane;
        const unsigned m = lo16((unsigned)((e0 - t - 1) >> 31)) | ((unsigned)((e0 - t) >> 31) << 16);
        R[i] = p16[64 * i] & m;
    }
    const unsigned ONE = 0x00010001u;
    unsigned thr = 0u;
#pragma unroll 1
    for (int b = 15; b >= 0; --b) {
        const unsigned cand = thr | (1u << b), cm1 = cand - 1u, C = cm1 | (cm1 << 16);
        unsigned acc = 0u;
#pragma unroll
        for (int i = 0; i < NR2; ++i) acc = pk_cnt(acc, R[i], C, ONE);
        const int c = wave_total((int)(lo16(acc) + (acc >> 16)));
        if (c >= 256) thr = cand;
        if (c == 256) break;
    }
    unsigned ag = 0u, ae = 0u;
    {
        const unsigned Cg = thr | (thr << 16), tm1 = thr - 1u, Ce = tm1 | (tm1 << 16);
#pragma unroll
        for (int i = 0; i < NR2; ++i) { ag = pk_cnt(ag, R[i], Cg, ONE); ae = pk_cnt(ae, R[i], Ce, ONE); }
    }
    const int cg_l = (int)(lo16(ag) + (ag >> 16)), ce_l = (int)(lo16(ae) + (ae >> 16)) - cg_l;
    int sc = cg_l | (ce_l << 16);
    const int mine = sc;
    sc += __builtin_amdgcn_update_dpp(0, sc, 0x111, 0xf, 0xf, false);
    sc += __builtin_amdgcn_update_dpp(0, sc, 0x112, 0xf, 0xf, false);
    sc += __builtin_amdgcn_update_dpp(0, sc, 0x114, 0xf, 0xf, false);
    sc += __builtin_amdgcn_update_dpp(0, sc, 0x118, 0xf, 0xf, false);
    const int r0 = __builtin_amdgcn_readlane(sc, 15), r1 = __builtin_amdgcn_readlane(sc, 31), r2 = __builtin_amdgcn_readlane(sc, 47), r3 = __builtin_amdgcn_readlane(sc, 63);
    const int rowi = lane >> 4;
    sc += (rowi > 0 ? r0 : 0) + (rowi > 1 ? r1 : 0) + (rowi > 2 ? r2 : 0);
    const int tot = r0 + r1 + r2 + r3;
    const int cgt = (int)lo16((unsigned)tot), meq = tot >> 16, need = 256 - cgt;
    sc -= mine;
    int og = (int)lo16((unsigned)sc), oe = sc >> 16;
#pragma unroll
    for (int i = 0; i < NR2; ++i) {
        const int e0 = 128 * i + 2 * lane;
        const unsigned lo = lo16(R[i]), hi = R[i] >> 16;
        if (lo > thr) { sel[og & 255] = (unsigned short)e0; ++og; }
        else if (lo == thr) { if (oe < 256) bl[oe] = (unsigned short)e0; ++oe; }
        if (hi > thr) { sel[og & 255] = (unsigned short)(e0 + 1); ++og; }
        else if (hi == thr) { if (oe < 256) bl[oe] = (unsigned short)(e0 + 1); ++oe; }
    }
    LDS_WAIT(); asm volatile("" ::: "memory");
    const int mc = meq < 256 ? meq : 256;
    unsigned v[4]; int vi[4];
#pragma unroll
    for (int r = 0; r < 4; ++r) {
        const int ci = lane + 64 * r;
        const int idx = (int)bl[ci < mc ? ci : mc - 1];
        const unsigned k32 = fkey(sc32[idx]);
        vi[r] = idx;
        v[r] = (ci < mc) ? (((lo16(k32) << 13) | (unsigned)(8191 - idx)) + 1u) : 0u;
    }
    unsigned tv = 1u;
    if (mc != need) {
        tv = 0u;
#pragma unroll 1
        for (int b = 29; b >= 0; --b) {
            const unsigned cand = tv | (1u << b);
            int c = 0;
#pragma unroll
            for (int r = 0; r < 4; ++r) c += __popcll(__ballot(v[r] >= cand));
            if (c >= need) tv = cand;
            if (c == need) break;
        }
    }
    int base = cgt;
#pragma unroll
    for (int r = 0; r < 4; ++r) {
        const bool take = v[r] >= tv;
        const unsigned long long tm = __ballot(take);
        const int pos = base + (int)__builtin_amdgcn_mbcnt_hi((unsigned)(tm >> 32), __builtin_amdgcn_mbcnt_lo((unsigned)tm, 0u));
        if (take) sel[pos & 255] = (unsigned short)vi[r];
        base += __popcll(tm);
    }
}

template <int MODE>
__device__ __forceinline__ void dsa_item(LAS unsigned char* lds, const bf16_t* P, const bf16_t* IKC, float* scr, unsigned short* scr16, bf16_t* AOb, int t0, int wv) {
    const int tid = tid_of(wv);
    const int lane = tid & 63, w = wv; (void)tid;
    const bool need_sel = (t0 >= 256);
    if (need_sel && (MODE & 1)) {
        const int g = w & 3, c = lane & 31, hh = lane >> 5;
        const int nkb = (t0 + 16 + 31) / 32;
        const int qiA = 2 * ((c >> 2) & 1) + (c >> 4), hdA = 4 * ((c >> 3) & 1) + (c & 3);
        bf16x8 af[4];
#pragma unroll
        for (int ds = 0; ds < 4; ++ds) af[ds] = *(const bf16x8*)(P + (size_t)(t0 + 4 * g + qiA) * NIN + C_IQ + hdA * 64 + 16 * ds + 8 * hh);
        float wq[2][8];
#pragma unroll
        for (int qq = 0; qq < 2; ++qq) {
            float tmp[8]; unpack8(*(const u32x4*)(P + (size_t)(t0 + 4 * g + 2 * hh + qq) * NIN + C_IW), tmp);
#pragma unroll
            for (int h = 0; h < 8; ++h) wq[qq][h] = tmp[h] * 0.044194173824159216f;
        }
        const bf16_t* ikp = IKC + (size_t)lane * 8;
        bf16x8 bc[4], bn[4], bm[4];
        const int kbw = (w >> 2);
        {
            const int kb1 = min(kbw + 2, nkb - 1);
#pragma unroll
            for (int ds = 0; ds < 4; ++ds) { bc[ds] = *(const bf16x8*)(ikp + (size_t)kbw * 2048 + 512 * ds); bn[ds] = *(const bf16x8*)(ikp + (size_t)kb1 * 2048 + 512 * ds); }
        }
#pragma unroll 1
        for (int kc = kbw; kc < nkb; kc += 16) {
            float ra[8][2];
#pragma unroll
            for (int i = 0; i < 8; ++i) {
                const int kn = min(kc + 2 * i + 4, nkb - 1);
#pragma unroll
                for (int ds = 0; ds < 4; ++ds) bm[ds] = *(const bf16x8*)(ikp + (size_t)kn * 2048 + 512 * ds);
                f32x16 s;
#pragma unroll
                for (int r = 0; r < 16; ++r) s[r] = 0.f;
#pragma unroll
                for (int ds = 0; ds < 4; ++ds) s = __builtin_amdgcn_mfma_f32_32x32x16_bf16(af[ds], bc[ds], s, 0, 0, 0);
#pragma unroll
                for (int qq = 0; qq < 2; ++qq) {
                    float a = 0.f;
#pragma unroll
                    for (int h = 0; h < 8; ++h) a += wq[qq][h] * fmaxf(s[8 * qq + h], 0.f);
                    ra[i][qq] = a;
                }
#pragma unroll
                for (int ds = 0; ds < 4; ++ds) { bc[ds] = bn[ds]; bn[ds] = bm[ds]; }
            }
#pragma unroll
            for (int i = 0; i < 8; ++i) {
                const int kb = kc + 2 * i;
                if (kb < nkb) {
#pragma unroll
                    for (int qq = 0; qq < 2; ++qq) {
                        const size_t o = (size_t)(4 * g + 2 * hh + qq) * SEQ + 32 * kb + c;
                        scr[o] = ra[i][qq];
                        scr16[o] = (unsigned short)(fkey(ra[i][qq]) >> 16);
                    }
                }
            }
        }
    }
    __syncthreads();
    LAS unsigned char* wl = lds + w * 8192;
    LAS float* pl = (LAS float*)wl;
    LAS unsigned short* sel = (LAS unsigned short*)(wl + 4096);
    LAS unsigned short* bl = (LAS unsigned short*)(wl + 4096 + 512);
    typedef float f32x4_t __attribute__((ext_vector_type(4)));
    const int n16 = lane & 15, g4 = lane >> 4;
#pragma unroll 1
    for (int qq = 0; qq < 2; ++qq) {
        const int ql = 2 * w + qq, t = t0 + ql;
        int nsel;
        if (need_sel && (MODE & 2)) {
            const float* sc = scr + (size_t)ql * SEQ;
            const unsigned* sc16 = (const unsigned*)(scr16 + (size_t)ql * SEQ);
            const int nr2 = (t >> 7) + 1;
            if (nr2 <= 16) topk_select16<16>(sc16, sc, t, sel, bl, lane);
            else if (nr2 <= 32) topk_select16<32>(sc16, sc, t, sel, bl, lane);
            else if (nr2 <= 48) topk_select16<48>(sc16, sc, t, sel, bl, lane);
            else topk_select16<64>(sc16, sc, t, sel, bl, lane);
            nsel = 256;
        } else {
            nsel = t + 1;
#pragma unroll
            for (int i = 0; i < 4; ++i) sel[lane + 64 * i] = (unsigned short)(lane + 64 * i);
        }
        if (!(MODE & 4)) { if (lane == 0) AOb[(size_t)t * DM] = sel[17]; continue; }
        LDS_WAIT(); asm volatile("" ::: "memory");
        bf16x8 qa[4];
#pragma unroll
        for (int ks = 0; ks < 4; ++ks) qa[ks] = *(const bf16x8*)(P + (size_t)t * NIN + C_BQ + (n16 & 3) * 128 + 32 * ks + 8 * g4);
        float sl[4][4];
#pragma unroll
        for (int i = 0; i < 4; ++i)
#pragma unroll
            for (int h = 0; h < 4; ++h) sl[i][h] = 0.f;
#pragma unroll
        for (int kb = 0; kb < 16; ++kb) {
            const int idx = (int)sel[16 * kb + n16];
            const bf16_t* kr = P + (size_t)idx * NIN + C_BK + 8 * g4;
            bf16x8 kf[4];
#pragma unroll
            for (int ks = 0; ks < 4; ++ks) kf[ks] = *(const bf16x8*)(kr + 32 * ks);
            f32x4 acc = (f32x4){0.f, 0.f, 0.f, 0.f};
#pragma unroll
            for (int ks = 0; ks < 4; ++ks) acc = __builtin_amdgcn_mfma_f32_16x16x32_bf16(qa[ks], kf[ks], acc, 0, 0, 0);
            const bool mine = (g4 == (kb & 3));
#pragma unroll
            for (int h = 0; h < 4; ++h) sl[kb >> 2][h] = mine ? acc[h] : sl[kb >> 2][h];
            if ((kb & 3) == 3) __builtin_amdgcn_sched_barrier(0);
        }
        float linv[4];
#pragma unroll
        for (int i = 0; i < 4; ++i) {
            const bool val = (16 * (4 * i + g4) + n16) < nsel;
#pragma unroll
            for (int h = 0; h < 4; ++h) sl[i][h] = val ? sl[i][h] : -INFINITY;
        }
#pragma unroll
        for (int h = 0; h < 4; ++h) {
            float mx = fmaxf(fmaxf(sl[0][h], sl[1][h]), fmaxf(sl[2][h], sl[3][h]));
            mx = wave_max_dpp(mx);
            float ps = 0.f;
#pragma unroll
            for (int i = 0; i < 4; ++i) { sl[i][h] = fexp2(sl[i][h] - mx); ps += sl[i][h]; }
            ps = wave_sum_dpp(ps);
            linv[h] = 1.f / ps;
        }
#pragma unroll
        for (int i = 0; i < 4; ++i) *(LAS f32x4*)(pl + 4 * (16 * (4 * i + g4) + n16)) = (f32x4){sl[i][0], sl[i][1], sl[i][2], sl[i][3]};
        LDS_WAIT(); asm volatile("" ::: "memory");
        typedef float f32x2_t __attribute__((ext_vector_type(2)));
        f32x2_t oacc[4][4];
#pragma unroll
        for (int h = 0; h < 4; ++h)
#pragma unroll
            for (int d = 0; d < 4; ++d) oacc[h][d] = (f32x2_t){0.f, 0.f};
        const bf16_t* vb = P + C_BV + 8 * n16;
        const int nj = (nsel + 15) & ~15;
        u32x4 vw[4], vn[4];
#pragma unroll
        for (int u = 0; u < 4; ++u) vw[u] = *(const u32x4*)(vb + (size_t)((int)sel[4 * u + g4]) * NIN);
#pragma unroll 1
        for (int j0 = 0; j0 < nj; j0 += 16) {
            const int jn = (j0 + 16 < nj) ? j0 + 16 : j0;
#pragma unroll
            for (int u = 0; u < 4; ++u) vn[u] = *(const u32x4*)(vb + (size_t)((int)sel[jn + 4 * u + g4]) * NIN);
#pragma unroll
            for (int u = 0; u < 4; ++u) {
                const f32x4 pq = *(const LAS f32x4*)(pl + 4 * (j0 + 4 * u + g4));
                float vx[8]; unpack8(vw[u], vx);
#pragma unroll
                for (int h = 0; h < 4; ++h)
#pragma unroll
                    for (int d = 0; d < 4; ++d) oacc[h][d] += (f32x2_t){vx[2 * d], vx[2 * d + 1]} * pq[h];
            }
#pragma unroll
            for (int u = 0; u < 4; ++u) vw[u] = vn[u];
        }
#pragma unroll
        for (int h = 0; h < 4; ++h) {
            float r[8];
#pragma unroll
            for (int d = 0; d < 4; ++d) {
                float a0 = oacc[h][d].x, a1 = oacc[h][d].y;
                a0 += swz_xor<16>(a0); a1 += swz_xor<16>(a1);
                a0 = xhalf_sum(a0); a1 = xhalf_sum(a1);
                r[2 * d] = a0 * linv[h]; r[2 * d + 1] = a1 * linv[h];
            }
            if (g4 == 0) {
                u32x4 w; w.x = cvt_pk_bf16(r[0], r[1]); w.y = cvt_pk_bf16(r[2], r[3]); w.z = cvt_pk_bf16(r[4], r[5]); w.w = cvt_pk_bf16(r[6], r[7]);
                *(u32x4*)(AOb + (size_t)t * DM + h * 128 + 8 * n16) = w;
            }
        }
        LDS_WAIT(); asm volatile("" ::: "memory");
    }
    __syncthreads();
}

struct Args { const float* in[19]; float* out; unsigned char* ws; };
constexpr int TAB_OFF = MISC_OFF + 256;
__device__ __forceinline__ unsigned long long tabp_(LAS unsigned char* lds, int i) {
    volatile LAS unsigned* p = (volatile LAS unsigned*)(lds + TAB_OFF + 8 * i);
    const unsigned lo = __builtin_amdgcn_readfirstlane(p[0]), hi = __builtin_amdgcn_readfirstlane(p[1]);
    return ((unsigned long long)hi << 32) | lo;
}
#define tabp(i) tabp_(lds, (i))
#define INP(i) ((const float*)(const GAS float*)tabp(i))
#define WSP(T, off) ((T*)(GAS T*)(tabp(20) + (off)))
#define GRID_BAR() do { XcdBarrier b_; b_.bar = WSP(unsigned, WS_CTL) + CW_BAR; b_.x = xb_xcc_id(); b_.st = (volatile LAS unsigned*)(lds + MISC_OFF) + 8; xcd_barrier(b_, wv); } while (0)

#define PHASE_VARS const int tid = tid_of(wv); const int lane = tid & 63, wave = wv; \
    int bx = blockIdx.x; asm volatile("" : "+s"(bx)); const int GW = bx * 8 + wave, NGW = (int)gridDim.x * 8; LAS float* wscr = (LAS float*)(lds + wave * 8448); \
    (void)lane; (void)GW; (void)NGW; (void)wscr; (void)tid;
template <int L> __device__ __forceinline__ void layer_fwd(LAS unsigned char* lds, const int wv) {

        {
            PHASE_VARS
            constexpr int I_IN = 32 * 352, I_KVB = 8 * 64, I_BR = 32 * 64, I_OUT = 32 * 64, I_GU = 32 * 352, I_DN = 88 * 64;
            constexpr int NITEMS = I_IN + I_KVB + I_BR + I_OUT + I_GU + I_DN;
#pragma unroll 1
            for (int it = GW; it < NITEMS; it += NGW) {
                int r = it;
                if (r < I_IN) { tr_item(INP(2) + (size_t)L * DM * INW, INW, DM, WSP(bf16_t, WS_WIN), 1, INP(1) + (size_t)L * DM, wscr, r, 352, lane); continue; } r -= I_IN;
                if (r < I_KVB) { tr_item(INP(12) + (size_t)L * 512 * 2048, 2048, 512, WSP(bf16_t, WS_WKVB), 0, nullptr, wscr, r, 64, lane); continue; } r -= I_KVB;
                if (r < I_BR) { tr_item(INP(14) + (size_t)L * DM * DM, DM, DM, WSP(bf16_t, WS_WBR), 0, nullptr, wscr, r, 64, lane); continue; } r -= I_BR;
                if (r < I_OUT) { tr_item(INP(15) + (size_t)L * DM * DM, DM, DM, WSP(bf16_t, WS_WOUT), 0, nullptr, wscr, r, 64, lane); continue; } r -= I_OUT;
                if (r < I_GU) { tr_item(INP(17) + (size_t)L * DM * 2 * DFF, 2 * DFF, DM, WSP(bf16_t, WS_WGU), 2, INP(16) + (size_t)L * DM, wscr, r, 352, lane); continue; } r -= I_GU;
                tr_item(INP(18) + (size_t)L * DFF * DM, DM, DFF, WSP(bf16_t, WS_WDN), 0, nullptr, wscr, r, 64, lane);
            }
            if (L == 0) {
                const float* x_in = INP(0); bf16_t* XB = WSP(bf16_t, WS_XB); float* ssq_attn = WSP(float, WS_CTL) + CW_SSQ;
#pragma unroll 1
                for (int t = GW; t < SEQ; t += NGW) {
                    const float* xr = x_in + (size_t)t * DM; float ss = 0.f;
#pragma unroll
                    for (int j = 0; j < 4; ++j) {
                        const int e = 8 * (lane + 64 * j);
                        const f32x4 a = *(const f32x4*)(xr + e), b = *(const f32x4*)(xr + e + 4);
                        ss += a[0] * a[0] + a[1] * a[1] + a[2] * a[2] + a[3] * a[3] + b[0] * b[0] + b[1] * b[1] + b[2] * b[2] + b[3] * b[3];
                        u32x4 wv; wv.x = pk2(a[0], a[1]); wv.y = pk2(a[2], a[3]); wv.z = pk2(b[0], b[1]); wv.w = pk2(b[2], b[3]);
                        *(u32x4*)(XB + (size_t)t * DM + e) = wv;
                    }
                    ss = wave_sum(ss);
                    if (lane == 0) ssq_attn[t] = ss;
                }
            }
        }
        if (L == 0) { asm volatile("s_waitcnt vmcnt(0)" ::: "memory"); __threadfence(); cg::this_grid().sync(); } else GRID_BAR();

        {
            pg8::Gemm g{WSP(bf16_t, WS_XB), WSP(bf16_t, WS_WIN), SEQ, NIN, DM, DM, DM}; pg8::StaticOrder S; { int bx_ = blockIdx.x; asm volatile("" : "+s"(bx_)); S.init(SEQ, NIN, gridDim.x, bx_); }
            pg8::Epi E{}; E.mode = pg8::EPI_INPROJ; E.obf = WSP(bf16_t, WS_P); E.ldo = NIN; E.f1 = WSP(float, WS_CTL) + CW_SSQ + (2 * L) * SEQ;
            pg8::gemm_phase(lds, g, S, E, wv);
        }
        GRID_BAR();

#ifdef PROBE_P1
        {
            pg8::Gemm g{WSP(bf16_t, WS_XB), WSP(bf16_t, WS_WIN), SEQ, NIN, DM, DM, DM}; pg8::StaticOrder S; { int bx_ = blockIdx.x; asm volatile("" : "+s"(bx_)); S.init(SEQ, NIN, gridDim.x, bx_); }
            pg8::Epi E{}; E.mode = pg8::EPI_INPROJ; E.obf = WSP(bf16_t, WS_P); E.ldo = NIN; E.f1 = WSP(float, WS_CTL) + CW_SSQ + (2 * L) * SEQ;
            pg8::gemm_phase(lds, g, S, E, wv);
        }
        GRID_BAR();

#endif
        {
            PHASE_VARS
            bf16_t* P = WSP(bf16_t, WS_P);
#pragma unroll 1
            for (int t = GW; t < SEQ; t += NGW) {
                bf16_t* pr = P + (size_t)t * NIN;
                LAS float* tab = wscr;
                bf16_t* hb = pr + C_CQ + (lane >> 3) * 192; const int c8 = lane & 7;
                const u32x4 l_aq = *(const u32x4*)(pr + C_AQ + 8 * lane), l_ak = *(const u32x4*)(pr + C_AK + 8 * lane), l_bq = *(const u32x4*)(pr + C_BQ + 8 * lane);
                const u32x4 l_bk = *(const u32x4*)(pr + C_BK + 8 * (lane & 15)), l_iq = *(const u32x4*)(pr + C_IQ + 8 * lane), l_ik = *(const u32x4*)(pr + C_IK + 8 * c8);
                const u32x4 l_kv = *(const u32x4*)(pr + C_CKV + 8 * lane);
                const u32x4 l_c0 = *(const u32x4*)(hb + 8 * c8), l_c1 = *(const u32x4*)(hb + 64 + 8 * c8), l_c2 = *(const u32x4*)(hb + 128 + 8 * c8);
                rope_table(tab, (float)t, lane);
                pp_chunk<64, 16, true>(l_aq, pr + C_AQ + 8 * lane, lane & 7, true, INP(3) + L * 64, tab, 0.125f * LOG2E);
                pp_chunk<64, 16, true>(l_ak, pr + C_AK + 8 * lane, lane & 7, true, INP(4) + L * 64, tab, 1.f);
                pp_chunk<128, 32, true>(l_bq, pr + C_BQ + 8 * lane, lane & 15, true, INP(7) + L * 128, tab + 8, 0.08838834764831845f * LOG2E);
                pp_chunk<128, 32, true>(l_bk, pr + C_BK + 8 * (lane & 15), lane & 15, lane < 16, INP(8) + L * 128, tab + 8, 1.f);
                pp_chunk<64, 16, false>(l_iq, pr + C_IQ + 8 * lane, lane & 7, true, nullptr, tab, 1.f);
                pp_chunk<64, 16, true>(l_ik, WSP(bf16_t, WS_IKC) + ((size_t)(((t >> 5) * 4 + (c8 >> 1)) * 64 + (c8 & 1) * 32 + (t & 31))) * 8, c8, lane < 8, INP(9) + L * 64, tab, 1.f);
                pp_chunk<512, 0, true>(l_kv, pr + C_CKV + 8 * lane, lane, true, INP(11) + L * 512, tab, 1.f);
                pp_head192(l_c0, l_c1, l_c2, hb, c8, INP(10) + L * 192, tab + 24, 0.07216878364870323f * LOG2E);
                LDS_WAIT(); asm volatile("" ::: "memory");
            }
            bf16_t* VTA = WSP(bf16_t, WS_VTA);
#pragma unroll 1
            for (int it = GW; it < 128 * 8; it += NGW) {
                const int tb = it >> 3, cb = it & 7;
                trb_item(P + (size_t)(64 * tb) * NIN + C_AV + 64 * cb, NIN, VTA + (size_t)(64 * cb) * SEQ + 64 * tb, SEQ, (LAS unsigned short*)wscr, lane);
            }
        }
        GRID_BAR();

        {
            pg8::Gemm g{WSP(bf16_t, WS_P) + C_CKV, WSP(bf16_t, WS_WKVB), SEQ, 2048, 512, NIN, 512}; pg8::StaticOrder S; { int bx_ = blockIdx.x; asm volatile("" : "+s"(bx_)); S.init(SEQ, 2048, gridDim.x, bx_); }
            pg8::Epi E{}; E.mode = pg8::EPI_PLAIN; E.obf = WSP(bf16_t, WS_KVB); E.ldo = 2048;
            pg8::gemm_phase(lds, g, S, E, wv);
        }
        GRID_BAR();

        {
            PHASE_VARS
            const bf16_t* P = WSP(bf16_t, WS_P); const bf16_t* KVB = WSP(bf16_t, WS_KVB); bf16_t* KC = WSP(bf16_t, WS_KC); bf16_t* VTC = WSP(bf16_t, WS_VTC);
            const float* c_k_norm = INP(13) + L * 192;
#pragma unroll 1
            for (int t = GW; t < SEQ; t += NGW) {
                const int h = lane >> 3, ci = lane & 7;
                const bf16_t* kv = KVB + (size_t)t * 2048 + h * 256;
                const u32x4 a0 = *(const u32x4*)(P + (size_t)t * NIN + C_CKR + 8 * ci), a1 = *(const u32x4*)(kv + 8 * ci), a2 = *(const u32x4*)(kv + 64 + 8 * ci);
                LAS float* tab = wscr;
                rope_table(tab, (float)t, lane);
                pp_head192(a0, a1, a2, KC + (size_t)t * 1536 + h * 192, ci, c_k_norm, tab + 24, 1.f);
                LDS_WAIT(); asm volatile("" ::: "memory");
            }
#pragma unroll 1
            for (int it = GW; it < 128 * 16; it += NGW) {
                const int tb = it >> 4, cb = it & 15, h = cb >> 1, d0 = (cb & 1) * 64;
                trb_item(KVB + (size_t)(64 * tb) * 2048 + h * 256 + 128 + d0, 2048, VTC + (size_t)(h * 128 + d0) * SEQ + 64 * tb, SEQ, (LAS unsigned short*)wscr, lane);
            }
        }
        GRID_BAR();

#define RUN_P5(QSLOT, ITEM_LO, ITEM_HI, DSAMODE) { \
            _Pragma("unroll 1") for (;;) { \
                PHASE_VARS \
                volatile LAS unsigned* MISC = (volatile LAS unsigned*)(lds + MISC_OFF); \
                __syncthreads(); \
                if (tid == 0) MISC[16] = atomicAdd(WSP(unsigned, WS_CTL) + CW_Q + 64 * (QSLOT), 1u); \
                __syncthreads(); \
                const int item = (ITEM_LO) + (int)__builtin_amdgcn_readfirstlane(MISC[16]); \
                if (item >= (ITEM_HI)) break; \
                bf16_t* P = WSP(bf16_t, WS_P); bf16_t* AO = WSP(bf16_t, WS_AO); \
                if (item < 512) { \
                    const int qb = 31 - (item >> 4), j = item & 15; \
                    if (j < 8) attn_unit<192>(lds, P + C_CQ + j * 192, NIN, WSP(bf16_t, WS_KC) + j * 192, 1536, WSP(bf16_t, WS_VTC) + (size_t)j * 128 * SEQ, qb, nullptr, 0, AO + 1024 + j * 128, DM, wv); \
                    else { const int hm = j - 8; attn_unit<64>(lds, P + C_AQ + hm * 64, NIN, P + C_AK + hm * 64, NIN, WSP(bf16_t, WS_VTA) + (size_t)(hm >> 1) * 128 * SEQ, qb, WSP(float, WS_OA32) + hm * 128, 1024, nullptr, 0, wv); } \
                } else { \
                    const int t0 = (511 - (item - 512)) * 16; \
                    dsa_item<DSAMODE>(lds, P, WSP(bf16_t, WS_IKC), WSP(float, WS_SCR) + (size_t)bx * 16 * SEQ, WSP(unsigned short, WS_SCR16) + (size_t)bx * 16 * SEQ, (DSAMODE == 15 ? AO + 512 : WSP(bf16_t, WS_OA32)), t0, wv); \
                } \
            } \
        }
        RUN_P5(L, 0, 1024, 15)
#ifdef PROBE_DENSE
        GRID_BAR();
        RUN_P5(L + 2, 0, 512, 15)
#endif
#ifdef PROBE_P5
        GRID_BAR();
        RUN_P5(L + 6, 0, 1024, 15)
#endif
#ifdef PROBE_DSA
        GRID_BAR();
        RUN_P5(L + 4, 512, 1024, PROBE_DSA)
#endif
        GRID_BAR();

        {
            PHASE_VARS
            const float lam_init = (L == 0) ? 0.2f : (0.8f - 0.6f * 0.7408182206817179f);
            const float* a_lambda = INP(5) + L * 256; const float* a_sub_norm = INP(6) + L * 128;
            const float* OA32 = WSP(float, WS_OA32); bf16_t* AO = WSP(bf16_t, WS_AO);
            float lam;
            { const float a = a_lambda[lane] * a_lambda[64 + lane], b = a_lambda[128 + lane] * a_lambda[192 + lane];
              lam = expf(wave_sum(a)) - expf(wave_sum(b)) + lam_init; }
            const float g0 = a_sub_norm[2 * lane], g1 = a_sub_norm[2 * lane + 1];
#pragma unroll 1
            for (int t = GW; t < SEQ; t += NGW) {
                float a1[4][2], a2[4][2];
#pragma unroll
                for (int h = 0; h < 4; ++h) {
                    const float* o1 = OA32 + (size_t)t * 1024 + (2 * h) * 128 + 2 * lane;
                    a1[h][0] = o1[0]; a1[h][1] = o1[1]; a2[h][0] = o1[128]; a2[h][1] = o1[129];
                }
#pragma unroll
                for (int h = 0; h < 4; ++h) {
                    const float d0 = a1[h][0] - lam * a2[h][0], d1 = a1[h][1] - lam * a2[h][1];
                    const float ss = wave_sum(d0 * d0 + d1 * d1);
                    const float r = (1.0f / sqrtf(ss * (1.f / 128.f) + NORM_EPS)) * (1.f - lam_init);
                    *(unsigned*)(AO + (size_t)t * DM + h * 128 + 2 * lane) = pk2(d0 * r * g0, d1 * r * g1);
                }
            }
        }
        GRID_BAR();

#pragma unroll 1
        for (int br = 0; br < 3; ++br) {
            pg8::StaticOrder S; { int bx_ = blockIdx.x; asm volatile("" : "+s"(bx_)); S.init(SEQ, DM, gridDim.x, bx_); }
            const int ko = (br == 2) ? 1024 : 512 * br;
            pg8::Gemm g{WSP(bf16_t, WS_AO) + ko, WSP(bf16_t, WS_WBR) + ko, SEQ, DM, (br == 2) ? 1024 : 512, DM, DM};
            pg8::Epi E{}; E.mode = pg8::EPI_BR0 + br; E.gate = WSP(bf16_t, WS_P) + C_G + br * DM; E.ldg = NIN; E.f0 = WSP(float, WS_SCR); E.obf = WSP(bf16_t, WS_MG); E.ldo = DM;
            pg8::gemm_phase(lds, g, S, E, wv);
        }
        GRID_BAR();

        {
            pg8::Gemm g{WSP(bf16_t, WS_MG), WSP(bf16_t, WS_WOUT), SEQ, DM, DM, DM, DM}; pg8::StaticOrder S; { int bx_ = blockIdx.x; asm volatile("" : "+s"(bx_)); S.init(SEQ, DM, gridDim.x, bx_); }
            pg8::Epi E{}; E.mode = pg8::EPI_RESID; E.f1 = (L == 0) ? INP(0) : (const float*)(const GAS float*)tabp(19); E.f0 = (float*)(GAS float*)tabp(19); E.obf = WSP(bf16_t, WS_XB); E.ldo = DM;
            E.f2 = WSP(float, WS_CTL) + CW_SSQ + (2 * L + 1) * SEQ;
            pg8::gemm_phase(lds, g, S, E, wv);
        }
        GRID_BAR();

        {
            pg8::Gemm g{WSP(bf16_t, WS_XB), WSP(bf16_t, WS_WGU), SEQ, NGU, DM, DM, DM}; pg8::StaticOrder S; { int bx_ = blockIdx.x; asm volatile("" : "+s"(bx_)); S.init(SEQ, NGU, gridDim.x, bx_); }
            pg8::Epi E{}; E.mode = pg8::EPI_SWIGLU; E.obf = WSP(bf16_t, WS_P); E.ldo = DFF; E.f1 = WSP(float, WS_CTL) + CW_SSQ + (2 * L + 1) * SEQ;
            pg8::gemm_phase(lds, g, S, E, wv);
        }
        GRID_BAR();

#ifdef PROBE_P9
        {
            pg8::Gemm g{WSP(bf16_t, WS_XB), WSP(bf16_t, WS_WGU), SEQ, NGU, DM, DM, DM}; pg8::StaticOrder S; { int bx_ = blockIdx.x; asm volatile("" : "+s"(bx_)); S.init(SEQ, NGU, gridDim.x, bx_); }
            pg8::Epi E{}; E.mode = pg8::EPI_SWIGLU; E.obf = WSP(bf16_t, WS_P); E.ldo = DFF; E.f1 = WSP(float, WS_CTL) + CW_SSQ + (2 * L + 1) * SEQ;
            pg8::gemm_phase(lds, g, S, E, wv);
        }
        GRID_BAR();

#endif
        {
            pg8::Gemm g{WSP(bf16_t, WS_P), WSP(bf16_t, WS_WDN), SEQ, DM, DFF, DFF, DFF}; pg8::StaticOrder S; { int bx_ = blockIdx.x; asm volatile("" : "+s"(bx_)); S.init(SEQ, DM, gridDim.x, bx_); }
            pg8::Epi E{}; E.mode = pg8::EPI_RESID; E.f1 = (const float*)(const GAS float*)tabp(19); E.f0 = (float*)(GAS float*)tabp(19); E.obf = WSP(bf16_t, WS_XB); E.ldo = DM;
            E.f2 = WSP(float, WS_CTL) + CW_SSQ + (2 * L + 2) * SEQ;
            pg8::gemm_phase(lds, g, S, E, wv);
        }
        GRID_BAR();

}

__global__ void __launch_bounds__(512) fwd_kernel(Args args) {
    extern __shared__ __attribute__((aligned(16))) unsigned char lds_raw[];
    LAS unsigned char* lds = (LAS unsigned char*)lds_raw;
    const int wv = __builtin_amdgcn_readfirstlane((int)(threadIdx.x >> 6));
    {
        const int tid = tid_of(wv);
        volatile LAS unsigned* MISC = (volatile LAS unsigned*)(lds + MISC_OFF);
        for (int u = tid; u < 64; u += 512) MISC[u] = 0u;
        if (tid < 21) {
            const unsigned long long v = (tid < 19) ? (unsigned long long)args.in[tid] : (tid == 19 ? (unsigned long long)args.out : (unsigned long long)args.ws);
            volatile LAS unsigned* p = (volatile LAS unsigned*)(lds + TAB_OFF + 8 * tid);
            p[0] = (unsigned)v; p[1] = (unsigned)(v >> 32);
        }
        __syncthreads();
        (void)xcd_barrier_post(WSP(unsigned, WS_CTL) + CW_BAR, MISC + 8);
    }

    layer_fwd<0>(lds, wv);
    layer_fwd<1>(lds, wv);
}

extern "C" void kernel_launch(void* const* d_in, const int* in_sizes, int n_in, void* d_out, int out_size, void* d_ws, size_t ws_size, hipStream_t stream) {
    static int grid = 0;
    if (grid == 0) {
        if (n_in != 19 || ws_size < WS_END) { fprintf(stderr, "kernel_launch: unexpected inputs (n_in %d, ws %zu, need %zu)\n", n_in, ws_size, (size_t)WS_END); grid = -1; return; }
        int dev = 0, cus = 0, per_cu = 0;
        hipGetDevice(&dev);
        hipDeviceGetAttribute(&cus, hipDeviceAttributeMultiprocessorCount, dev);
        hipFuncSetAttribute((const void*)fwd_kernel, hipFuncAttributeMaxDynamicSharedMemorySize, LDS_BYTES);
        hipOccupancyMaxActiveBlocksPerMultiprocessor(&per_cu, (const void*)fwd_kernel, 512, LDS_BYTES);
        (void)hipGetLastError();
        if (per_cu < 1) per_cu = 1;
        grid = cus;
        if (grid > 256) grid = 256;
    }
    if (grid < 0) return;
    hipMemsetAsync((char*)d_ws + WS_CTL, 0, CTL_BYTES, stream);
    Args a{};
    for (int i = 0; i < 19; ++i) a.in[i] = (const float*)d_in[i];
    a.out = (float*)d_out; a.ws = (unsigned char*)d_ws;
    void* kargs[] = {&a};
    hipError_t e = hipLaunchCooperativeKernel((const void*)fwd_kernel, dim3(grid), dim3(512), kargs, LDS_BYTES, stream);
    if (e != hipSuccess) fprintf(stderr, "cooperative launch failed: %s (grid %d)\n", hipGetErrorString(e), grid);
}
```

```cpp
#include <hip/hip_runtime.h>
#include <hip/hip_cooperative_groups.h>
#include <cstdio>
#include <cstdint>
namespace cg = cooperative_groups;

#define GAS __attribute__((address_space(1)))
#define LAS __attribute__((address_space(3)))
typedef unsigned short bf16_t;
typedef short bf16x8 __attribute__((ext_vector_type(8)));
typedef float f32x4 __attribute__((ext_vector_type(4)));
typedef float f32x16 __attribute__((ext_vector_type(16)));
typedef unsigned u32x4 __attribute__((ext_vector_type(4)));
typedef unsigned u32x2 __attribute__((ext_vector_type(2)));

constexpr int SEQ = 8192, DM = 2048, NIN = 11264, DFF = 5632, NGU = 11264, INW = 11144;
constexpr int C_AQ = 0, C_AK = 512, C_AV = 1024, C_BQ = 1536, C_BK = 2048, C_BV = 2176, C_IQ = 2304, C_IK = 2816, C_CKR = 2880,
              C_CQ = 2944, C_CKV = 4480, C_IW = 4992, C_G = 5120;
constexpr float NORM_EPS = 1e-6f;
constexpr float LOG2E = 1.4426950408889634f;
constexpr float LOG2_THETA = 18.931568569324174f;

constexpr size_t MiB = 1u << 20;
constexpr size_t WS_CTL = 0, CTL_BYTES = 1 * MiB;
constexpr size_t WS_WIN = 1 * MiB;
constexpr size_t WS_WKVB = WS_WIN + 44 * MiB;
constexpr size_t WS_WBR = WS_WKVB + 2 * MiB;
constexpr size_t WS_WOUT = WS_WBR + 8 * MiB;
constexpr size_t WS_WGU = WS_WOUT + 8 * MiB;
constexpr size_t WS_WDN = WS_WGU + 44 * MiB;
constexpr size_t WS_P = WS_WDN + 22 * MiB;
constexpr size_t WS_XB = WS_P + 176 * MiB;
constexpr size_t WS_AO = WS_XB + 32 * MiB;
constexpr size_t WS_KC = WS_AO + 32 * MiB;
constexpr size_t WS_VTC = WS_KC + 24 * MiB;
constexpr size_t WS_VTA = WS_VTC + 16 * MiB;
constexpr size_t WS_KVB = WS_VTA + 8 * MiB;
constexpr size_t WS_MG = WS_KVB + 32 * MiB;
constexpr size_t WS_OA32 = WS_MG + 32 * MiB;
constexpr size_t WS_SCR = WS_OA32 + 32 * MiB;
constexpr size_t WS_IKC = WS_SCR + 128 * MiB;
constexpr size_t WS_SCR16 = WS_KVB;
constexpr size_t WS_END = WS_IKC + 1 * MiB;
static_assert(WS_END <= 704 * MiB, "workspace");
constexpr int CW_BAR = 4096;
constexpr int CW_Q = 8192;
constexpr int CW_SSQ = 16384;

__device__ __forceinline__ unsigned f2bf(float f) { unsigned u = __builtin_bit_cast(unsigned, f); return (u + 0x7fffu + ((u >> 16) & 1u)) >> 16; }
__device__ __forceinline__ unsigned pk2(float lo, float hi) { return f2bf(lo) | (f2bf(hi) << 16); }
__device__ __forceinline__ float bf2f(unsigned short b) { return __builtin_bit_cast(float, (unsigned)b << 16); }
__device__ __forceinline__ unsigned cvt_pk_bf16(float lo, float hi) { unsigned r; asm volatile("v_cvt_pk_bf16_f32 %0, %1, %2" : "=v"(r) : "v"(lo), "v"(hi)); return r; }
__device__ __forceinline__ void unpack8(u32x4 w, float* x) {
    x[0] = __builtin_bit_cast(float, w.x << 16); x[1] = __builtin_bit_cast(float, w.x & 0xffff0000u);
    x[2] = __builtin_bit_cast(float, w.y << 16); x[3] = __builtin_bit_cast(float, w.y & 0xffff0000u);
    x[4] = __builtin_bit_cast(float, w.z << 16); x[5] = __builtin_bit_cast(float, w.z & 0xffff0000u);
    x[6] = __builtin_bit_cast(float, w.w << 16); x[7] = __builtin_bit_cast(float, w.w & 0xffff0000u);
}
__device__ __forceinline__ u32x4 pack8(const float* x) { u32x4 w; w.x = pk2(x[0], x[1]); w.y = pk2(x[2], x[3]); w.z = pk2(x[4], x[5]); w.w = pk2(x[6], x[7]); return w; }
__device__ __forceinline__ float wave_sum_dpp(float x);
__device__ __forceinline__ float wave_sum(float v) { return wave_sum_dpp(v); }


template <int CTRL> __device__ __forceinline__ float dppf(float x) { return __builtin_bit_cast(float, __builtin_amdgcn_update_dpp(0, __builtin_bit_cast(int, x), CTRL, 0xf, 0xf, false)); }
__device__ __forceinline__ float rdl(float x, int l) { return __builtin_bit_cast(float, __builtin_amdgcn_readlane(__builtin_bit_cast(int, x), l)); }
__device__ __forceinline__ float wave_max_dpp(float x) {
    x = fmaxf(x, dppf<0xB1>(x)); x = fmaxf(x, dppf<0x4E>(x)); x = fmaxf(x, dppf<0x141>(x)); x = fmaxf(x, dppf<0x140>(x));
    return fmaxf(fmaxf(rdl(x, 0), rdl(x, 16)), fmaxf(rdl(x, 32), rdl(x, 48)));
}
__device__ __forceinline__ float wave_sum_dpp(float x) {
    x += dppf<0xB1>(x); x += dppf<0x4E>(x); x += dppf<0x141>(x); x += dppf<0x140>(x);
    return (rdl(x, 0) + rdl(x, 16)) + (rdl(x, 32) + rdl(x, 48));
}
__device__ __forceinline__ float xhalf_max(float m) {
    unsigned a = __builtin_bit_cast(unsigned, m), b = a; asm volatile("" : "+v"(b));
    auto rr = __builtin_amdgcn_permlane32_swap(a, b, false, false);
    unsigned r0 = rr[0], r1 = rr[1]; asm volatile("" : "+v"(r0), "+v"(r1));
    return fmaxf(__builtin_bit_cast(float, r0), __builtin_bit_cast(float, r1)); }
__device__ __forceinline__ float xhalf_sum(float m) {
    unsigned a = __builtin_bit_cast(unsigned, m), b = a; asm volatile("" : "+v"(b));
    auto rr = __builtin_amdgcn_permlane32_swap(a, b, false, false);
    unsigned r0 = rr[0], r1 = rr[1]; asm volatile("" : "+v"(r0), "+v"(r1));
    return __builtin_bit_cast(float, r0) + __builtin_bit_cast(float, r1); }
template <int O> __device__ __forceinline__ float swz_xor(float x) { return __builtin_bit_cast(float, __builtin_amdgcn_ds_swizzle(__builtin_bit_cast(int, x), 0x1F | (O << 10))); }
__device__ __forceinline__ float fexp2(float x) { return __builtin_amdgcn_exp2f(x); }
__device__ __forceinline__ int tid_of(int wv) { int l = (int)__builtin_amdgcn_mbcnt_hi(~0u, __builtin_amdgcn_mbcnt_lo(~0u, 0u)); asm volatile("" : "+v"(l)); return wv * 64 + l; }
#define LDS_WAIT() asm volatile("s_waitcnt lgkmcnt(0)" ::: "memory")

namespace pg8 {
constexpr int BM = 256, BK = 64, HALF = 128, HTB = HALF * BK * 2, STAGE_BYTES = 8 * HTB, NXCD = 8, WGM = 8;
__host__ __device__ __forceinline__ int lds_byte(int r, int c) { const int st = (r >> 4) * 2 + (c >> 5), rr = r & 15, cc = c & 31, ob = rr * 64 + cc * 2; return st * 1024 + (ob ^ (((ob >> 9) & 1) << 5)); }
__host__ __device__ __forceinline__ void stage_rc(int b, int& R, int& C) { const int st = b / 1024, sb = b % 1024, swz = sb ^ (((sb >> 9) & 1) << 5); R = (st >> 1) * 16 + swz / 64; C = (st & 1) * 32 + (swz % 64) / 2; }
__host__ __device__ __forceinline__ int perm32(int rho) { const int n = rho >> 4, i = rho & 15; return 8 * (i >> 2) + 4 * n + (i & 3); }
struct Unit { int pm, pn; };
struct Gemm { const bf16_t* A; const bf16_t* Bt; int M, N, K, lda, ldb; };
struct StaticOrder {
    int nM, nN, nwg, G, c;
    __device__ void init(int M, int N, int G_, int c_) { nM = M / BM; nN = N / BM; nwg = nM * nN; G = G_; c = c_; }
    __device__ bool next(int i, Unit& u) const {
        const long L = (long)i * G + c; if (L >= nwg) return false;
        int wgid = (int)L; { const int q = nwg / NXCD, r = nwg % NXCD, xcd = wgid % NXCD, off = wgid / NXCD; wgid = (xcd < r ? xcd * (q + 1) : r * (q + 1) + (xcd - r) * q) + off; }
        const int nig = WGM * nN, gid = wgid / nig, fm = gid * WGM, gsz = (nM - fm) < WGM ? (nM - fm) : WGM;
        u.pm = fm + ((wgid % nig) % gsz); u.pn = (wgid % nig) / gsz; return true;
    }
};

enum { EPI_INPROJ = 0, EPI_PLAIN = 1, EPI_BR0 = 2, EPI_BR1 = 3, EPI_BR2 = 4, EPI_RESID = 5, EPI_SWIGLU = 6 };
struct Epi {
    int mode, ldo, ldg;
    bf16_t* obf;
    const bf16_t* gate;
    float* f0;
    const float* f1;
    float* f2;
    __device__ __forceinline__ void operator()(const f32x4 (&acc)[2][2][4][2], const Unit& u, int wr, int wc, int fr, int fq) const {
        const int row0 = u.pm * BM + wr * 64 + fr;
        const int colt = u.pn * BM + wc * 32 + 8 * fq;
        if (mode == EPI_INPROJ || mode == EPI_PLAIN) {
            const bool sg = (mode == EPI_INPROJ) && (u.pn * BM >= C_G);
            float rs[2][4];
#pragma unroll
            for (int ai = 0; ai < 2; ++ai)
#pragma unroll
                for (int m = 0; m < 4; ++m) rs[ai][m] = (mode == EPI_INPROJ) ? f1[row0 + ai * HALF + m * 16] : 0.f;
#pragma unroll
            for (int ai = 0; ai < 2; ++ai)
#pragma unroll
                for (int m = 0; m < 4; ++m) {
                    const int row = row0 + ai * HALF + m * 16;
                    float r = 1.f;
                    if (mode == EPI_INPROJ) r = __builtin_amdgcn_rsqf(rs[ai][m] * (1.f / DM) + NORM_EPS);
#pragma unroll
                    for (int bj = 0; bj < 2; ++bj) {
                        float v[8];
#pragma unroll
                        for (int j = 0; j < 4; ++j) { v[j] = acc[ai][bj][m][0][j] * r; v[4 + j] = acc[ai][bj][m][1][j] * r; }
                        if (sg) {
#pragma unroll
                            for (int j = 0; j < 8; ++j) v[j] = __builtin_amdgcn_rcpf(1.f + __expf(-v[j]));
                        }
                        u32x4 w; w.x = cvt_pk_bf16(v[0], v[1]); w.y = cvt_pk_bf16(v[2], v[3]); w.z = cvt_pk_bf16(v[4], v[5]); w.w = cvt_pk_bf16(v[6], v[7]);
                        *(u32x4*)(obf + (size_t)row * ldo + colt + bj * HALF) = w;
                    }
                }
        } else if (mode == EPI_BR0 || mode == EPI_BR1 || mode == EPI_BR2) {
#pragma unroll
            for (int ai = 0; ai < 2; ++ai)
#pragma unroll
                for (int mh = 0; mh < 2; ++mh) {
                    u32x4 gw[2][2], pw[2][2];
#pragma unroll
                    for (int mm = 0; mm < 2; ++mm)
#pragma unroll
                        for (int bj = 0; bj < 2; ++bj) {
                            const int row = row0 + ai * HALF + (2 * mh + mm) * 16, col = colt + bj * HALF;
                            gw[mm][bj] = *(const u32x4*)(gate + (size_t)row * ldg + col);
                            if (mode != EPI_BR0) pw[mm][bj] = *(const u32x4*)((const bf16_t*)f0 + (size_t)row * DM + col);
                        }
#pragma unroll
                    for (int mm = 0; mm < 2; ++mm)
#pragma unroll
                        for (int bj = 0; bj < 2; ++bj) {
                            const int m = 2 * mh + mm;
                            const int row = row0 + ai * HALF + m * 16, col = colt + bj * HALF;
                            float g[8]; unpack8(gw[mm][bj], g);
                            float v[8];
#pragma unroll
                            for (int j = 0; j < 4; ++j) { v[j] = acc[ai][bj][m][0][j] * g[j]; v[4 + j] = acc[ai][bj][m][1][j] * g[4 + j]; }
                            if (mode != EPI_BR0) {
                                float pp[8]; unpack8(pw[mm][bj], pp);
#pragma unroll
                                for (int j = 0; j < 8; ++j) v[j] += pp[j];
                            }
                            u32x4 w; w.x = cvt_pk_bf16(v[0], v[1]); w.y = cvt_pk_bf16(v[2], v[3]); w.z = cvt_pk_bf16(v[4], v[5]); w.w = cvt_pk_bf16(v[6], v[7]);
                            if (mode == EPI_BR2) *(u32x4*)(obf + (size_t)row * ldo + col) = w;
                            else *(u32x4*)((bf16_t*)f0 + (size_t)row * DM + col) = w;
                        }
                }
        } else if (mode == EPI_RESID) {
#pragma unroll
            for (int ai = 0; ai < 2; ++ai)
#pragma unroll
                for (int mh = 0; mh < 2; ++mh) {
                    f32x4 x0[2][2], x1[2][2];
#pragma unroll
                    for (int mm = 0; mm < 2; ++mm)
#pragma unroll
                        for (int bj = 0; bj < 2; ++bj) {
                            const float* xp = f1 + (size_t)(row0 + ai * HALF + (2 * mh + mm) * 16) * DM + colt + bj * HALF;
                            x0[mm][bj] = *(const f32x4*)xp; x1[mm][bj] = *(const f32x4*)(xp + 4);
                        }
#pragma unroll
                    for (int mm = 0; mm < 2; ++mm) {
                        const int m = 2 * mh + mm;
                        const int row = row0 + ai * HALF + m * 16;
                        float ss = 0.f;
#pragma unroll
                        for (int bj = 0; bj < 2; ++bj) {
                            const int col = colt + bj * HALF;
                            float v[8];
#pragma unroll
                            for (int j = 0; j < 4; ++j) { v[j] = acc[ai][bj][m][0][j] + x0[mm][bj][j]; v[4 + j] = acc[ai][bj][m][1][j] + x1[mm][bj][j]; }
#pragma unroll
                            for (int j = 0; j < 8; ++j) ss += v[j] * v[j];
                            float* op = f0 + (size_t)row * DM + col;
                            *(f32x4*)op = (f32x4){v[0], v[1], v[2], v[3]}; *(f32x4*)(op + 4) = (f32x4){v[4], v[5], v[6], v[7]};
                            u32x4 w; w.x = cvt_pk_bf16(v[0], v[1]); w.y = cvt_pk_bf16(v[2], v[3]); w.z = cvt_pk_bf16(v[4], v[5]); w.w = cvt_pk_bf16(v[6], v[7]);
                            *(u32x4*)(obf + (size_t)row * ldo + col) = w;
                        }
                        ss += swz_xor<16>(ss); ss = xhalf_sum(ss);
                        if (fq == 0) atomicAdd(f2 + row, ss);
                    }
                }
        } else {
            const int colh = u.pn * HALF + wc * 32 + 8 * fq;
            float rs[2][4];
#pragma unroll
            for (int ai = 0; ai < 2; ++ai)
#pragma unroll
                for (int m = 0; m < 4; ++m) rs[ai][m] = f1[row0 + ai * HALF + m * 16];
#pragma unroll
            for (int ai = 0; ai < 2; ++ai)
#pragma unroll
                for (int m = 0; m < 4; ++m) {
                    const int row = row0 + ai * HALF + m * 16;
                    const float r = __builtin_amdgcn_rsqf(rs[ai][m] * (1.f / DM) + NORM_EPS);
                    float v[8];
#pragma unroll
                    for (int n = 0; n < 2; ++n)
#pragma unroll
                        for (int j = 0; j < 4; ++j) {
                            const float g = acc[ai][0][m][n][j] * r, up = acc[ai][1][m][n][j] * r;
                            v[4 * n + j] = g * __builtin_amdgcn_rcpf(1.f + __expf(-g)) * up;
                        }
                    u32x4 w; w.x = cvt_pk_bf16(v[0], v[1]); w.y = cvt_pk_bf16(v[2], v[3]); w.z = cvt_pk_bf16(v[4], v[5]); w.w = cvt_pk_bf16(v[6], v[7]);
                    *(u32x4*)(obf + (size_t)row * ldo + colh) = w;
                }
        }
    }
};

__device__ __forceinline__ void gemm_phase(LAS unsigned char* lds, const Gemm g, const StaticOrder& S, const Epi& E, int wv) {
    const int tid = tid_of(wv);
    const int wid = __builtin_amdgcn_readfirstlane(tid >> 6), lane = tid & 63, wr = wid >> 2, wc = wid & 3, fr = lane & 15, fq = lane >> 4;
    const int K = g.K, nt = K / BK;
    unsigned voffA[2], voffB[2];
#pragma unroll
    for (int i = 0; i < 2; ++i) { int R, C; stage_rc(tid * 16 + i * 8192, R, C); const int Rb = (R & ~31) + perm32(R & 31);
        voffA[i] = (unsigned)(R * g.lda + C) * 2u; voffB[i] = (unsigned)(Rb * g.ldb + C) * 2u; }
    const size_t kstep = (size_t)(BK * 2);
    const size_t hstepA = (size_t)HALF * g.lda * 2, hstepB = (size_t)HALF * g.ldb * 2;
    const size_t tstepA = 2 * hstepA, tstepB = 2 * hstepB;
    const unsigned ldsw = (unsigned)wid * 1024u;
    const int aoff = lds_byte(wr * 64 + fr, fq * 8), boff = lds_byte(wc * 32 + fr, fq * 8);
#define PG8_SA(b, h) (((b) * 2 + (h)) * HTB)
#define PG8_SB(b, h) ((4 + (b) * 2 + (h)) * HTB)
#define PG8_STAGE(bufoff, gbase, voff) do { _Pragma("unroll") for (int _i = 0; _i < 2; ++_i) \
        __builtin_amdgcn_global_load_lds((const unsigned*)((const char*)(gbase) + (voff)[_i]), (LAS unsigned*)(lds + (bufoff) + ldsw + _i * 8192), 16, 0, 0); } while (0)
#define PG8_LDA(dst, b, h) do { _Pragma("unroll") for (int m = 0; m < 4; ++m) _Pragma("unroll") for (int k = 0; k < 2; ++k) dst[m][k] = *(const LAS bf16x8*)(lds + PG8_SA(b, h) + aoff + m * 2048 + k * 1024); } while (0)
#define PG8_LDB(dst, b, h) do { _Pragma("unroll") for (int n = 0; n < 2; ++n) _Pragma("unroll") for (int k = 0; k < 2; ++k) dst[n][k] = *(const LAS bf16x8*)(lds + PG8_SB(b, h) + boff + n * 2048 + k * 1024); } while (0)
#define PG8_MMA(ai, bj, At, Bt) do { __builtin_amdgcn_s_setprio(1); _Pragma("unroll") for (int m = 0; m < 4; ++m) _Pragma("unroll") for (int n = 0; n < 2; ++n) _Pragma("unroll") for (int k = 0; k < 2; ++k) \
        acc[ai][bj][m][n] = __builtin_amdgcn_mfma_f32_16x16x32_bf16(Bt[n][k], At[m][k], acc[ai][bj][m][n], 0, 0, 0); __builtin_amdgcn_s_setprio(0); } while (0)
#define PG8_WAIT_V(n) asm volatile("s_waitcnt vmcnt(" #n ")" ::: "memory")
#define PG8_WAIT_L(n) asm volatile("s_waitcnt lgkmcnt(" #n ")" ::: "memory")
#define PG8_BAR __builtin_amdgcn_s_barrier()
#define PG8_SCHED __builtin_amdgcn_sched_barrier(0)
    Unit cur, nxt; int ui = 0;
    if (!S.next(0, cur)) return;
    f32x4 acc[2][2][4][2];
#pragma unroll
    for (int a = 0; a < 2; ++a)
#pragma unroll
        for (int b = 0; b < 2; ++b)
#pragma unroll
            for (int m = 0; m < 4; ++m)
#pragma unroll
                for (int n = 0; n < 2; ++n) acc[a][b][m][n] = (f32x4){0.f, 0.f, 0.f, 0.f};
    bf16x8 At[4][2], B0[2][2], B1[2][2];
    const char* cA = (const char*)g.A + (size_t)cur.pm * tstepA; const char* cB = (const char*)g.Bt + (size_t)cur.pn * tstepB;
    PG8_STAGE(PG8_SB(0, 0), cB, voffB); PG8_STAGE(PG8_SB(0, 1), cB + hstepB, voffB); PG8_STAGE(PG8_SA(0, 0), cA, voffA); PG8_STAGE(PG8_SA(0, 1), cA + hstepA, voffA);
    if (wr == 1) PG8_BAR;
    PG8_WAIT_V(2); PG8_BAR;
    PG8_STAGE(PG8_SB(1, 0), cB + kstep, voffB); PG8_STAGE(PG8_SA(1, 0), cA + kstep, voffA); PG8_STAGE(PG8_SB(1, 1), cB + hstepB + kstep, voffB);
    PG8_WAIT_V(6); PG8_BAR;
    for (;;) {
        const bool has_next = S.next(ui + 1, nxt);
        const char* nA = has_next ? (const char*)g.A + (size_t)nxt.pm * tstepA : cA; const char* nB = has_next ? (const char*)g.Bt + (size_t)nxt.pn * tstepB : cB;
        for (int t = 0; t < nt; t += 2) {
            const bool last = (t == nt - 2);
            const char* a1 = cA + (size_t)(t + 1) * kstep;
            const char* a2 = last ? nA : cA + (size_t)(t + 2) * kstep; const char* b2 = last ? nB : cB + (size_t)(t + 2) * kstep;
            const char* a3 = a2 + kstep; const char* b3 = b2 + kstep;
            PG8_LDB(B0, 0, 0); PG8_LDB(B1, 0, 1); PG8_SCHED; PG8_LDA(At, 0, 0); PG8_STAGE(PG8_SA(1, 1), a1 + hstepA, voffA);
            PG8_WAIT_V(8); PG8_WAIT_L(0); PG8_BAR; PG8_MMA(0, 0, At, B0); PG8_MMA(0, 1, At, B1); PG8_BAR; PG8_SCHED;
            PG8_LDA(At, 0, 1); PG8_STAGE(PG8_SB(0, 0), b2, voffB); PG8_STAGE(PG8_SB(0, 1), b2 + hstepB, voffB); PG8_STAGE(PG8_SA(0, 0), a2, voffA);
            PG8_WAIT_V(8); PG8_WAIT_L(0); PG8_BAR; PG8_MMA(1, 0, At, B0); PG8_MMA(1, 1, At, B1); PG8_BAR; PG8_SCHED;
            PG8_LDB(B0, 1, 0); PG8_LDB(B1, 1, 1); PG8_SCHED; PG8_LDA(At, 1, 0); PG8_STAGE(PG8_SA(0, 1), a2 + hstepA, voffA);
            PG8_WAIT_V(8); PG8_WAIT_L(0); PG8_BAR; PG8_MMA(0, 0, At, B0); PG8_MMA(0, 1, At, B1); PG8_BAR; PG8_SCHED;
            PG8_LDA(At, 1, 1); PG8_STAGE(PG8_SB(1, 0), b3, voffB); PG8_STAGE(PG8_SB(1, 1), b3 + hstepB, voffB); PG8_STAGE(PG8_SA(1, 0), a3, voffA);
            PG8_WAIT_V(8); PG8_WAIT_L(0); PG8_BAR; PG8_MMA(1, 0, At, B0); PG8_MMA(1, 1, At, B1); PG8_BAR; PG8_SCHED;
        }
        if (wr == 0) PG8_BAR;
        E(acc, cur, wr, wc, fr, fq);
        if (!has_next) break;
#pragma unroll
        for (int a = 0; a < 2; ++a)
#pragma unroll
            for (int b = 0; b < 2; ++b)
#pragma unroll
                for (int m = 0; m < 4; ++m)
#pragma unroll
                    for (int n = 0; n < 2; ++n) acc[a][b][m][n] = (f32x4){0.f, 0.f, 0.f, 0.f};
        cur = nxt; cA = nA; cB = nB; ++ui;
        if (wr == 1) PG8_BAR;
    }
    PG8_WAIT_V(0);
    PG8_BAR;
#undef PG8_SA
#undef PG8_SB
#undef PG8_STAGE
#undef PG8_LDA
#undef PG8_LDB
#undef PG8_MMA
#undef PG8_WAIT_V
#undef PG8_WAIT_L
#undef PG8_BAR
#undef PG8_SCHED
}
}

#define XB_TMO      128
#define XB_XCNT(j)  (256  + 64 * (j))
#define XB_XSUB(j)  (1280 + 64 * (j))
#define XB_XGEN(j)  (2304 + 64 * (j))
#define XB_TOP      3328
#define XB_TOPGEN   3392
#define XCD_BAR_WORDS 3456
#define XB_SPIN_CAP (1u << 22)
__device__ __forceinline__ unsigned xb_ld(unsigned* p)              { return __hip_atomic_load(p, __ATOMIC_RELAXED, __HIP_MEMORY_SCOPE_AGENT); }
__device__ __forceinline__ unsigned xb_add(unsigned* p, unsigned v) { return __hip_atomic_fetch_add(p, v, __ATOMIC_RELAXED, __HIP_MEMORY_SCOPE_AGENT); }
__device__ __forceinline__ unsigned xb_xcc_id() { return (unsigned)__builtin_amdgcn_s_getreg((3 << 11) | 20) & 0xFu; }
#define XB_SPIN(cond, bar) do { unsigned _sp = 0; while (cond) { __builtin_amdgcn_s_sleep(1); \
    if ((++_sp & 255u) == 0u) { if (xb_ld(&(bar)[XB_TMO])) break; if (_sp > XB_SPIN_CAP) { atomicAdd(&(bar)[XB_TMO], 1u); break; } } } } while (0)
struct XcdBarrier { unsigned* bar; unsigned x; volatile LAS unsigned* st; };

__device__ __forceinline__ XcdBarrier xcd_barrier_post(unsigned* bar, volatile LAS unsigned* st) {
    XcdBarrier b; b.bar = bar; b.x = xb_xcc_id(); b.st = st;
    if (threadIdx.x == 0) (void)xb_add(&bar[XB_XCNT(b.x)], 1u);
    return b;
}
__device__ __forceinline__ void xcd_barrier_complete(unsigned* bar, unsigned x, unsigned& nloc, unsigned& nx) {
    const unsigned G = gridDim.x * gridDim.y * gridDim.z;
    unsigned sum, cnt, mine, sp = 0u;
    for (;;) {
        sum = 0u; cnt = 0u; mine = 0u;
#pragma unroll
        for (unsigned j = 0; j < 16; ++j) { const unsigned c = xb_ld(&bar[XB_XCNT(j)]); sum += c; cnt += (c > 0u) ? 1u : 0u; mine = (j == x) ? c : mine; }
        if (sum == G) break;
        __builtin_amdgcn_s_sleep(1);
        if ((++sp & 255u) == 0u) { if (xb_ld(&bar[XB_TMO])) break; if (sp > XB_SPIN_CAP) { atomicAdd(&bar[XB_TMO], 1u); break; } }
    }
    nloc = mine > 0u ? mine : 1u; nx = cnt > 0u ? cnt : 1u;
}
__device__ __forceinline__ void xcd_barrier(const XcdBarrier& b, int wv) {
    asm volatile("s_waitcnt vmcnt(0)" ::: "memory");
    __syncthreads();
    if (tid_of(wv) == 0) {
        unsigned* bar = b.bar;
        __builtin_amdgcn_s_waitcnt(0);
        unsigned nloc = b.st[0], nx = b.st[1];
        if (nloc == 0u) { xcd_barrier_complete(bar, b.x, nloc, nx); b.st[0] = nloc; b.st[1] = nx; }
        const unsigned old = xb_add(&bar[XB_XSUB(b.x)], 1u);
        const unsigned gen = old / nloc;
        if (old + 1u == (gen + 1u) * nloc) {
            __builtin_amdgcn_fence(__ATOMIC_RELEASE, "agent");
            asm volatile("s_waitcnt vmcnt(0)" ::: "memory");
            const unsigned og = xb_add(&bar[XB_TOP], 1u);
            const unsigned tg = og / nx;
            if (og + 1u == (tg + 1u) * nx) xb_add(&bar[XB_TOPGEN], 1u);
            else XB_SPIN(xb_ld(&bar[XB_TOPGEN]) == tg, bar);
            __builtin_amdgcn_fence(__ATOMIC_ACQUIRE, "agent");
            xb_add(&bar[XB_XGEN(b.x)], 1u);
            asm volatile("s_waitcnt vmcnt(0)" ::: "memory");
        } else {
            XB_SPIN(xb_ld(&bar[XB_XGEN(b.x)]) == gen, bar);
            __builtin_amdgcn_fence(__ATOMIC_ACQUIRE, "agent");
            asm volatile("s_waitcnt vmcnt(0)" ::: "memory");
        }
    }
    __syncthreads();
}

constexpr int RING_BYTES = 131072, MISC_OFF = RING_BYTES, LDS_BYTES = 147456;

__device__ __forceinline__ int srccol(int cmode, int nd) {
    if (cmode == 0) return nd;
    if (cmode == 1) {
        if (nd < 2880) return nd;
        if (nd < 2944) return 4936 + (nd - 2880);
        if (nd < 4480) return 2888 + (nd - 2944);
        if (nd < 4992) return 4424 + (nd - 4480);
        if (nd < 5000) return 2880 + (nd - 4992);
        if (nd < 5120) return -1;
        return 5000 + (nd - 5120);
    }
    const int p = nd >> 8, j = nd & 255;
    return (j < 128) ? (128 * p + j) : (DFF + 128 * p + (j - 128));
}
__device__ __forceinline__ void tr_item(const float* W, int ldw, int K, bf16_t* WT, int cmode, const float* gain, LAS float* scr, int item, int nblk, int lane) {
    const int kb = item / nblk, nb = item % nblk, k0 = 64 * kb, n0 = 32 * nb;
    const int sc = srccol(cmode, n0 + (lane & 31));
    float v[32];
    const float* wp = W + (size_t)(k0 + (lane >> 5)) * ldw + (sc >= 0 ? sc : 0);
#pragma unroll
    for (int i = 0; i < 32; ++i) v[i] = __builtin_nontemporal_load(wp + (size_t)(2 * i) * ldw);
    if (gain) {
        const float* gp = gain + k0 + (lane >> 5);
#pragma unroll
        for (int i = 0; i < 32; ++i) v[i] *= gp[2 * i];
    }
    if (sc < 0) {
#pragma unroll
        for (int i = 0; i < 32; ++i) v[i] = 0.f;
    }
#pragma unroll
    for (int i = 0; i < 32; ++i) scr[(2 * i + (lane >> 5)) * 33 + (lane & 31)] = v[i];
    LDS_WAIT(); asm volatile("" ::: "memory");
    const int c = lane & 7;
#pragma unroll
    for (int j = 0; j < 4; ++j) { const int n = (lane >> 3) + 8 * j; const LAS float* s = scr + (8 * c) * 33 + n;
        u32x4 o; o.x = pk2(s[0 * 33], s[1 * 33]); o.y = pk2(s[2 * 33], s[3 * 33]); o.z = pk2(s[4 * 33], s[5 * 33]); o.w = pk2(s[6 * 33], s[7 * 33]);
        *(u32x4*)(WT + (size_t)(n0 + n) * K + k0 + 8 * c) = o; }
    LDS_WAIT(); asm volatile("" ::: "memory");
}
__device__ __forceinline__ void trb_item(const bf16_t* src, int lds_, bf16_t* dst, int ldd, LAS unsigned short* scr, int lane) {
#pragma unroll
    for (int i = 0; i < 8; ++i) {
        const int id = lane + 64 * i, row = id >> 3, cc = id & 7;
        const u32x4 w = *(const u32x4*)(src + (size_t)row * lds_ + 8 * cc);
        LAS unsigned* d = (LAS unsigned*)(scr + row * 66 + 8 * cc);
        d[0] = w.x; d[1] = w.y; d[2] = w.z; d[3] = w.w;
    }
    LDS_WAIT(); asm volatile("" ::: "memory");
#pragma unroll
    for (int i = 0; i < 8; ++i) {
        const int id = lane + 64 * i, c = id >> 3, tc = id & 7;
        const LAS unsigned short* s = scr + (8 * tc) * 66 + c;
        u32x4 o;
        o.x = (unsigned)s[0] | ((unsigned)s[66] << 16); o.y = (unsigned)s[2 * 66] | ((unsigned)s[3 * 66] << 16);
        o.z = (unsigned)s[4 * 66] | ((unsigned)s[5 * 66] << 16); o.w = (unsigned)s[6 * 66] | ((unsigned)s[7 * 66] << 16);
        *(u32x4*)(dst + (size_t)c * ldd + 8 * tc) = o;
    }
    LDS_WAIT(); asm volatile("" ::: "memory");
}

__device__ __forceinline__ float inv_freq(int fi, int rot) { return exp2f(-((float)fi * 2.0f / (float)rot) * LOG2_THETA); }
template <int HD, int ROT, bool NORM>
__device__ __forceinline__ void pp_chunk(u32x4 xin, bf16_t* dst, int ci, bool act, const float* gain, const LAS float* tab, float oscale) {
    float x[8]; unpack8(xin, x);
    if (NORM) {
        float ss = 0.f;
#pragma unroll
        for (int j = 0; j < 8; ++j) ss += x[j] * x[j];
        if (HD == 512) ss = wave_sum_dpp(ss);
        else { ss += dppf<0xB1>(ss); ss += dppf<0x4E>(ss); ss += dppf<0x141>(ss); if (HD == 128) ss += dppf<0x140>(ss); }
        const float r = 1.0f / sqrtf(ss * (1.f / HD) + NORM_EPS);
#pragma unroll
        for (int j = 0; j < 8; ++j) x[j] = x[j] * r * gain[8 * ci + j];
    }
    if (ROT > 0) {
        float oth[8];
#pragma unroll
        for (int j = 0; j < 8; ++j) oth[j] = swz_xor<(ROT / 16)>(x[j]);
        if (ci < ROT / 8) {
            const bool first = ci < ROT / 16;
#pragma unroll
            for (int j = 0; j < 8; ++j) {
                const int fi = 8 * (ci & (ROT / 16 - 1)) + j;
                const float cs = tab[fi], sn = tab[64 + fi];
                x[j] = first ? (x[j] * cs - oth[j] * sn) : (x[j] * cs + oth[j] * sn);
            }
        }
    }
#pragma unroll
    for (int j = 0; j < 8; ++j) x[j] *= oscale;
    if (act) *(u32x4*)dst = pack8(x);
}
__device__ __forceinline__ void pp_head192(u32x4 a0, u32x4 a1, u32x4 a2, bf16_t* d, int ci, const float* gain, const LAS float* tab, float oscale) {
    float x0[8], x1[8], x2[8];
    unpack8(a0, x0); unpack8(a1, x1); unpack8(a2, x2);
    float ss = 0.f;
#pragma unroll
    for (int j = 0; j < 8; ++j) ss += x0[j] * x0[j] + x1[j] * x1[j] + x2[j] * x2[j];
    ss += dppf<0xB1>(ss); ss += dppf<0x4E>(ss); ss += dppf<0x141>(ss);
    const float r = 1.0f / sqrtf(ss * (1.f / 192.f) + NORM_EPS);
#pragma unroll
    for (int j = 0; j < 8; ++j) { x0[j] = x0[j] * r * gain[8 * ci + j]; x1[j] = x1[j] * r * gain[64 + 8 * ci + j]; x2[j] = x2[j] * r * gain[128 + 8 * ci + j]; }
    float oth[8];
#pragma unroll
    for (int j = 0; j < 8; ++j) oth[j] = swz_xor<4>(x0[j]);
    const bool first = ci < 4;
#pragma unroll
    for (int j = 0; j < 8; ++j) {
        const int fi = 8 * (ci & 3) + j;
        const float cs = tab[fi], sn = tab[64 + fi];
        x0[j] = first ? (x0[j] * cs - oth[j] * sn) : (x0[j] * cs + oth[j] * sn);
    }
#pragma unroll
    for (int j = 0; j < 8; ++j) { x0[j] *= oscale; x1[j] *= oscale; x2[j] *= oscale; }
    *(u32x4*)(d + 8 * ci) = pack8(x0); *(u32x4*)(d + 64 + 8 * ci) = pack8(x1); *(u32x4*)(d + 128 + 8 * ci) = pack8(x2);
}
__device__ __forceinline__ void rope_table(LAS float* tab, float pos, int lane) {
    int rot = 64, fi = lane - 24;
    if (lane < 8) { rot = 16; fi = lane; } else if (lane < 24) { rot = 32; fi = lane - 8; }
    if (fi > 31) fi = 31;
    float sn, cs; sincosf(pos * inv_freq(fi, rot), &sn, &cs);
    tab[lane] = cs; tab[64 + lane] = sn;
    LDS_WAIT(); asm volatile("" ::: "memory");
}

__device__ __forceinline__ int pi32(int r) { return (r & ~12) | ((r & 4) << 1) | ((r & 8) >> 1); }
template <int DQK>
__device__ __forceinline__ void attn_unit(LAS unsigned char* lds, const bf16_t* Q, int ldq, const bf16_t* K, int ldk, const bf16_t* VT, int qb,
                                          float* of32, int ldo32, bf16_t* obf, int ldo, int wv) {
    constexpr int KS = DQK * 2 + 16, VS = 144, KBYTES = 64 * KS, BUF = KBYTES + 128 * VS, NDS = DQK / 16, CPR = DQK / 8, NKC = 64 * CPR / 512;
    const int tid = tid_of(wv);
    const int lane = tid & 63, w = wv, qi = lane & 31, hh = lane >> 5;
    const int q0 = qb * 256 + w * 32, NT = 4 * qb + 4, ntw = (q0 + 31) / 64 + 1;
    bf16x8 qf[NDS];
#pragma unroll
    for (int ds = 0; ds < NDS; ++ds) qf[ds] = *(const bf16x8*)(Q + (size_t)(q0 + qi) * ldq + 16 * ds + 8 * hh);
    f32x16 o[4];
#pragma unroll
    for (int d = 0; d < 4; ++d)
#pragma unroll
        for (int r = 0; r < 16; ++r) o[d][r] = 0.f;
    float mrun = -INFINITY, lsum = 0.f;
    u32x4 kst[NKC], vst[2];
    int krow[NKC], kcc[NKC];
#pragma unroll
    for (int i = 0; i < NKC; ++i) { const int id = tid + 512 * i; krow[i] = id / CPR; kcc[i] = id % CPR; }
    const int vd0 = tid >> 3, vcc = tid & 7;
#define ATT_LOAD(kt) do { _Pragma("unroll") for (int i = 0; i < NKC; ++i) kst[i] = *(const u32x4*)(K + (size_t)(64 * (kt) + krow[i]) * ldk + 8 * kcc[i]); \
        _Pragma("unroll") for (int i = 0; i < 2; ++i) vst[i] = *(const u32x4*)(VT + (size_t)(vd0 + 64 * i) * SEQ + 64 * (kt) + 8 * vcc); } while (0)
#define ATT_WRITE(b) do { LAS unsigned char* base = lds + (b) * BUF; \
        _Pragma("unroll") for (int i = 0; i < NKC; ++i) *(LAS u32x4*)(base + krow[i] * KS + 16 * kcc[i]) = kst[i]; \
        _Pragma("unroll") for (int i = 0; i < 2; ++i) *(LAS u32x4*)(base + KBYTES + (vd0 + 64 * i) * VS + 16 * vcc) = vst[i]; } while (0)
    ATT_LOAD(0); ATT_WRITE(0);
    __syncthreads();
    const int kro = pi32(qi) * KS + 16 * hh;
    const int vro = KBYTES + qi * VS + 16 * hh;
    for (int kt = 0; kt < NT; ++kt) {
        const bool more = (kt + 1 < NT);
        if (more) ATT_LOAD(kt + 1);
        if (kt < ntw) {
            const LAS unsigned char* base = lds + (kt & 1) * BUF;
#pragma unroll
            for (int kb = 0; kb < 2; ++kb) {
                f32x16 s;
#pragma unroll
                for (int r = 0; r < 16; ++r) s[r] = 0.f;
#pragma unroll
                for (int ds = 0; ds < NDS; ++ds) {
                    const bf16x8 kf = *(const LAS bf16x8*)(base + kro + kb * 32 * KS + ds * 32);
                    s = __builtin_amdgcn_mfma_f32_32x32x16_bf16(kf, qf[ds], s, 0, 0, 0);
                }
                const int kbase = 64 * kt + 32 * kb;
                if (kbase + 31 > q0) {
                    const int qq = q0 + qi;
#pragma unroll
                    for (int r = 0; r < 16; ++r) { const int key = kbase + (r & 7) + 8 * hh + 16 * (r >> 3); if (key > qq) s[r] = -INFINITY; }
                }
                float mx = s[0];
#pragma unroll
                for (int r = 1; r < 16; ++r) mx = fmaxf(mx, s[r]);
                mx = xhalf_max(mx);
                if (__builtin_amdgcn_ballot_w64(mx > mrun + 8.f) != 0ull) {
                    const float mnew = fmaxf(mrun, mx);
                    const float alpha = fexp2(mrun - mnew);
                    mrun = mnew;
                    lsum *= alpha;
#pragma unroll
                    for (int d = 0; d < 4; ++d)
#pragma unroll
                        for (int r = 0; r < 16; ++r) o[d][r] *= alpha;
                }
                float ps = 0.f;
#pragma unroll
                for (int r = 0; r < 16; ++r) { s[r] = fexp2(s[r] - mrun); ps += s[r]; }
                lsum += ps;
                __builtin_amdgcn_iglp_opt(0);
                bf16x8 pf[2];
#pragma unroll
                for (int s2 = 0; s2 < 2; ++s2) {
                    u32x4 pw; pw.x = cvt_pk_bf16(s[8 * s2 + 0], s[8 * s2 + 1]); pw.y = cvt_pk_bf16(s[8 * s2 + 2], s[8 * s2 + 3]);
                    pw.z = cvt_pk_bf16(s[8 * s2 + 4], s[8 * s2 + 5]); pw.w = cvt_pk_bf16(s[8 * s2 + 6], s[8 * s2 + 7]);
                    pf[s2] = __builtin_bit_cast(bf16x8, pw);
                }
#pragma unroll
                for (int d = 0; d < 4; ++d)
#pragma unroll
                    for (int s2 = 0; s2 < 2; ++s2) {
                        const bf16x8 vf = *(const LAS bf16x8*)(base + vro + d * 32 * VS + (32 * kb + 16 * s2) * 2);
                        o[d] = __builtin_amdgcn_mfma_f32_32x32x16_bf16(vf, pf[s2], o[d], 0, 0, 0);
                    }
            }
        }
        if (more) ATT_WRITE((kt + 1) & 1);
        __syncthreads();
    }
#undef ATT_LOAD
#undef ATT_WRITE
    const float l = xhalf_sum(lsum);
    const float inv = 1.f / l;
    const size_t row = (size_t)(q0 + qi);
#pragma unroll
    for (int d = 0; d < 4; ++d)
#pragma unroll
        for (int g = 0; g < 4; ++g) {
            const int dim = 32 * d + 8 * g + 4 * hh;
            const float v0 = o[d][4 * g] * inv, v1 = o[d][4 * g + 1] * inv, v2 = o[d][4 * g + 2] * inv, v3 = o[d][4 * g + 3] * inv;
            if (of32) *(f32x4*)(of32 + row * ldo32 + dim) = (f32x4){v0, v1, v2, v3};
            else { u32x2 wv; wv.x = cvt_pk_bf16(v0, v1); wv.y = cvt_pk_bf16(v2, v3); *(u32x2*)(obf + row * ldo + dim) = wv; }
        }
}

__device__ __forceinline__ unsigned fkey(float f) { const unsigned u = __builtin_bit_cast(unsigned, f); return (u & 0x80000000u) ? ~u : (u | 0x80000000u); }
template <int NR>
__device__ __forceinline__ void topk_select(const float* sc, int t, LAS unsigned short* sel, int lane) {
    unsigned key[NR];
    const float* scl = sc + lane;
#pragma unroll
    for (int i = 0; i < NR; ++i) { const int e = 64 * i + lane; const unsigned kv = fkey(scl[64 * i]); key[i] = kv & (unsigned)((e - t - 1) >> 31); }
    unsigned thr = 0u;
    for (int b = 31; b >= 0; --b) {
        const unsigned cand = thr | (1u << b);
        int c = 0;
#pragma unroll
        for (int i = 0; i < NR; ++i) c += __popcll(__ballot(key[i] >= cand));
        if (c >= 256) thr = cand;
        if (c == 256) break;
    }
    int cgt = 0;
    unsigned thr1 = thr + 1u; asm volatile("" : "+v"(thr1));
#pragma unroll
    for (int i = 0; i < NR; ++i) cgt += __popcll(__ballot(key[i] >= thr1));
    const int need = 256 - cgt;
    int base = 0, eqbase = 0;
#pragma unroll
    for (int i = 0; i < NR; ++i) {
        const bool gt = key[i] > thr, eq = key[i] == thr;
        const unsigned long long em = __ballot(eq);
        const int erank = eqbase + (int)__builtin_amdgcn_mbcnt_hi((unsigned)(em >> 32), __builtin_amdgcn_mbcnt_lo((unsigned)em, 0u));
        const bool take = gt || (eq && erank < need);
        const unsigned long long tm = __ballot(take);
        const int pos = base + (int)__builtin_amdgcn_mbcnt_hi((unsigned)(tm >> 32), __builtin_amdgcn_mbcnt_lo((unsigned)tm, 0u));
        if (take) sel[pos & 255] = (unsigned short)(64 * i + lane);
        base += __popcll(tm); eqbase += __popcll(em);
        __builtin_amdgcn_sched_barrier(0);
    }
}

__device__ __forceinline__ unsigned lo16(unsigned x) { return __builtin_amdgcn_ubfe(x, 0u, 16u); }
__device__ __forceinline__ int row_sum16(int x) {
    x += __builtin_amdgcn_update_dpp(0, x, 0xB1, 0xf, 0xf, false);
    x += __builtin_amdgcn_update_dpp(0, x, 0x4E, 0xf, 0xf, false);
    x += __builtin_amdgcn_update_dpp(0, x, 0x141, 0xf, 0xf, false);
    x += __builtin_amdgcn_update_dpp(0, x, 0x140, 0xf, 0xf, false);
    return x;
}
__device__ __forceinline__ int wave_total(int x) {
    x = row_sum16(x);
    return __builtin_amdgcn_readlane(x, 0) + __builtin_amdgcn_readlane(x, 16) + __builtin_amdgcn_readlane(x, 32) + __builtin_amdgcn_readlane(x, 48);
}
__device__ __forceinline__ unsigned pk_cnt(unsigned acc, unsigned R, unsigned C, unsigned ONE) {
    unsigned d, f;
    asm("v_pk_sub_u16 %0, %1, %2 clamp" : "=v"(d) : "v"(R), "s"(C));
    asm("v_pk_min_u16 %0, %1, %2" : "=v"(f) : "v"(d), "s"(ONE));
    asm("v_pk_add_u16 %0, %0, %1" : "+v"(acc) : "v"(f));
    return acc;
}
template <int NR2>
__device__ __forceinline__ void topk_select16(const unsigned* sc16, const float* sc32, int t, LAS unsigned short* sel, LAS unsigned short* bl, int lane) {
    unsigned R[NR2];
    const unsigned* p16 = sc16 + lane;
#pragma unroll
    for (int i = 0; i < NR2; ++i) {
        const int e0 = 128 * i + 2 * lane;
        const unsigned m = lo16((unsigned)((e0 - t - 1) >> 31)) | ((unsigned)((e0 - t) >> 31) << 16);
        R[i] = p16[64 * i] & m;
    }
    const unsigned ONE = 0x00010001u;
    unsigned thr = 0u;
#pragma unroll 1
    for (int b = 15; b >= 0; --b) {
        const unsigned cand = thr | (1u << b), cm1 = cand - 1u, C = cm1 | (cm1 << 16);
        unsigned acc = 0u;
#pragma unroll
        for (int i = 0; i < NR2; ++i) acc = pk_cnt(acc, R[i], C, ONE);
        const int c = wave_total((int)(lo16(acc) + (acc >> 16)));
        if (c >= 256) thr = cand;
        if (c == 256) break;
    }
    unsigned ag = 0u, ae = 0u;
    {
        const unsigned Cg = thr | (thr << 16), tm1 = thr - 1u, Ce = tm1 | (tm1 << 16);
#pragma unroll
        for (int i = 0; i < NR2; ++i) { ag = pk_cnt(ag, R[i], Cg, ONE); ae = pk_cnt(ae, R[i], Ce, ONE); }
    }
    const int cg_l = (int)(lo16(ag) + (ag >> 16)), ce_l = (int)(lo16(ae) + (ae >> 16)) - cg_l;
    int sc = cg_l | (ce_l << 16);
    const int mine = sc;
    sc += __builtin_amdgcn_update_dpp(0, sc, 0x111, 0xf, 0xf, false);
    sc += __builtin_amdgcn_update_dpp(0, sc, 0x112, 0xf, 0xf, false);
    sc += __builtin_amdgcn_update_dpp(0, sc, 0x114, 0xf, 0xf, false);
    sc += __builtin_amdgcn_update_dpp(0, sc, 0x118, 0xf, 0xf, false);
    const int r0 = __builtin_amdgcn_readlane(sc, 15), r1 = __builtin_amdgcn_readlane(sc, 31), r2 = __builtin_amdgcn_readlane(sc, 47), r3 = __builtin_amdgcn_readlane(sc, 63);
    const int rowi = lane >> 4;
    sc += (rowi > 0 ? r0 : 0) + (rowi > 1 ? r1 : 0) + (rowi > 2 ? r2 : 0);
    const int tot = r0 + r1 + r2 + r3;
    const int cgt = (int)lo16((unsigned)tot), meq = tot >> 16, need = 256 - cgt;
    sc -= mine;
    int og = (int)lo16((unsigned)sc), oe = sc >> 16;
#pragma unroll
    for (int i = 0; i < NR2; ++i) {
        const int e0 = 128 * i + 2 * lane;
        const unsigned lo = lo16(R[i]), hi = R[i] >> 16;
        if (lo > thr) { sel[og & 255] = (unsigned short)e0; ++og; }
        else if (lo == thr) { if (oe < 256) bl[oe] = (unsigned short)e0; ++oe; }
        if (hi > thr) { sel[og & 255] = (unsigned short)(e0 + 1); ++og; }
        else if (hi == thr) { if (oe < 256) bl[oe] = (unsigned short)(e0 + 1); ++oe; }
    }
    LDS_WAIT(); asm volatile("" ::: "memory");
    const int mc = meq < 256 ? meq : 256;
    unsigned v[4]; int vi[4];
#pragma unroll
    for (int r = 0; r < 4; ++r) {
        const int ci = lane + 64 * r;
        const int idx = (int)bl[ci < mc ? ci : mc - 1];
        const unsigned k32 = fkey(sc32[idx]);
        vi[r] = idx;
        v[r] = (ci < mc) ? (((lo16(k32) << 13) | (unsigned)(8191 - idx)) + 1u) : 0u;
    }
    unsigned tv = 1u;
    if (mc != need) {
        tv = 0u;
#pragma unroll 1
        for (int b = 29; b >= 0; --b) {
            const unsigned cand = tv | (1u << b);
            int c = 0;
#pragma unroll
            for (int r = 0; r < 4; ++r) c += __popcll(__ballot(v[r] >= cand));
            if (c >= need) tv = cand;
            if (c == need) break;
        }
    }
    int base = cgt;
#pragma unroll
    for (int r = 0; r < 4; ++r) {
        const bool take = v[r] >= tv;
        const unsigned long long tm = __ballot(take);
        const int pos = base + (int)__builtin_amdgcn_mbcnt_hi((unsigned)(tm >> 32), __builtin_amdgcn_mbcnt_lo((unsigned)tm, 0u));
        if (take) sel[pos & 255] = (unsigned short)vi[r];
        base += __popcll(tm);
    }
}

template <int MODE>
__device__ __forceinline__ void dsa_item(LAS unsigned char* lds, const bf16_t* P, const bf16_t* IKC, float* scr, unsigned short* scr16, bf16_t* AOb, int t0, int wv) {
    const int tid = tid_of(wv);
    const int lane = tid & 63, w = wv; (void)tid;
    const bool need_sel = (t0 >= 256);
    if (need_sel && (MODE & 1)) {
        const int g = w & 3, c = lane & 31, hh = lane >> 5;
        const int nkb = (t0 + 16 + 31) / 32;
        const int qiA = 2 * ((c >> 2) & 1) + (c >> 4), hdA = 4 * ((c >> 3) & 1) + (c & 3);
        bf16x8 af[4];
#pragma unroll
        for (int ds = 0; ds < 4; ++ds) af[ds] = *(const bf16x8*)(P + (size_t)(t0 + 4 * g + qiA) * NIN + C_IQ + hdA * 64 + 16 * ds + 8 * hh);
        float wq[2][8];
#pragma unroll
        for (int qq = 0; qq < 2; ++qq) {
            float tmp[8]; unpack8(*(const u32x4*)(P + (size_t)(t0 + 4 * g + 2 * hh + qq) * NIN + C_IW), tmp);
#pragma unroll
            for (int h = 0; h < 8; ++h) wq[qq][h] = tmp[h] * 0.044194173824159216f;
        }
        const bf16_t* ikp = IKC + (size_t)lane * 8;
        bf16x8 bc[4], bn[4], bm[4];
        const int kbw = (w >> 2);
        {
            const int kb1 = min(kbw + 2, nkb - 1);
#pragma unroll
            for (int ds = 0; ds < 4; ++ds) { bc[ds] = *(const bf16x8*)(ikp + (size_t)kbw * 2048 + 512 * ds); bn[ds] = *(const bf16x8*)(ikp + (size_t)kb1 * 2048 + 512 * ds); }
        }
#pragma unroll 1
        for (int kc = kbw; kc < nkb; kc += 16) {
            float ra[8][2];
#pragma unroll
            for (int i = 0; i < 8; ++i) {
                const int kn = min(kc + 2 * i + 4, nkb - 1);
#pragma unroll
                for (int ds = 0; ds < 4; ++ds) bm[ds] = *(const bf16x8*)(ikp + (size_t)kn * 2048 + 512 * ds);
                f32x16 s;
#pragma unroll
                for (int r = 0; r < 16; ++r) s[r] = 0.f;
#pragma unroll
                for (int ds = 0; ds < 4; ++ds) s = __builtin_amdgcn_mfma_f32_32x32x16_bf16(af[ds], bc[ds], s, 0, 0, 0);
#pragma unroll
                for (int qq = 0; qq < 2; ++qq) {
                    float a = 0.f;
#pragma unroll
                    for (int h = 0; h < 8; ++h) a += wq[qq][h] * fmaxf(s[8 * qq + h], 0.f);
                    ra[i][qq] = a;
                }
#pragma unroll
                for (int ds = 0; ds < 4; ++ds) { bc[ds] = bn[ds]; bn[ds] = bm[ds]; }
            }
#pragma unroll
            for (int i = 0; i < 8; ++i) {
                const int kb = kc + 2 * i;
                if (kb < nkb) {
#pragma unroll
                    for (int qq = 0; qq < 2; ++qq) {
                        const size_t o = (size_t)(4 * g + 2 * hh + qq) * SEQ + 32 * kb + c;
                        scr[o] = ra[i][qq];
                        scr16[o] = (unsigned short)(fkey(ra[i][qq]) >> 16);
                    }
                }
            }
        }
    }
    __syncthreads();
    LAS unsigned char* wl = lds + w * 8192;
    LAS float* pl = (LAS float*)wl;
    LAS unsigned short* sel = (LAS unsigned short*)(wl + 4096);
    LAS unsigned short* bl = (LAS unsigned short*)(wl + 4096 + 512);
    typedef float f32x4_t __attribute__((ext_vector_type(4)));
    const int n16 = lane & 15, g4 = lane >> 4;
#pragma unroll 1
    for (int qq = 0; qq < 2; ++qq) {
        const int ql = 2 * w + qq, t = t0 + ql;
        int nsel;
        if (need_sel && (MODE & 2)) {
            const float* sc = scr + (size_t)ql * SEQ;
            const unsigned* sc16 = (const unsigned*)(scr16 + (size_t)ql * SEQ);
            const int nr2 = (t >> 7) + 1;
            if (nr2 <= 16) topk_select16<16>(sc16, sc, t, sel, bl, lane);
            else if (nr2 <= 32) topk_select16<32>(sc16, sc, t, sel, bl, lane);
            else if (nr2 <= 48) topk_select16<48>(sc16, sc, t, sel, bl, lane);
            else topk_select16<64>(sc16, sc, t, sel, bl, lane);
            nsel = 256;
        } else {
            nsel = t + 1;
#pragma unroll
            for (int i = 0; i < 4; ++i) sel[lane + 64 * i] = (unsigned short)(lane + 64 * i);
        }
        if (!(MODE & 4)) { if (lane == 0) AOb[(size_t)t * DM] = sel[17]; continue; }
        LDS_WAIT(); asm volatile("" ::: "memory");
        bf16x8 qa[4];
#pragma unroll
        for (int ks = 0; ks < 4; ++ks) qa[ks] = *(const bf16x8*)(P + (size_t)t * NIN + C_BQ + (n16 & 3) * 128 + 32 * ks + 8 * g4);
        float sl[4][4];
#pragma unroll
        for (int i = 0; i < 4; ++i)
#pragma unroll
            for (int h = 0; h < 4; ++h) sl[i][h] = 0.f;
#pragma unroll
        for (int kb = 0; kb < 16; ++kb) {
            const int idx = (int)sel[16 * kb + n16];
            const bf16_t* kr = P + (size_t)idx * NIN + C_BK + 8 * g4;
            bf16x8 kf[4];
#pragma unroll
            for (int ks = 0; ks < 4; ++ks) kf[ks] = *(const bf16x8*)(kr + 32 * ks);
            f32x4 acc = (f32x4){0.f, 0.f, 0.f, 0.f};
#pragma unroll
            for (int ks = 0; ks < 4; ++ks) acc = __builtin_amdgcn_mfma_f32_16x16x32_bf16(qa[ks], kf[ks], acc, 0, 0, 0);
            const bool mine = (g4 == (kb & 3));
#pragma unroll
            for (int h = 0; h < 4; ++h) sl[kb >> 2][h] = mine ? acc[h] : sl[kb >> 2][h];
            if ((kb & 3) == 3) __builtin_amdgcn_sched_barrier(0);
        }
        float linv[4];
#pragma unroll
        for (int i = 0; i < 4; ++i) {
            const bool val = (16 * (4 * i + g4) + n16) < nsel;
#pragma unroll
            for (int h = 0; h < 4; ++h) sl[i][h] = val ? sl[i][h] : -INFINITY;
        }
#pragma unroll
        for (int h = 0; h < 4; ++h) {
            float mx = fmaxf(fmaxf(sl[0][h], sl[1][h]), fmaxf(sl[2][h], sl[3][h]));
            mx = wave_max_dpp(mx);
            float ps = 0.f;
#pragma unroll
            for (int i = 0; i < 4; ++i) { sl[i][h] = fexp2(sl[i][h] - mx); ps += sl[i][h]; }
            ps = wave_sum_dpp(ps);
            linv[h] = 1.f / ps;
        }
#pragma unroll
        for (int i = 0; i < 4; ++i) *(LAS f32x4*)(pl + 4 * (16 * (4 * i + g4) + n16)) = (f32x4){sl[i][0], sl[i][1], sl[i][2], sl[i][3]};
        LDS_WAIT(); asm volatile("" ::: "memory");
        typedef float f32x2_t __attribute__((ext_vector_type(2)));
        f32x2_t oacc[4][4];
#pragma unroll
        for (int h = 0; h < 4; ++h)
#pragma unroll
            for (int d = 0; d < 4; ++d) oacc[h][d] = (f32x2_t){0.f, 0.f};
        const bf16_t* vb = P + C_BV + 8 * n16;
        const int nj = (nsel + 15) & ~15;
        u32x4 vw[4], vn[4];
#pragma unroll
        for (int u = 0; u < 4; ++u) vw[u] = *(const u32x4*)(vb + (size_t)((int)sel[4 * u + g4]) * NIN);
#pragma unroll 1
        for (int j0 = 0; j0 < nj; j0 += 16) {
            const int jn = (j0 + 16 < nj) ? j0 + 16 : j0;
#pragma unroll
            for (int u = 0; u < 4; ++u) vn[u] = *(const u32x4*)(vb + (size_t)((int)sel[jn + 4 * u + g4]) * NIN);
#pragma unroll
            for (int u = 0; u < 4; ++u) {
                const f32x4 pq = *(const LAS f32x4*)(pl + 4 * (j0 + 4 * u + g4));
                float vx[8]; unpack8(vw[u], vx);
#pragma unroll
                for (int h = 0; h < 4; ++h)
#pragma unroll
                    for (int d = 0; d < 4; ++d) oacc[h][d] += (f32x2_t){vx[2 * d], vx[2 * d + 1]} * pq[h];
            }
#pragma unroll
            for (int u = 0; u < 4; ++u) vw[u] = vn[u];
        }
#pragma unroll
        for (int h = 0; h < 4; ++h) {
            float r[8];
#pragma unroll
            for (int d = 0; d < 4; ++d) {
                float a0 = oacc[h][d].x, a1 = oacc[h][d].y;
                a0 += swz_xor<16>(a0); a1 += swz_xor<16>(a1);
                a0 = xhalf_sum(a0); a1 = xhalf_sum(a1);
                r[2 * d] = a0 * linv[h]; r[2 * d + 1] = a1 * linv[h];
            }
            if (g4 == 0) {
                u32x4 w; w.x = cvt_pk_bf16(r[0], r[1]); w.y = cvt_pk_bf16(r[2], r[3]); w.z = cvt_pk_bf16(r[4], r[5]); w.w = cvt_pk_bf16(r[6], r[7]);
                *(u32x4*)(AOb + (size_t)t * DM + h * 128 + 8 * n16) = w;
            }
        }
        LDS_WAIT(); asm volatile("" ::: "memory");
    }
    __syncthreads();
}

struct Args { const float* in[19]; float* out; unsigned char* ws; };
constexpr int TAB_OFF = MISC_OFF + 256;
__device__ __forceinline__ unsigned long long tabp_(LAS unsigned char* lds, int i) {
    volatile LAS unsigned* p = (volatile LAS unsigned*)(lds + TAB_OFF + 8 * i);
    const unsigned lo = __builtin_amdgcn_readfirstlane(p[0]), hi = __builtin_amdgcn_readfirstlane(p[1]);
    return ((unsigned long long)hi << 32) | lo;
}
#define tabp(i) tabp_(lds, (i))
#define INP(i) ((const float*)(const GAS float*)tabp(i))
#define WSP(T, off) ((T*)(GAS T*)(tabp(20) + (off)))
#define GRID_BAR() do { XcdBarrier b_; b_.bar = WSP(unsigned, WS_CTL) + CW_BAR; b_.x = xb_xcc_id(); b_.st = (volatile LAS unsigned*)(lds + MISC_OFF) + 8; xcd_barrier(b_, wv); } while (0)

#define PHASE_VARS const int tid = tid_of(wv); const int lane = tid & 63, wave = wv; \
    int bx = blockIdx.x; asm volatile("" : "+s"(bx)); const int GW = bx * 8 + wave, NGW = (int)gridDim.x * 8; LAS float* wscr = (LAS float*)(lds + wave * 8448); \
    (void)lane; (void)GW; (void)NGW; (void)wscr; (void)tid;
#define DENSE_ORDER 0
__device__ __forceinline__ unsigned dense_order(int i) {
    static constexpr unsigned char tab[64] = {31, 30, 29, 28, 27, 26, 25, 24, 23, 22, 21, 20, 19, 159, 18, 158, 17, 157, 156, 16, 155, 154, 15, 153, 14, 152, 151, 13, 150, 149, 12, 148, 11, 147, 146, 10, 145, 144, 9, 143, 8, 142, 141, 7, 140, 139, 6, 138, 5, 137, 136, 4, 135, 134, 3, 133, 2, 132, 131, 1, 130, 129, 0, 128};
    return tab[i];
}
template <int L> __device__ __forceinline__ void layer_fwd(LAS unsigned char* lds, const int wv) {

        {
            PHASE_VARS
            constexpr int I_IN = 32 * 352, I_KVB = 8 * 64, I_BR = 32 * 64, I_OUT = 32 * 64, I_GU = 32 * 352, I_DN = 88 * 64;
            constexpr int NITEMS = I_IN + I_KVB + I_BR + I_OUT + I_GU + I_DN;
#pragma unroll 1
            for (int it = GW; it < NITEMS; it += NGW) {
                int r = it;
                if (r < I_IN) { tr_item(INP(2) + (size_t)L * DM * INW, INW, DM, WSP(bf16_t, WS_WIN), 1, INP(1) + (size_t)L * DM, wscr, r, 352, lane); continue; } r -= I_IN;
                if (r < I_KVB) { tr_item(INP(12) + (size_t)L * 512 * 2048, 2048, 512, WSP(bf16_t, WS_WKVB), 0, nullptr, wscr, r, 64, lane); continue; } r -= I_KVB;
                if (r < I_BR) { tr_item(INP(14) + (size_t)L * DM * DM, DM, DM, WSP(bf16_t, WS_WBR), 0, nullptr, wscr, r, 64, lane); continue; } r -= I_BR;
                if (r < I_OUT) { tr_item(INP(15) + (size_t)L * DM * DM, DM, DM, WSP(bf16_t, WS_WOUT), 0, nullptr, wscr, r, 64, lane); continue; } r -= I_OUT;
                if (r < I_GU) { tr_item(INP(17) + (size_t)L * DM * 2 * DFF, 2 * DFF, DM, WSP(bf16_t, WS_WGU), 2, INP(16) + (size_t)L * DM, wscr, r, 352, lane); continue; } r -= I_GU;
                tr_item(INP(18) + (size_t)L * DFF * DM, DM, DFF, WSP(bf16_t, WS_WDN), 0, nullptr, wscr, r, 64, lane);
            }
            if (L == 0) {
                const float* x_in = INP(0); bf16_t* XB = WSP(bf16_t, WS_XB); float* ssq_attn = WSP(float, WS_CTL) + CW_SSQ;
#pragma unroll 1
                for (int t = GW; t < SEQ; t += NGW) {
                    const float* xr = x_in + (size_t)t * DM; float ss = 0.f;
#pragma unroll
                    for (int j = 0; j < 4; ++j) {
                        const int e = 8 * (lane + 64 * j);
                        const f32x4 a = *(const f32x4*)(xr + e), b = *(const f32x4*)(xr + e + 4);
                        ss += a[0] * a[0] + a[1] * a[1] + a[2] * a[2] + a[3] * a[3] + b[0] * b[0] + b[1] * b[1] + b[2] * b[2] + b[3] * b[3];
                        u32x4 wv; wv.x = pk2(a[0], a[1]); wv.y = pk2(a[2], a[3]); wv.z = pk2(b[0], b[1]); wv.w = pk2(b[2], b[3]);
                        *(u32x4*)(XB + (size_t)t * DM + e) = wv;
                    }
                    ss = wave_sum(ss);
                    if (lane == 0) ssq_attn[t] = ss;
                }
            }
        }
        if (L == 0) { asm volatile("s_waitcnt vmcnt(0)" ::: "memory"); __threadfence(); cg::this_grid().sync(); } else GRID_BAR();

        {
            pg8::Gemm g{WSP(bf16_t, WS_XB), WSP(bf16_t, WS_WIN), SEQ, NIN, DM, DM, DM}; pg8::StaticOrder S; { int bx_ = blockIdx.x; asm volatile("" : "+s"(bx_)); S.init(SEQ, NIN, gridDim.x, bx_); }
            pg8::Epi E{}; E.mode = pg8::EPI_INPROJ; E.obf = WSP(bf16_t, WS_P); E.ldo = NIN; E.f1 = WSP(float, WS_CTL) + CW_SSQ + (2 * L) * SEQ;
            pg8::gemm_phase(lds, g, S, E, wv);
        }
        GRID_BAR();

#ifdef PROBE_P1
        {
            pg8::Gemm g{WSP(bf16_t, WS_XB), WSP(bf16_t, WS_WIN), SEQ, NIN, DM, DM, DM}; pg8::StaticOrder S; { int bx_ = blockIdx.x; asm volatile("" : "+s"(bx_)); S.init(SEQ, NIN, gridDim.x, bx_); }
            pg8::Epi E{}; E.mode = pg8::EPI_INPROJ; E.obf = WSP(bf16_t, WS_P); E.ldo = NIN; E.f1 = WSP(float, WS_CTL) + CW_SSQ + (2 * L) * SEQ;
            pg8::gemm_phase(lds, g, S, E, wv);
        }
        GRID_BAR();

#endif
        {
            PHASE_VARS
            bf16_t* P = WSP(bf16_t, WS_P);
#pragma unroll 1
            for (int t = GW; t < SEQ; t += NGW) {
                bf16_t* pr = P + (size_t)t * NIN;
                LAS float* tab = wscr;
                bf16_t* hb = pr + C_CQ + (lane >> 3) * 192; const int c8 = lane & 7;
                const u32x4 l_aq = *(const u32x4*)(pr + C_AQ + 8 * lane), l_ak = *(const u32x4*)(pr + C_AK + 8 * lane), l_bq = *(const u32x4*)(pr + C_BQ + 8 * lane);
                const u32x4 l_bk = *(const u32x4*)(pr + C_BK + 8 * (lane & 15)), l_iq = *(const u32x4*)(pr + C_IQ + 8 * lane), l_ik = *(const u32x4*)(pr + C_IK + 8 * c8);
                const u32x4 l_kv = *(const u32x4*)(pr + C_CKV + 8 * lane);
                const u32x4 l_c0 = *(const u32x4*)(hb + 8 * c8), l_c1 = *(const u32x4*)(hb + 64 + 8 * c8), l_c2 = *(const u32x4*)(hb + 128 + 8 * c8);
                rope_table(tab, (float)t, lane);
                pp_chunk<64, 16, true>(l_aq, pr + C_AQ + 8 * lane, lane & 7, true, INP(3) + L * 64, tab, 0.125f * LOG2E);
                pp_chunk<64, 16, true>(l_ak, pr + C_AK + 8 * lane, lane & 7, true, INP(4) + L * 64, tab, 1.f);
                pp_chunk<128, 32, true>(l_bq, pr + C_BQ + 8 * lane, lane & 15, true, INP(7) + L * 128, tab + 8, 0.08838834764831845f * LOG2E);
                pp_chunk<128, 32, true>(l_bk, pr + C_BK + 8 * (lane & 15), lane & 15, lane < 16, INP(8) + L * 128, tab + 8, 1.f);
                pp_chunk<64, 16, false>(l_iq, pr + C_IQ + 8 * lane, lane & 7, true, nullptr, tab, 1.f);
                pp_chunk<64, 16, true>(l_ik, WSP(bf16_t, WS_IKC) + ((size_t)(((t >> 5) * 4 + (c8 >> 1)) * 64 + (c8 & 1) * 32 + (t & 31))) * 8, c8, lane < 8, INP(9) + L * 64, tab, 1.f);
                pp_chunk<512, 0, true>(l_kv, pr + C_CKV + 8 * lane, lane, true, INP(11) + L * 512, tab, 1.f);
                pp_head192(l_c0, l_c1, l_c2, hb, c8, INP(10) + L * 192, tab + 24, 0.07216878364870323f * LOG2E);
                LDS_WAIT(); asm volatile("" ::: "memory");
            }
            bf16_t* VTA = WSP(bf16_t, WS_VTA);
#pragma unroll 1
            for (int it = GW; it < 128 * 8; it += NGW) {
                const int tb = it >> 3, cb = it & 7;
                trb_item(P + (size_t)(64 * tb) * NIN + C_AV + 64 * cb, NIN, VTA + (size_t)(64 * cb) * SEQ + 64 * tb, SEQ, (LAS unsigned short*)wscr, lane);
            }
        }
        GRID_BAR();

        {
            pg8::Gemm g{WSP(bf16_t, WS_P) + C_CKV, WSP(bf16_t, WS_WKVB), SEQ, 2048, 512, NIN, 512}; pg8::StaticOrder S; { int bx_ = blockIdx.x; asm volatile("" : "+s"(bx_)); S.init(SEQ, 2048, gridDim.x, bx_); }
            pg8::Epi E{}; E.mode = pg8::EPI_PLAIN; E.obf = WSP(bf16_t, WS_KVB); E.ldo = 2048;
            pg8::gemm_phase(lds, g, S, E, wv);
        }
        GRID_BAR();

        {
            PHASE_VARS
            const bf16_t* P = WSP(bf16_t, WS_P); const bf16_t* KVB = WSP(bf16_t, WS_KVB); bf16_t* KC = WSP(bf16_t, WS_KC); bf16_t* VTC = WSP(bf16_t, WS_VTC);
            const float* c_k_norm = INP(13) + L * 192;
#pragma unroll 1
            for (int t = GW; t < SEQ; t += NGW) {
                const int h = lane >> 3, ci = lane & 7;
                const bf16_t* kv = KVB + (size_t)t * 2048 + h * 256;
                const u32x4 a0 = *(const u32x4*)(P + (size_t)t * NIN + C_CKR + 8 * ci), a1 = *(const u32x4*)(kv + 8 * ci), a2 = *(const u32x4*)(kv + 64 + 8 * ci);
                LAS float* tab = wscr;
                rope_table(tab, (float)t, lane);
                pp_head192(a0, a1, a2, KC + (size_t)t * 1536 + h * 192, ci, c_k_norm, tab + 24, 1.f);
                LDS_WAIT(); asm volatile("" ::: "memory");
            }
#pragma unroll 1
            for (int it = GW; it < 128 * 16; it += NGW) {
                const int tb = it >> 4, cb = it & 15, h = cb >> 1, d0 = (cb & 1) * 64;
                trb_item(KVB + (size_t)(64 * tb) * 2048 + h * 256 + 128 + d0, 2048, VTC + (size_t)(h * 128 + d0) * SEQ + 64 * tb, SEQ, (LAS unsigned short*)wscr, lane);
            }
        }
        GRID_BAR();

#define RUN_P5(QSLOT, ITEM_LO, ITEM_HI, DSAMODE) { \
            const int xq = (int)(xb_xcc_id() & 7u);       \
            int dx = ((ITEM_LO) == 0) ? 0 : 8;             \
            _Pragma("unroll 1") for (;;) { \
                PHASE_VARS \
                volatile LAS unsigned* MISC = (volatile LAS unsigned*)(lds + MISC_OFF); \
                int item = -1, dj = 0, dqb = 0; \
                while (dx < 8) { \
                    const int xs = (xq + dx) & 7; \
                    __syncthreads(); \
                    if (tid == 0) MISC[16] = atomicAdd(WSP(unsigned, WS_CTL) + CW_Q + 64 * (16 + 8 * (QSLOT) + xs), 1u); \
                    __syncthreads(); \
                    const int di = (int)__builtin_amdgcn_readfirstlane(MISC[16]); \
                    if (di < 64) { const unsigned e = dense_order(di); dj = (e >> 7) ? 8 + xs : xs; dqb = (int)(e & 31u); item = 0; break; } \
                    ++dx; \
                } \
                if (item < 0) { \
                    __syncthreads(); \
                    if (tid == 0) MISC[16] = atomicAdd(WSP(unsigned, WS_CTL) + CW_Q + 64 * (QSLOT), 1u); \
                    __syncthreads(); \
                    item = 512 + (int)__builtin_amdgcn_readfirstlane(MISC[16]); \
                    if (item >= (ITEM_HI)) break; \
                } \
                bf16_t* P = WSP(bf16_t, WS_P); bf16_t* AO = WSP(bf16_t, WS_AO); \
                if (item < 512) { \
                    const int qb = dqb, j = dj; \
                    if (j < 8) attn_unit<192>(lds, P + C_CQ + j * 192, NIN, WSP(bf16_t, WS_KC) + j * 192, 1536, WSP(bf16_t, WS_VTC) + (size_t)j * 128 * SEQ, qb, nullptr, 0, AO + 1024 + j * 128, DM, wv); \
                    else { const int hm = j - 8; attn_unit<64>(lds, P + C_AQ + hm * 64, NIN, P + C_AK + hm * 64, NIN, WSP(bf16_t, WS_VTA) + (size_t)(hm >> 1) * 128 * SEQ, qb, WSP(float, WS_OA32) + hm * 128, 1024, nullptr, 0, wv); } \
                } else { \
                    const int t0 = (511 - (item - 512)) * 16; \
                    dsa_item<DSAMODE>(lds, P, WSP(bf16_t, WS_IKC), WSP(float, WS_SCR) + (size_t)bx * 16 * SEQ, WSP(unsigned short, WS_SCR16) + (size_t)bx * 16 * SEQ, (DSAMODE == 15 ? AO + 512 : WSP(bf16_t, WS_OA32)), t0, wv); \
                } \
            } \
        }
        RUN_P5(L, 0, 1024, 15)
#ifdef PROBE_DENSE
        GRID_BAR();
        RUN_P5(L + 2, 0, 512, 15)
#endif
#ifdef PROBE_P5
        GRID_BAR();
        RUN_P5(L + 6, 0, 1024, 15)
#endif
#ifdef PROBE_DSA
        GRID_BAR();
        RUN_P5(L + 4, 512, 1024, PROBE_DSA)
#endif
        GRID_BAR();

        {
            PHASE_VARS
            const float lam_init = (L == 0) ? 0.2f : (0.8f - 0.6f * 0.7408182206817179f);
            const float* a_lambda = INP(5) + L * 256; const float* a_sub_norm = INP(6) + L * 128;
            const float* OA32 = WSP(float, WS_OA32); bf16_t* AO = WSP(bf16_t, WS_AO);
            float lam;
            { const float a = a_lambda[lane] * a_lambda[64 + lane], b = a_lambda[128 + lane] * a_lambda[192 + lane];
              lam = expf(wave_sum(a)) - expf(wave_sum(b)) + lam_init; }
            const float g0 = a_sub_norm[2 * lane], g1 = a_sub_norm[2 * lane + 1];
#pragma unroll 1
            for (int t = GW; t < SEQ; t += NGW) {
                float a1[4][2], a2[4][2];
#pragma unroll
                for (int h = 0; h < 4; ++h) {
                    const float* o1 = OA32 + (size_t)t * 1024 + (2 * h) * 128 + 2 * lane;
                    a1[h][0] = o1[0]; a1[h][1] = o1[1]; a2[h][0] = o1[128]; a2[h][1] = o1[129];
                }
#pragma unroll
                for (int h = 0; h < 4; ++h) {
                    const float d0 = a1[h][0] - lam * a2[h][0], d1 = a1[h][1] - lam * a2[h][1];
                    const float ss = wave_sum(d0 * d0 + d1 * d1);
                    const float r = (1.0f / sqrtf(ss * (1.f / 128.f) + NORM_EPS)) * (1.f - lam_init);
                    *(unsigned*)(AO + (size_t)t * DM + h * 128 + 2 * lane) = pk2(d0 * r * g0, d1 * r * g1);
                }
            }
        }
        GRID_BAR();

#pragma unroll 1
        for (int br = 0; br < 3; ++br) {
            pg8::StaticOrder S; { int bx_ = blockIdx.x; asm volatile("" : "+s"(bx_)); S.init(SEQ, DM, gridDim.x, bx_); }
            const int ko = (br == 2) ? 1024 : 512 * br;
            pg8::Gemm g{WSP(bf16_t, WS_AO) + ko, WSP(bf16_t, WS_WBR) + ko, SEQ, DM, (br == 2) ? 1024 : 512, DM, DM};
            pg8::Epi E{}; E.mode = pg8::EPI_BR0 + br; E.gate = WSP(bf16_t, WS_P) + C_G + br * DM; E.ldg = NIN; E.f0 = WSP(float, WS_SCR); E.obf = WSP(bf16_t, WS_MG); E.ldo = DM;
            pg8::gemm_phase(lds, g, S, E, wv);
        }
        GRID_BAR();

        {
            pg8::Gemm g{WSP(bf16_t, WS_MG), WSP(bf16_t, WS_WOUT), SEQ, DM, DM, DM, DM}; pg8::StaticOrder S; { int bx_ = blockIdx.x; asm volatile("" : "+s"(bx_)); S.init(SEQ, DM, gridDim.x, bx_); }
            pg8::Epi E{}; E.mode = pg8::EPI_RESID; E.f1 = (L == 0) ? INP(0) : (const float*)(const GAS float*)tabp(19); E.f0 = (float*)(GAS float*)tabp(19); E.obf = WSP(bf16_t, WS_XB); E.ldo = DM;
            E.f2 = WSP(float, WS_CTL) + CW_SSQ + (2 * L + 1) * SEQ;
            pg8::gemm_phase(lds, g, S, E, wv);
        }
        GRID_BAR();

        {
            pg8::Gemm g{WSP(bf16_t, WS_XB), WSP(bf16_t, WS_WGU), SEQ, NGU, DM, DM, DM}; pg8::StaticOrder S; { int bx_ = blockIdx.x; asm volatile("" : "+s"(bx_)); S.init(SEQ, NGU, gridDim.x, bx_); }
            pg8::Epi E{}; E.mode = pg8::EPI_SWIGLU; E.obf = WSP(bf16_t, WS_P); E.ldo = DFF; E.f1 = WSP(float, WS_CTL) + CW_SSQ + (2 * L + 1) * SEQ;
            pg8::gemm_phase(lds, g, S, E, wv);
        }
        GRID_BAR();

#ifdef PROBE_P9
        {
            pg8::Gemm g{WSP(bf16_t, WS_XB), WSP(bf16_t, WS_WGU), SEQ, NGU, DM, DM, DM}; pg8::StaticOrder S; { int bx_ = blockIdx.x; asm volatile("" : "+s"(bx_)); S.init(SEQ, NGU, gridDim.x, bx_); }
            pg8::Epi E{}; E.mode = pg8::EPI_SWIGLU; E.obf = WSP(bf16_t, WS_P); E.ldo = DFF; E.f1 = WSP(float, WS_CTL) + CW_SSQ + (2 * L + 1) * SEQ;
            pg8::gemm_phase(lds, g, S, E, wv);
        }
        GRID_BAR();

#endif
        {
            pg8::Gemm g{WSP(bf16_t, WS_P), WSP(bf16_t, WS_WDN), SEQ, DM, DFF, DFF, DFF}; pg8::StaticOrder S; { int bx_ = blockIdx.x; asm volatile("" : "+s"(bx_)); S.init(SEQ, DM, gridDim.x, bx_); }
            pg8::Epi E{}; E.mode = pg8::EPI_RESID; E.f1 = (const float*)(const GAS float*)tabp(19); E.f0 = (float*)(GAS float*)tabp(19); E.obf = WSP(bf16_t, WS_XB); E.ldo = DM;
            E.f2 = WSP(float, WS_CTL) + CW_SSQ + (2 * L + 2) * SEQ;
            pg8::gemm_phase(lds, g, S, E, wv);
        }
        GRID_BAR();

}

__global__ void __launch_bounds__(512) fwd_kernel(Args args) {
    extern __shared__ __attribute__((aligned(16))) unsigned char lds_raw[];
    LAS unsigned char* lds = (LAS unsigned char*)lds_raw;
    const int wv = __builtin_amdgcn_readfirstlane((int)(threadIdx.x >> 6));
    {
        const int tid = tid_of(wv);
        volatile LAS unsigned* MISC = (volatile LAS unsigned*)(lds + MISC_OFF);
        for (int u = tid; u < 64; u += 512) MISC[u] = 0u;
        if (tid < 21) {
            const unsigned long long v = (tid < 19) ? (unsigned long long)args.in[tid] : (tid == 19 ? (unsigned long long)args.out : (unsigned long long)args.ws);
            volatile LAS unsigned* p = (volatile LAS unsigned*)(lds + TAB_OFF + 8 * tid);
            p[0] = (unsigned)v; p[1] = (unsigned)(v >> 32);
        }
        __syncthreads();
        (void)xcd_barrier_post(WSP(unsigned, WS_CTL) + CW_BAR, MISC + 8);
    }

    layer_fwd<0>(lds, wv);
    layer_fwd<1>(lds, wv);
}

extern "C" void kernel_launch(void* const* d_in, const int* in_sizes, int n_in, void* d_out, int out_size, void* d_ws, size_t ws_size, hipStream_t stream) {
    static int grid = 0;
    if (grid == 0) {
        if (n_in != 19 || ws_size < WS_END) { fprintf(stderr, "kernel_launch: unexpected inputs (n_in %d, ws %zu, need %zu)\n", n_in, ws_size, (size_t)WS_END); grid = -1; return; }
        int dev = 0, cus = 0, per_cu = 0;
        hipGetDevice(&dev);
        hipDeviceGetAttribute(&cus, hipDeviceAttributeMultiprocessorCount, dev);
        hipFuncSetAttribute((const void*)fwd_kernel, hipFuncAttributeMaxDynamicSharedMemorySize, LDS_BYTES);
        hipOccupancyMaxActiveBlocksPerMultiprocessor(&per_cu, (const void*)fwd_kernel, 512, LDS_BYTES);
        (void)hipGetLastError();
        if (per_cu < 1) per_cu = 1;
        grid = cus;
        if (grid > 256) grid = 256;
    }
    if (grid < 0) return;
    hipMemsetAsync((char*)d_ws + WS_CTL, 0, CTL_BYTES, stream);
    Args a{};
    for (int i = 0; i < 19; ++i) a.in[i] = (const float*)d_in[i];
    a.out = (float*)d_out; a.ws = (unsigned char*)d_ws;
    void* kargs[] = {&a};
    hipError_t e = hipLaunchCooperativeKernel((const void*)fwd_kernel, dim3(grid), dim3(512), kargs, LDS_BYTES, stream);
    if (e != hipSuccess) fprintf(stderr, "cooperative launch failed: %s (grid %d)\n", hipGetErrorString(e), grid);
}
```

```cpp
#include <hip/hip_runtime.h>
#include <hip/hip_cooperative_groups.h>
#include <cstdio>
#include <cstdint>
namespace cg = cooperative_groups;

#define GAS __attribute__((address_space(1)))
#define LAS __attribute__((address_space(3)))
typedef unsigned short bf16_t;
typedef short bf16x8 __attribute__((ext_vector_type(8)));
typedef float f32x4 __attribute__((ext_vector_type(4)));
typedef float f32x16 __attribute__((ext_vector_type(16)));
typedef unsigned u32x4 __attribute__((ext_vector_type(4)));
typedef unsigned u32x2 __attribute__((ext_vector_type(2)));

constexpr int SEQ = 8192, DM = 2048, NIN = 11264, DFF = 5632, NGU = 11264, INW = 11144;
constexpr int C_AQ = 0, C_AK = 512, C_AV = 1024, C_BQ = 1536, C_BK = 2048, C_BV = 2176, C_IQ = 2304, C_IK = 2816, C_CKR = 2880,
              C_CQ = 2944, C_CKV = 4480, C_IW = 4992, C_G = 5120;
constexpr float NORM_EPS = 1e-6f;
constexpr float LOG2E = 1.4426950408889634f;
constexpr float LOG2_THETA = 18.931568569324174f;

constexpr size_t MiB = 1u << 20;
constexpr size_t WS_CTL = 0, CTL_BYTES = 1 * MiB;
constexpr size_t WS_WIN = 1 * MiB;
constexpr size_t WS_WKVB = WS_WIN + 44 * MiB;
constexpr size_t WS_WBR = WS_WKVB + 2 * MiB;
constexpr size_t WS_WOUT = WS_WBR + 8 * MiB;
constexpr size_t WS_WGU = WS_WOUT + 8 * MiB;
constexpr size_t WS_WDN = WS_WGU + 44 * MiB;
constexpr size_t WS_P = WS_WDN + 22 * MiB;
constexpr size_t WS_XB = WS_P + 176 * MiB;
constexpr size_t WS_AO = WS_XB + 32 * MiB;
constexpr size_t WS_KC = WS_AO + 32 * MiB;
constexpr size_t WS_VTC = WS_KC + 24 * MiB;
constexpr size_t WS_VTA = WS_VTC + 16 * MiB;
constexpr size_t WS_KVB = WS_VTA + 8 * MiB;
constexpr size_t WS_MG = WS_KVB + 32 * MiB;
constexpr size_t WS_OA32 = WS_MG + 32 * MiB;
constexpr size_t WS_SCR = WS_OA32 + 32 * MiB;
constexpr size_t WS_IKC = WS_SCR + 128 * MiB;
constexpr size_t WS_SCR16 = WS_KVB;
constexpr size_t WS_END = WS_IKC + 1 * MiB;
static_assert(WS_END <= 704 * MiB, "workspace");
constexpr int CW_BAR = 4096;
constexpr int CW_Q = 8192;
constexpr int CW_SSQ = 16384;

__device__ __forceinline__ unsigned f2bf(float f) { unsigned u = __builtin_bit_cast(unsigned, f); return (u + 0x7fffu + ((u >> 16) & 1u)) >> 16; }
__device__ __forceinline__ unsigned pk2(float lo, float hi) { return f2bf(lo) | (f2bf(hi) << 16); }
__device__ __forceinline__ float bf2f(unsigned short b) { return __builtin_bit_cast(float, (unsigned)b << 16); }
__device__ __forceinline__ unsigned cvt_pk_bf16(float lo, float hi) { unsigned r; asm volatile("v_cvt_pk_bf16_f32 %0, %1, %2" : "=v"(r) : "v"(lo), "v"(hi)); return r; }
__device__ __forceinline__ void unpack8(u32x4 w, float* x) {
    x[0] = __builtin_bit_cast(float, w.x << 16); x[1] = __builtin_bit_cast(float, w.x & 0xffff0000u);
    x[2] = __builtin_bit_cast(float, w.y << 16); x[3] = __builtin_bit_cast(float, w.y & 0xffff0000u);
    x[4] = __builtin_bit_cast(float, w.z << 16); x[5] = __builtin_bit_cast(float, w.z & 0xffff0000u);
    x[6] = __builtin_bit_cast(float, w.w << 16); x[7] = __builtin_bit_cast(float, w.w & 0xffff0000u);
}
__device__ __forceinline__ u32x4 pack8(const float* x) { u32x4 w; w.x = pk2(x[0], x[1]); w.y = pk2(x[2], x[3]); w.z = pk2(x[4], x[5]); w.w = pk2(x[6], x[7]); return w; }
__device__ __forceinline__ float wave_sum_dpp(float x);
__device__ __forceinline__ float wave_sum(float v) { return wave_sum_dpp(v); }


template <int CTRL> __device__ __forceinline__ float dppf(float x) { return __builtin_bit_cast(float, __builtin_amdgcn_update_dpp(0, __builtin_bit_cast(int, x), CTRL, 0xf, 0xf, false)); }
__device__ __forceinline__ float rdl(float x, int l) { return __builtin_bit_cast(float, __builtin_amdgcn_readlane(__builtin_bit_cast(int, x), l)); }
__device__ __forceinline__ float wave_max_dpp(float x) {
    x = fmaxf(x, dppf<0xB1>(x)); x = fmaxf(x, dppf<0x4E>(x)); x = fmaxf(x, dppf<0x141>(x)); x = fmaxf(x, dppf<0x140>(x));
    return fmaxf(fmaxf(rdl(x, 0), rdl(x, 16)), fmaxf(rdl(x, 32), rdl(x, 48)));
}
__device__ __forceinline__ float wave_sum_dpp(float x) {
    x += dppf<0xB1>(x); x += dppf<0x4E>(x); x += dppf<0x141>(x); x += dppf<0x140>(x);
    return (rdl(x, 0) + rdl(x, 16)) + (rdl(x, 32) + rdl(x, 48));
}
__device__ __forceinline__ float xhalf_max(float m) {
    unsigned a = __builtin_bit_cast(unsigned, m), b = a; asm volatile("" : "+v"(b));
    auto rr = __builtin_amdgcn_permlane32_swap(a, b, false, false);
    unsigned r0 = rr[0], r1 = rr[1]; asm volatile("" : "+v"(r0), "+v"(r1));
    return fmaxf(__builtin_bit_cast(float, r0), __builtin_bit_cast(float, r1)); }
__device__ __forceinline__ float xhalf_sum(float m) {
    unsigned a = __builtin_bit_cast(unsigned, m), b = a; asm volatile("" : "+v"(b));
    auto rr = __builtin_amdgcn_permlane32_swap(a, b, false, false);
    unsigned r0 = rr[0], r1 = rr[1]; asm volatile("" : "+v"(r0), "+v"(r1));
    return __builtin_bit_cast(float, r0) + __builtin_bit_cast(float, r1); }
template <int O> __device__ __forceinline__ float swz_xor(float x) { return __builtin_bit_cast(float, __builtin_amdgcn_ds_swizzle(__builtin_bit_cast(int, x), 0x1F | (O << 10))); }
__device__ __forceinline__ float fexp2(float x) { return __builtin_amdgcn_exp2f(x); }
__device__ __forceinline__ int tid_of(int wv) { int l = (int)__builtin_amdgcn_mbcnt_hi(~0u, __builtin_amdgcn_mbcnt_lo(~0u, 0u)); asm volatile("" : "+v"(l)); return wv * 64 + l; }
#define LDS_WAIT() asm volatile("s_waitcnt lgkmcnt(0)" ::: "memory")

namespace pg8 {
constexpr int BM = 256, BK = 64, HALF = 128, HTB = HALF * BK * 2, STAGE_BYTES = 8 * HTB, NXCD = 8, WGM = 8;
__host__ __device__ __forceinline__ int lds_byte(int r, int c) { const int st = (r >> 4) * 2 + (c >> 5), rr = r & 15, cc = c & 31, ob = rr * 64 + cc * 2; return st * 1024 + (ob ^ (((ob >> 9) & 1) << 5)); }
__host__ __device__ __forceinline__ void stage_rc(int b, int& R, int& C) { const int st = b / 1024, sb = b % 1024, swz = sb ^ (((sb >> 9) & 1) << 5); R = (st >> 1) * 16 + swz / 64; C = (st & 1) * 32 + (swz % 64) / 2; }
__host__ __device__ __forceinline__ int perm32(int rho) { const int n = rho >> 4, i = rho & 15; return 8 * (i >> 2) + 4 * n + (i & 3); }
struct Unit { int pm, pn; };
struct Gemm { const bf16_t* A; const bf16_t* Bt; int M, N, K, lda, ldb; };
struct StaticOrder {
    int nM, nN, nwg, G, c;
    __device__ void init(int M, int N, int G_, int c_) { nM = M / BM; nN = N / BM; nwg = nM * nN; G = G_; c = c_; }
    __device__ bool next(int i, Unit& u) const {
        const long L = (long)i * G + c; if (L >= nwg) return false;
        int wgid = (int)L; { const int q = nwg / NXCD, r = nwg % NXCD, xcd = wgid % NXCD, off = wgid / NXCD; wgid = (xcd < r ? xcd * (q + 1) : r * (q + 1) + (xcd - r) * q) + off; }
        const int nig = WGM * nN, gid = wgid / nig, fm = gid * WGM, gsz = (nM - fm) < WGM ? (nM - fm) : WGM;
        u.pm = fm + ((wgid % nig) % gsz); u.pn = (wgid % nig) / gsz; return true;
    }
};

enum { EPI_INPROJ = 0, EPI_PLAIN = 1, EPI_BR0 = 2, EPI_BR1 = 3, EPI_BR2 = 4, EPI_RESID = 5, EPI_SWIGLU = 6 };
struct Epi {
    int mode, ldo, ldg;
    bf16_t* obf;
    const bf16_t* gate;
    float* f0;
    const float* f1;
    float* f2;
    __device__ __forceinline__ void operator()(const f32x4 (&acc)[2][2][4][2], const Unit& u, int wr, int wc, int fr, int fq) const {
        const int row0 = u.pm * BM + wr * 64 + fr;
        const int colt = u.pn * BM + wc * 32 + 8 * fq;
        if (mode == EPI_INPROJ || mode == EPI_PLAIN) {
            const bool sg = (mode == EPI_INPROJ) && (u.pn * BM >= C_G);
            float rs[2][4];
#pragma unroll
            for (int ai = 0; ai < 2; ++ai)
#pragma unroll
                for (int m = 0; m < 4; ++m) rs[ai][m] = (mode == EPI_INPROJ) ? f1[row0 + ai * HALF + m * 16] : 0.f;
#pragma unroll
            for (int ai = 0; ai < 2; ++ai)
#pragma unroll
                for (int m = 0; m < 4; ++m) {
                    const int row = row0 + ai * HALF + m * 16;
                    float r = 1.f;
                    if (mode == EPI_INPROJ) r = __builtin_amdgcn_rsqf(rs[ai][m] * (1.f / DM) + NORM_EPS);
#pragma unroll
                    for (int bj = 0; bj < 2; ++bj) {
                        float v[8];
#pragma unroll
                        for (int j = 0; j < 4; ++j) { v[j] = acc[ai][bj][m][0][j] * r; v[4 + j] = acc[ai][bj][m][1][j] * r; }
                        if (sg) {
#pragma unroll
                            for (int j = 0; j < 8; ++j) v[j] = __builtin_amdgcn_rcpf(1.f + __expf(-v[j]));
                        }
                        u32x4 w; w.x = cvt_pk_bf16(v[0], v[1]); w.y = cvt_pk_bf16(v[2], v[3]); w.z = cvt_pk_bf16(v[4], v[5]); w.w = cvt_pk_bf16(v[6], v[7]);
                        *(u32x4*)(obf + (size_t)row * ldo + colt + bj * HALF) = w;
                    }
                }
        } else if (mode == EPI_BR0 || mode == EPI_BR1 || mode == EPI_BR2) {
#pragma unroll
            for (int ai = 0; ai < 2; ++ai)
#pragma unroll
                for (int mh = 0; mh < 2; ++mh) {
                    u32x4 gw[2][2], pw[2][2];
#pragma unroll
                    for (int mm = 0; mm < 2; ++mm)
#pragma unroll
                        for (int bj = 0; bj < 2; ++bj) {
                            const int row = row0 + ai * HALF + (2 * mh + mm) * 16, col = colt + bj * HALF;
                            gw[mm][bj] = *(const u32x4*)(gate + (size_t)row * ldg + col);
                            if (mode != EPI_BR0) pw[mm][bj] = *(const u32x4*)((const bf16_t*)f0 + (size_t)row * DM + col);
                        }
#pragma unroll
                    for (int mm = 0; mm < 2; ++mm)
#pragma unroll
                        for (int bj = 0; bj < 2; ++bj) {
                            const int m = 2 * mh + mm;
                            const int row = row0 + ai * HALF + m * 16, col = colt + bj * HALF;
                            float g[8]; unpack8(gw[mm][bj], g);
                            float v[8];
#pragma unroll
                            for (int j = 0; j < 4; ++j) { v[j] = acc[ai][bj][m][0][j] * g[j]; v[4 + j] = acc[ai][bj][m][1][j] * g[4 + j]; }
                            if (mode != EPI_BR0) {
                                float pp[8]; unpack8(pw[mm][bj], pp);
#pragma unroll
                                for (int j = 0; j < 8; ++j) v[j] += pp[j];
                            }
                            u32x4 w; w.x = cvt_pk_bf16(v[0], v[1]); w.y = cvt_pk_bf16(v[2], v[3]); w.z = cvt_pk_bf16(v[4], v[5]); w.w = cvt_pk_bf16(v[6], v[7]);
                            if (mode == EPI_BR2) *(u32x4*)(obf + (size_t)row * ldo + col) = w;
                            else *(u32x4*)((bf16_t*)f0 + (size_t)row * DM + col) = w;
                        }
                }
        } else if (mode == EPI_RESID) {
#pragma unroll
            for (int ai = 0; ai < 2; ++ai)
#pragma unroll
                for (int mh = 0; mh < 2; ++mh) {
                    f32x4 x0[2][2], x1[2][2];
#pragma unroll
                    for (int mm = 0; mm < 2; ++mm)
#pragma unroll
                        for (int bj = 0; bj < 2; ++bj) {
                            const float* xp = f1 + (size_t)(row0 + ai * HALF + (2 * mh + mm) * 16) * DM + colt + bj * HALF;
                            x0[mm][bj] = *(const f32x4*)xp; x1[mm][bj] = *(const f32x4*)(xp + 4);
                        }
#pragma unroll
                    for (int mm = 0; mm < 2; ++mm) {
                        const int m = 2 * mh + mm;
                        const int row = row0 + ai * HALF + m * 16;
                        float ss = 0.f;
#pragma unroll
                        for (int bj = 0; bj < 2; ++bj) {
                            const int col = colt + bj * HALF;
                            float v[8];
#pragma unroll
                            for (int j = 0; j < 4; ++j) { v[j] = acc[ai][bj][m][0][j] + x0[mm][bj][j]; v[4 + j] = acc[ai][bj][m][1][j] + x1[mm][bj][j]; }
#pragma unroll
                            for (int j = 0; j < 8; ++j) ss += v[j] * v[j];
                            float* op = f0 + (size_t)row * DM + col;
                            *(f32x4*)op = (f32x4){v[0], v[1], v[2], v[3]}; *(f32x4*)(op + 4) = (f32x4){v[4], v[5], v[6], v[7]};
                            u32x4 w; w.x = cvt_pk_bf16(v[0], v[1]); w.y = cvt_pk_bf16(v[2], v[3]); w.z = cvt_pk_bf16(v[4], v[5]); w.w = cvt_pk_bf16(v[6], v[7]);
                            *(u32x4*)(obf + (size_t)row * ldo + col) = w;
                        }
                        ss += swz_xor<16>(ss); ss = xhalf_sum(ss);
                        if (fq == 0) atomicAdd(f2 + row, ss);
                    }
                }
        } else {
            const int colh = u.pn * HALF + wc * 32 + 8 * fq;
            float rs[2][4];
#pragma unroll
            for (int ai = 0; ai < 2; ++ai)
#pragma unroll
                for (int m = 0; m < 4; ++m) rs[ai][m] = f1[row0 + ai * HALF + m * 16];
#pragma unroll
            for (int ai = 0; ai < 2; ++ai)
#pragma unroll
                for (int m = 0; m < 4; ++m) {
                    const int row = row0 + ai * HALF + m * 16;
                    const float r = __builtin_amdgcn_rsqf(rs[ai][m] * (1.f / DM) + NORM_EPS);
                    float v[8];
#pragma unroll
                    for (int n = 0; n < 2; ++n)
#pragma unroll
                        for (int j = 0; j < 4; ++j) {
                            const float g = acc[ai][0][m][n][j] * r, up = acc[ai][1][m][n][j] * r;
                            v[4 * n + j] = g * __builtin_amdgcn_rcpf(1.f + __expf(-g)) * up;
                        }
                    u32x4 w; w.x = cvt_pk_bf16(v[0], v[1]); w.y = cvt_pk_bf16(v[2], v[3]); w.z = cvt_pk_bf16(v[4], v[5]); w.w = cvt_pk_bf16(v[6], v[7]);
                    *(u32x4*)(obf + (size_t)row * ldo + colh) = w;
                }
        }
    }
};

__device__ __forceinline__ void gemm_phase(LAS unsigned char* lds, const Gemm g, const StaticOrder& S, const Epi& E, int wv) {
    const int tid = tid_of(wv);
    const int wid = __builtin_amdgcn_readfirstlane(tid >> 6), lane = tid & 63, wr = wid >> 2, wc = wid & 3, fr = lane & 15, fq = lane >> 4;
    const int K = g.K, nt = K / BK;
    unsigned voffA[2], voffB[2];
#pragma unroll
    for (int i = 0; i < 2; ++i) { int R, C; stage_rc(tid * 16 + i * 8192, R, C); const int Rb = (R & ~31) + perm32(R & 31);
        voffA[i] = (unsigned)(R * g.lda + C) * 2u; voffB[i] = (unsigned)(Rb * g.ldb + C) * 2u; }
    const size_t kstep = (size_t)(BK * 2);
    const size_t hstepA = (size_t)HALF * g.lda * 2, hstepB = (size_t)HALF * g.ldb * 2;
    const size_t tstepA = 2 * hstepA, tstepB = 2 * hstepB;
    const unsigned ldsw = (unsigned)wid * 1024u;
    const int aoff = lds_byte(wr * 64 + fr, fq * 8), boff = lds_byte(wc * 32 + fr, fq * 8);
#define PG8_SA(b, h) (((b) * 2 + (h)) * HTB)
#define PG8_SB(b, h) ((4 + (b) * 2 + (h)) * HTB)
#define PG8_STAGE(bufoff, gbase, voff) do { _Pragma("unroll") for (int _i = 0; _i < 2; ++_i) \
        __builtin_amdgcn_global_load_lds((const unsigned*)((const char*)(gbase) + (voff)[_i]), (LAS unsigned*)(lds + (bufoff) + ldsw + _i * 8192), 16, 0, 0); } while (0)
#define PG8_LDA(dst, b, h) do { _Pragma("unroll") for (int m = 0; m < 4; ++m) _Pragma("unroll") for (int k = 0; k < 2; ++k) dst[m][k] = *(const LAS bf16x8*)(lds + PG8_SA(b, h) + aoff + m * 2048 + k * 1024); } while (0)
#define PG8_LDB(dst, b, h) do { _Pragma("unroll") for (int n = 0; n < 2; ++n) _Pragma("unroll") for (int k = 0; k < 2; ++k) dst[n][k] = *(const LAS bf16x8*)(lds + PG8_SB(b, h) + boff + n * 2048 + k * 1024); } while (0)
#define PG8_MMA(ai, bj, At, Bt) do { __builtin_amdgcn_s_setprio(1); _Pragma("unroll") for (int m = 0; m < 4; ++m) _Pragma("unroll") for (int n = 0; n < 2; ++n) _Pragma("unroll") for (int k = 0; k < 2; ++k) \
        acc[ai][bj][m][n] = __builtin_amdgcn_mfma_f32_16x16x32_bf16(Bt[n][k], At[m][k], acc[ai][bj][m][n], 0, 0, 0); __builtin_amdgcn_s_setprio(0); } while (0)
#define PG8_WAIT_V(n) asm volatile("s_waitcnt vmcnt(" #n ")" ::: "memory")
#define PG8_WAIT_L(n) asm volatile("s_waitcnt lgkmcnt(" #n ")" ::: "memory")
#define PG8_BAR __builtin_amdgcn_s_barrier()
#define PG8_SCHED __builtin_amdgcn_sched_barrier(0)
    Unit cur, nxt; int ui = 0;
    if (!S.next(0, cur)) return;
    f32x4 acc[2][2][4][2];
#pragma unroll
    for (int a = 0; a < 2; ++a)
#pragma unroll
        for (int b = 0; b < 2; ++b)
#pragma unroll
            for (int m = 0; m < 4; ++m)
#pragma unroll
                for (int n = 0; n < 2; ++n) acc[a][b][m][n] = (f32x4){0.f, 0.f, 0.f, 0.f};
    bf16x8 At[4][2], B0[2][2], B1[2][2];
    const char* cA = (const char*)g.A + (size_t)cur.pm * tstepA; const char* cB = (const char*)g.Bt + (size_t)cur.pn * tstepB;
    PG8_STAGE(PG8_SB(0, 0), cB, voffB); PG8_STAGE(PG8_SB(0, 1), cB + hstepB, voffB); PG8_STAGE(PG8_SA(0, 0), cA, voffA); PG8_STAGE(PG8_SA(0, 1), cA + hstepA, voffA);
    if (wr == 1) PG8_BAR;
    PG8_WAIT_V(2); PG8_BAR;
    PG8_STAGE(PG8_SB(1, 0), cB + kstep, voffB); PG8_STAGE(PG8_SA(1, 0), cA + kstep, voffA); PG8_STAGE(PG8_SB(1, 1), cB + hstepB + kstep, voffB);
    PG8_WAIT_V(6); PG8_BAR;
    for (;;) {
        const bool has_next = S.next(ui + 1, nxt);
        const char* nA = has_next ? (const char*)g.A + (size_t)nxt.pm * tstepA : cA; const char* nB = has_next ? (const char*)g.Bt + (size_t)nxt.pn * tstepB : cB;
        for (int t = 0; t < nt; t += 2) {
            const bool last = (t == nt - 2);
            const char* a1 = cA + (size_t)(t + 1) * kstep;
            const char* a2 = last ? nA : cA + (size_t)(t + 2) * kstep; const char* b2 = last ? nB : cB + (size_t)(t + 2) * kstep;
            const char* a3 = a2 + kstep; const char* b3 = b2 + kstep;
            PG8_LDB(B0, 0, 0); PG8_LDB(B1, 0, 1); PG8_SCHED; PG8_LDA(At, 0, 0); PG8_STAGE(PG8_SA(1, 1), a1 + hstepA, voffA);
            PG8_WAIT_V(8); PG8_WAIT_L(0); PG8_BAR; PG8_MMA(0, 0, At, B0); PG8_MMA(0, 1, At, B1); PG8_BAR; PG8_SCHED;
            PG8_LDA(At, 0, 1); PG8_STAGE(PG8_SB(0, 0), b2, voffB); PG8_STAGE(PG8_SB(0, 1), b2 + hstepB, voffB); PG8_STAGE(PG8_SA(0, 0), a2, voffA);
            PG8_WAIT_V(8); PG8_WAIT_L(0); PG8_BAR; PG8_MMA(1, 0, At, B0); PG8_MMA(1, 1, At, B1); PG8_BAR; PG8_SCHED;
            PG8_LDB(B0, 1, 0); PG8_LDB(B1, 1, 1); PG8_SCHED; PG8_LDA(At, 1, 0); PG8_STAGE(PG8_SA(0, 1), a2 + hstepA, voffA);
            PG8_WAIT_V(8); PG8_WAIT_L(0); PG8_BAR; PG8_MMA(0, 0, At, B0); PG8_MMA(0, 1, At, B1); PG8_BAR; PG8_SCHED;
            PG8_LDA(At, 1, 1); PG8_STAGE(PG8_SB(1, 0), b3, voffB); PG8_STAGE(PG8_SB(1, 1), b3 + hstepB, voffB); PG8_STAGE(PG8_SA(1, 0), a3, voffA);
            PG8_WAIT_V(8); PG8_WAIT_L(0); PG8_BAR; PG8_MMA(1, 0, At, B0); PG8_MMA(1, 1, At, B1); PG8_BAR; PG8_SCHED;
        }
        if (wr == 0) PG8_BAR;
        E(acc, cur, wr, wc, fr, fq);
        if (!has_next) break;
#pragma unroll
        for (int a = 0; a < 2; ++a)
#pragma unroll
            for (int b = 0; b < 2; ++b)
#pragma unroll
                for (int m = 0; m < 4; ++m)
#pragma unroll
                    for (int n = 0; n < 2; ++n) acc[a][b][m][n] = (f32x4){0.f, 0.f, 0.f, 0.f};
        cur = nxt; cA = nA; cB = nB; ++ui;
        if (wr == 1) PG8_BAR;
    }
    PG8_WAIT_V(0);
    PG8_BAR;
#undef PG8_SA
#undef PG8_SB
#undef PG8_STAGE
#undef PG8_LDA
#undef PG8_LDB
#undef PG8_MMA
#undef PG8_WAIT_V
#undef PG8_WAIT_L
#undef PG8_BAR
#undef PG8_SCHED
}
}

#define XB_TMO      128
#define XB_XCNT(j)  (256  + 64 * (j))
#define XB_XSUB(j)  (1280 + 64 * (j))
#define XB_XGEN(j)  (2304 + 64 * (j))
#define XB_TOP      3328
#define XB_TOPGEN   3392
#define XCD_BAR_WORDS 3456
#define XB_SPIN_CAP (1u << 22)
__device__ __forceinline__ unsigned xb_ld(unsigned* p)              { return __hip_atomic_load(p, __ATOMIC_RELAXED, __HIP_MEMORY_SCOPE_AGENT); }
__device__ __forceinline__ unsigned xb_add(unsigned* p, unsigned v) { return __hip_atomic_fetch_add(p, v, __ATOMIC_RELAXED, __HIP_MEMORY_SCOPE_AGENT); }
__device__ __forceinline__ unsigned xb_xcc_id() { return (unsigned)__builtin_amdgcn_s_getreg((3 << 11) | 20) & 0xFu; }
#define XB_SPIN(cond, bar) do { unsigned _sp = 0; while (cond) { __builtin_amdgcn_s_sleep(1); \
    if ((++_sp & 255u) == 0u) { if (xb_ld(&(bar)[XB_TMO])) break; if (_sp > XB_SPIN_CAP) { atomicAdd(&(bar)[XB_TMO], 1u); break; } } } } while (0)
struct XcdBarrier { unsigned* bar; unsigned x; volatile LAS unsigned* st; };

__device__ __forceinline__ XcdBarrier xcd_barrier_post(unsigned* bar, volatile LAS unsigned* st) {
    XcdBarrier b; b.bar = bar; b.x = xb_xcc_id(); b.st = st;
    if (threadIdx.x == 0) (void)xb_add(&bar[XB_XCNT(b.x)], 1u);
    return b;
}
__device__ __forceinline__ void xcd_barrier_complete(unsigned* bar, unsigned x, unsigned& nloc, unsigned& nx) {
    const unsigned G = gridDim.x * gridDim.y * gridDim.z;
    unsigned sum, cnt, mine, sp = 0u;
    for (;;) {
        sum = 0u; cnt = 0u; mine = 0u;
#pragma unroll
        for (unsigned j = 0; j < 16; ++j) { const unsigned c = xb_ld(&bar[XB_XCNT(j)]); sum += c; cnt += (c > 0u) ? 1u : 0u; mine = (j == x) ? c : mine; }
        if (sum == G) break;
        __builtin_amdgcn_s_sleep(1);
        if ((++sp & 255u) == 0u) { if (xb_ld(&bar[XB_TMO])) break; if (sp > XB_SPIN_CAP) { atomicAdd(&bar[XB_TMO], 1u); break; } }
    }
    nloc = mine > 0u ? mine : 1u; nx = cnt > 0u ? cnt : 1u;
}
__device__ __forceinline__ void xcd_barrier(const XcdBarrier& b, int wv) {
    asm volatile("s_waitcnt vmcnt(0)" ::: "memory");
    __syncthreads();
    if (tid_of(wv) == 0) {
        unsigned* bar = b.bar;
        __builtin_amdgcn_s_waitcnt(0);
        unsigned nloc = b.st[0], nx = b.st[1];
        if (nloc == 0u) { xcd_barrier_complete(bar, b.x, nloc, nx); b.st[0] = nloc; b.st[1] = nx; }
        const unsigned old = xb_add(&bar[XB_XSUB(b.x)], 1u);
        const unsigned gen = old / nloc;
        if (old + 1u == (gen + 1u) * nloc) {
            __builtin_amdgcn_fence(__ATOMIC_RELEASE, "agent");
            asm volatile("s_waitcnt vmcnt(0)" ::: "memory");
            const unsigned og = xb_add(&bar[XB_TOP], 1u);
            const unsigned tg = og / nx;
            if (og + 1u == (tg + 1u) * nx) xb_add(&bar[XB_TOPGEN], 1u);
            else XB_SPIN(xb_ld(&bar[XB_TOPGEN]) == tg, bar);
            __builtin_amdgcn_fence(__ATOMIC_ACQUIRE, "agent");
            xb_add(&bar[XB_XGEN(b.x)], 1u);
            asm volatile("s_waitcnt vmcnt(0)" ::: "memory");
        } else {
            XB_SPIN(xb_ld(&bar[XB_XGEN(b.x)]) == gen, bar);
            __builtin_amdgcn_fence(__ATOMIC_ACQUIRE, "agent");
            asm volatile("s_waitcnt vmcnt(0)" ::: "memory");
        }
    }
    __syncthreads();
}

constexpr int RING_BYTES = 131072, MISC_OFF = RING_BYTES, LDS_BYTES = 147456;

__device__ __forceinline__ int srccol(int cmode, int nd) {
    if (cmode == 0) return nd;
    if (cmode == 1) {
        if (nd < 2880) return nd;
        if (nd < 2944) return 4936 + (nd - 2880);
        if (nd < 4480) return 2888 + (nd - 2944);
        if (nd < 4992) return 4424 + (nd - 4480);
        if (nd < 5000) return 2880 + (nd - 4992);
        if (nd < 5120) return -1;
        return 5000 + (nd - 5120);
    }
    const int p = nd >> 8, j = nd & 255;
    return (j < 128) ? (128 * p + j) : (DFF + 128 * p + (j - 128));
}
__device__ __forceinline__ void tr_item(const float* W, int ldw, int K, bf16_t* WT, int cmode, const float* gain, LAS float* scr, int item, int nblk, int lane) {
    const int kb = item / nblk, nb = item % nblk, k0 = 64 * kb, n0 = 32 * nb;
    const int sc = srccol(cmode, n0 + (lane & 31));
    float v[32];
    const float* wp = W + (size_t)(k0 + (lane >> 5)) * ldw + (sc >= 0 ? sc : 0);
#pragma unroll
    for (int i = 0; i < 32; ++i) v[i] = __builtin_nontemporal_load(wp + (size_t)(2 * i) * ldw);
    if (gain) {
        const float* gp = gain + k0 + (lane >> 5);
#pragma unroll
        for (int i = 0; i < 32; ++i) v[i] *= gp[2 * i];
    }
    if (sc < 0) {
#pragma unroll
        for (int i = 0; i < 32; ++i) v[i] = 0.f;
    }
#pragma unroll
    for (int i = 0; i < 32; ++i) scr[(2 * i + (lane >> 5)) * 33 + (lane & 31)] = v[i];
    LDS_WAIT(); asm volatile("" ::: "memory");
    const int c = lane & 7;
#pragma unroll
    for (int j = 0; j < 4; ++j) { const int n = (lane >> 3) + 8 * j; const LAS float* s = scr + (8 * c) * 33 + n;
        u32x4 o; o.x = pk2(s[0 * 33], s[1 * 33]); o.y = pk2(s[2 * 33], s[3 * 33]); o.z = pk2(s[4 * 33], s[5 * 33]); o.w = pk2(s[6 * 33], s[7 * 33]);
        *(u32x4*)(WT + (size_t)(n0 + n) * K + k0 + 8 * c) = o; }
    LDS_WAIT(); asm volatile("" ::: "memory");
}
__device__ __forceinline__ void trb_item(const bf16_t* src, int lds_, bf16_t* dst, int ldd, LAS unsigned short* scr, int lane) {
#pragma unroll
    for (int i = 0; i < 8; ++i) {
        const int id = lane + 64 * i, row = id >> 3, cc = id & 7;
        const u32x4 w = *(const u32x4*)(src + (size_t)row * lds_ + 8 * cc);
        LAS unsigned* d = (LAS unsigned*)(scr + row * 66 + 8 * cc);
        d[0] = w.x; d[1] = w.y; d[2] = w.z; d[3] = w.w;
    }
    LDS_WAIT(); asm volatile("" ::: "memory");
#pragma unroll
    for (int i = 0; i < 8; ++i) {
        const int id = lane + 64 * i, c = id >> 3, tc = id & 7;
        const LAS unsigned short* s = scr + (8 * tc) * 66 + c;
        u32x4 o;
        o.x = (unsigned)s[0] | ((unsigned)s[66] << 16); o.y = (unsigned)s[2 * 66] | ((unsigned)s[3 * 66] << 16);
        o.z = (unsigned)s[4 * 66] | ((unsigned)s[5 * 66] << 16); o.w = (unsigned)s[6 * 66] | ((unsigned)s[7 * 66] << 16);
        *(u32x4*)(dst + (size_t)c * ldd + 8 * tc) = o;
    }
    LDS_WAIT(); asm volatile("" ::: "memory");
}

__device__ __forceinline__ float inv_freq(int fi, int rot) { return exp2f(-((float)fi * 2.0f / (float)rot) * LOG2_THETA); }
template <int HD, int ROT, bool NORM>
__device__ __forceinline__ void pp_chunk(u32x4 xin, bf16_t* dst, int ci, bool act, const float* gain, const LAS float* tab, float oscale) {
    float x[8]; unpack8(xin, x);
    if (NORM) {
        float ss = 0.f;
#pragma unroll
        for (int j = 0; j < 8; ++j) ss += x[j] * x[j];
        if (HD == 512) ss = wave_sum_dpp(ss);
        else { ss += dppf<0xB1>(ss); ss += dppf<0x4E>(ss); ss += dppf<0x141>(ss); if (HD == 128) ss += dppf<0x140>(ss); }
        const float r = 1.0f / sqrtf(ss * (1.f / HD) + NORM_EPS);
#pragma unroll
        for (int j = 0; j < 8; ++j) x[j] = x[j] * r * gain[8 * ci + j];
    }
    if (ROT > 0) {
        float oth[8];
#pragma unroll
        for (int j = 0; j < 8; ++j) oth[j] = swz_xor<(ROT / 16)>(x[j]);
        if (ci < ROT / 8) {
            const bool first = ci < ROT / 16;
#pragma unroll
            for (int j = 0; j < 8; ++j) {
                const int fi = 8 * (ci & (ROT / 16 - 1)) + j;
                const float cs = tab[fi], sn = tab[64 + fi];
                x[j] = first ? (x[j] * cs - oth[j] * sn) : (x[j] * cs + oth[j] * sn);
            }
        }
    }
#pragma unroll
    for (int j = 0; j < 8; ++j) x[j] *= oscale;
    if (act) *(u32x4*)dst = pack8(x);
}
__device__ __forceinline__ void pp_head192(u32x4 a0, u32x4 a1, u32x4 a2, bf16_t* d, int ci, const float* gain, const LAS float* tab, float oscale) {
    float x0[8], x1[8], x2[8];
    unpack8(a0, x0); unpack8(a1, x1); unpack8(a2, x2);
    float ss = 0.f;
#pragma unroll
    for (int j = 0; j < 8; ++j) ss += x0[j] * x0[j] + x1[j] * x1[j] + x2[j] * x2[j];
    ss += dppf<0xB1>(ss); ss += dppf<0x4E>(ss); ss += dppf<0x141>(ss);
    const float r = 1.0f / sqrtf(ss * (1.f / 192.f) + NORM_EPS);
#pragma unroll
    for (int j = 0; j < 8; ++j) { x0[j] = x0[j] * r * gain[8 * ci + j]; x1[j] = x1[j] * r * gain[64 + 8 * ci + j]; x2[j] = x2[j] * r * gain[128 + 8 * ci + j]; }
    float oth[8];
#pragma unroll
    for (int j = 0; j < 8; ++j) oth[j] = swz_xor<4>(x0[j]);
    const bool first = ci < 4;
#pragma unroll
    for (int j = 0; j < 8; ++j) {
        const int fi = 8 * (ci & 3) + j;
        const float cs = tab[fi], sn = tab[64 + fi];
        x0[j] = first ? (x0[j] * cs - oth[j] * sn) : (x0[j] * cs + oth[j] * sn);
    }
#pragma unroll
    for (int j = 0; j < 8; ++j) { x0[j] *= oscale; x1[j] *= oscale; x2[j] *= oscale; }
    *(u32x4*)(d + 8 * ci) = pack8(x0); *(u32x4*)(d + 64 + 8 * ci) = pack8(x1); *(u32x4*)(d + 128 + 8 * ci) = pack8(x2);
}
__device__ __forceinline__ void rope_table(LAS float* tab, float pos, int lane) {
    int rot = 64, fi = lane - 24;
    if (lane < 8) { rot = 16; fi = lane; } else if (lane < 24) { rot = 32; fi = lane - 8; }
    if (fi > 31) fi = 31;
    float sn, cs; sincosf(pos * inv_freq(fi, rot), &sn, &cs);
    tab[lane] = cs; tab[64 + lane] = sn;
    LDS_WAIT(); asm volatile("" ::: "memory");
}

__device__ __forceinline__ int pi32(int r) { return (r & ~12) | ((r & 4) << 1) | ((r & 8) >> 1); }
template <int DQK>
__device__ __forceinline__ void attn_unit(LAS unsigned char* lds, const bf16_t* Q, int ldq, const bf16_t* K, int ldk, const bf16_t* VT, int qb,
                                          float* of32, int ldo32, bf16_t* obf, int ldo, int wv) {
    constexpr int KS = DQK * 2 + 16, VS = 144, KBYTES = 64 * KS, BUF = KBYTES + 128 * VS, NDS = DQK / 16, CPR = DQK / 8, NKC = 64 * CPR / 512;
    const int tid = tid_of(wv);
    const int lane = tid & 63, w = wv, qi = lane & 31, hh = lane >> 5;
    const int q0 = qb * 256 + w * 32, NT = 4 * qb + 4, ntw = (q0 + 31) / 64 + 1;
    bf16x8 qf[NDS];
#pragma unroll
    for (int ds = 0; ds < NDS; ++ds) qf[ds] = *(const bf16x8*)(Q + (size_t)(q0 + qi) * ldq + 16 * ds + 8 * hh);
    f32x16 o[4];
#pragma unroll
    for (int d = 0; d < 4; ++d)
#pragma unroll
        for (int r = 0; r < 16; ++r) o[d][r] = 0.f;
    float mrun = -INFINITY, lsum = 0.f;
    u32x4 kst[NKC], vst[2];
    int krow[NKC], kcc[NKC];
#pragma unroll
    for (int i = 0; i < NKC; ++i) { const int id = tid + 512 * i; krow[i] = id / CPR; kcc[i] = id % CPR; }
    const int vd0 = tid >> 3, vcc = tid & 7;
#define ATT_LOAD(kt) do { _Pragma("unroll") for (int i = 0; i < NKC; ++i) kst[i] = *(const u32x4*)(K + (size_t)(64 * (kt) + krow[i]) * ldk + 8 * kcc[i]); \
        _Pragma("unroll") for (int i = 0; i < 2; ++i) vst[i] = *(const u32x4*)(VT + (size_t)(vd0 + 64 * i) * SEQ + 64 * (kt) + 8 * vcc); } while (0)
#define ATT_WRITE(b) do { LAS unsigned char* base = lds + (b) * BUF; \
        _Pragma("unroll") for (int i = 0; i < NKC; ++i) *(LAS u32x4*)(base + krow[i] * KS + 16 * kcc[i]) = kst[i]; \
        _Pragma("unroll") for (int i = 0; i < 2; ++i) *(LAS u32x4*)(base + KBYTES + (vd0 + 64 * i) * VS + 16 * vcc) = vst[i]; } while (0)
    ATT_LOAD(0); ATT_WRITE(0);
    __syncthreads();
    const int kro = pi32(qi) * KS + 16 * hh;
    const int vro = KBYTES + qi * VS + 16 * hh;
    for (int kt = 0; kt < NT; ++kt) {
        const bool more = (kt + 1 < NT);
        if (more) ATT_LOAD(kt + 1);
        if (kt < ntw) {
            const LAS unsigned char* base = lds + (kt & 1) * BUF;
#pragma unroll
            for (int kb = 0; kb < 2; ++kb) {
                f32x16 s;
#pragma unroll
                for (int r = 0; r < 16; ++r) s[r] = 0.f;
#pragma unroll
                for (int ds = 0; ds < NDS; ++ds) {
                    const bf16x8 kf = *(const LAS bf16x8*)(base + kro + kb * 32 * KS + ds * 32);
                    s = __builtin_amdgcn_mfma_f32_32x32x16_bf16(kf, qf[ds], s, 0, 0, 0);
                }
                const int kbase = 64 * kt + 32 * kb;
                if (kbase + 31 > q0) {
                    const int qq = q0 + qi;
#pragma unroll
                    for (int r = 0; r < 16; ++r) { const int key = kbase + (r & 7) + 8 * hh + 16 * (r >> 3); if (key > qq) s[r] = -INFINITY; }
                }
                float mx = s[0];
#pragma unroll
                for (int r = 1; r < 16; ++r) mx = fmaxf(mx, s[r]);
                mx = xhalf_max(mx);
                if (__builtin_amdgcn_ballot_w64(mx > mrun + 8.f) != 0ull) {
                    const float mnew = fmaxf(mrun, mx);
                    const float alpha = fexp2(mrun - mnew);
                    mrun = mnew;
                    lsum *= alpha;
#pragma unroll
                    for (int d = 0; d < 4; ++d)
#pragma unroll
                        for (int r = 0; r < 16; ++r) o[d][r] *= alpha;
                }
                float ps = 0.f;
#pragma unroll
                for (int r = 0; r < 16; ++r) { s[r] = fexp2(s[r] - mrun); ps += s[r]; }
                lsum += ps;
                __builtin_amdgcn_iglp_opt(0);
                bf16x8 pf[2];
#pragma unroll
                for (int s2 = 0; s2 < 2; ++s2) {
                    u32x4 pw; pw.x = cvt_pk_bf16(s[8 * s2 + 0], s[8 * s2 + 1]); pw.y = cvt_pk_bf16(s[8 * s2 + 2], s[8 * s2 + 3]);
                    pw.z = cvt_pk_bf16(s[8 * s2 + 4], s[8 * s2 + 5]); pw.w = cvt_pk_bf16(s[8 * s2 + 6], s[8 * s2 + 7]);
                    pf[s2] = __builtin_bit_cast(bf16x8, pw);
                }
#pragma unroll
                for (int d = 0; d < 4; ++d)
#pragma unroll
                    for (int s2 = 0; s2 < 2; ++s2) {
                        const bf16x8 vf = *(const LAS bf16x8*)(base + vro + d * 32 * VS + (32 * kb + 16 * s2) * 2);
                        o[d] = __builtin_amdgcn_mfma_f32_32x32x16_bf16(vf, pf[s2], o[d], 0, 0, 0);
                    }
            }
        }
        if (more) ATT_WRITE((kt + 1) & 1);
        __syncthreads();
    }
#undef ATT_LOAD
#undef ATT_WRITE
    const float l = xhalf_sum(lsum);
    const float inv = 1.f / l;
    const size_t row = (size_t)(q0 + qi);
#pragma unroll
    for (int d = 0; d < 4; ++d)
#pragma unroll
        for (int g = 0; g < 4; ++g) {
            const int dim = 32 * d + 8 * g + 4 * hh;
            const float v0 = o[d][4 * g] * inv, v1 = o[d][4 * g + 1] * inv, v2 = o[d][4 * g + 2] * inv, v3 = o[d][4 * g + 3] * inv;
            if (of32) *(f32x4*)(of32 + row * ldo32 + dim) = (f32x4){v0, v1, v2, v3};
            else { u32x2 wv; wv.x = cvt_pk_bf16(v0, v1); wv.y = cvt_pk_bf16(v2, v3); *(u32x2*)(obf + row * ldo + dim) = wv; }
        }
}

__device__ __forceinline__ unsigned fkey(float f) { const unsigned u = __builtin_bit_cast(unsigned, f); return (u & 0x80000000u) ? ~u : (u | 0x80000000u); }
template <int NR>
__device__ __forceinline__ void topk_select(const float* sc, int t, LAS unsigned short* sel, int lane) {
    unsigned key[NR];
    const float* scl = sc + lane;
#pragma unroll
    for (int i = 0; i < NR; ++i) { const int e = 64 * i + lane; const unsigned kv = fkey(scl[64 * i]); key[i] = kv & (unsigned)((e - t - 1) >> 31); }
    unsigned thr = 0u;
    for (int b = 31; b >= 0; --b) {
        const unsigned cand = thr | (1u << b);
        int c = 0;
#pragma unroll
        for (int i = 0; i < NR; ++i) c += __popcll(__ballot(key[i] >= cand));
        if (c >= 256) thr = cand;
        if (c == 256) break;
    }
    int cgt = 0;
    unsigned thr1 = thr + 1u; asm volatile("" : "+v"(thr1));
#pragma unroll
    for (int i = 0; i < NR; ++i) cgt += __popcll(__ballot(key[i] >= thr1));
    const int need = 256 - cgt;
    int base = 0, eqbase = 0;
#pragma unroll
    for (int i = 0; i < NR; ++i) {
        const bool gt = key[i] > thr, eq = key[i] == thr;
        const unsigned long long em = __ballot(eq);
        const int erank = eqbase + (int)__builtin_amdgcn_mbcnt_hi((unsigned)(em >> 32), __builtin_amdgcn_mbcnt_lo((unsigned)em, 0u));
        const bool take = gt || (eq && erank < need);
        const unsigned long long tm = __ballot(take);
        const int pos = base + (int)__builtin_amdgcn_mbcnt_hi((unsigned)(tm >> 32), __builtin_amdgcn_mbcnt_lo((unsigned)tm, 0u));
        if (take) sel[pos & 255] = (unsigned short)(64 * i + lane);
        base += __popcll(tm); eqbase += __popcll(em);
        __builtin_amdgcn_sched_barrier(0);
    }
}

__device__ __forceinline__ unsigned lo16(unsigned x) { return __builtin_amdgcn_ubfe(x, 0u, 16u); }
__device__ __forceinline__ int row_sum16(int x) {
    x += __builtin_amdgcn_update_dpp(0, x, 0xB1, 0xf, 0xf, false);
    x += __builtin_amdgcn_update_dpp(0, x, 0x4E, 0xf, 0xf, false);
    x += __builtin_amdgcn_update_dpp(0, x, 0x141, 0xf, 0xf, false);
    x += __builtin_amdgcn_update_dpp(0, x, 0x140, 0xf, 0xf, false);
    return x;
}
__device__ __forceinline__ int wave_total(int x) {
    x = row_sum16(x);
    return __builtin_amdgcn_readlane(x, 0) + __builtin_amdgcn_readlane(x, 16) + __builtin_amdgcn_readlane(x, 32) + __builtin_amdgcn_readlane(x, 48);
}
__device__ __forceinline__ unsigned pk_cnt(unsigned acc, unsigned R, unsigned C, unsigned ONE) {
    unsigned d, f;
    asm("v_pk_sub_u16 %0, %1, %2 clamp" : "=v"(d) : "v"(R), "s"(C));
    asm("v_pk_min_u16 %0, %1, %2" : "=v"(f) : "v"(d), "s"(ONE));
    asm("v_pk_add_u16 %0, %0, %1" : "+v"(acc) : "v"(f));
    return acc;
}
template <int NR2>
__device__ __forceinline__ void topk_select16(const unsigned* sc16, const float* sc32, int t, LAS unsigned short* sel, LAS unsigned short* bl, int lane) {
    unsigned R[NR2];
    const unsigned* p16 = sc16 + lane;
#pragma unroll
    for (int i = 0; i < NR2; ++i) {
        const int e0 = 128 * i + 2 * lane;
        const unsigned m = lo16((unsigned)((e0 - t - 1) >> 31)) | ((unsigned)((e0 - t) >> 31) << 16);
        R[i] = p16[64 * i] & m;
    }
    const unsigned ONE = 0x00010001u;
    unsigned thr = 0u;
#pragma unroll 1
    for (int b = 15; b >= 0; --b) {
        const unsigned cand = thr | (1u << b), cm1 = cand - 1u, C = cm1 | (cm1 << 16);
        unsigned acc = 0u;
#pragma unroll
        for (int i = 0; i < NR2; ++i) acc = pk_cnt(acc, R[i], C, ONE);
        const int c = wave_total((int)(lo16(acc) + (acc >> 16)));
        if (c >= 256) thr = cand;
        if (c == 256) break;
    }
    unsigned ag = 0u, ae = 0u;
    {
        const unsigned Cg = thr | (thr << 16), tm1 = thr - 1u, Ce = tm1 | (tm1 << 16);
#pragma unroll
        for (int i = 0; i < NR2; ++i) { ag = pk_cnt(ag, R[i], Cg, ONE); ae = pk_cnt(ae, R[i], Ce, ONE); }
    }
    const int cg_l = (int)(lo16(ag) + (ag >> 16)), ce_l = (int)(lo16(ae) + (ae >> 16)) - cg_l;
    int sc = cg_l | (ce_l << 16);
    const int mine = sc;
    sc += __builtin_amdgcn_update_dpp(0, sc, 0x111, 0xf, 0xf, false);
    sc += __builtin_amdgcn_update_dpp(0, sc, 0x112, 0xf, 0xf, false);
    sc += __builtin_amdgcn_update_dpp(0, sc, 0x114, 0xf, 0xf, false);
    sc += __builtin_amdgcn_update_dpp(0, sc, 0x118, 0xf, 0xf, false);
    const int r0 = __builtin_amdgcn_readlane(sc, 15), r1 = __builtin_amdgcn_readlane(sc, 31), r2 = __builtin_amdgcn_readlane(sc, 47), r3 = __builtin_amdgcn_readlane(sc, 63);
    const int rowi = lane >> 4;
    sc += (rowi > 0 ? r0 : 0) + (rowi > 1 ? r1 : 0) + (rowi > 2 ? r2 : 0);
    const int tot = r0 + r1 + r2 + r3;
    const int cgt = (int)lo16((unsigned)tot), meq = tot >> 16, need = 256 - cgt;
    sc -= mine;
    int og = (int)lo16((unsigned)sc), oe = sc >> 16;
#pragma unroll
    for (int i = 0; i < NR2; ++i) {
        const int e0 = 128 * i + 2 * lane;
        const unsigned lo = lo16(R[i]), hi = R[i] >> 16;
        if (lo > thr) { sel[og & 255] = (unsigned short)e0; ++og; }
        else if (lo == thr) { if (oe < 256) bl[oe] = (unsigned short)e0; ++oe; }
        if (hi > thr) { sel[og & 255] = (unsigned short)(e0 + 1); ++og; }
        else if (hi == thr) { if (oe < 256) bl[oe] = (unsigned short)(e0 + 1); ++oe; }
    }
    LDS_WAIT(); asm volatile("" ::: "memory");
    const int mc = meq < 256 ? meq : 256;
    unsigned v[4]; int vi[4];
#pragma unroll
    for (int r = 0; r < 4; ++r) {
        const int ci = lane + 64 * r;
        const int idx = (int)bl[ci < mc ? ci : mc - 1];
        const unsigned k32 = fkey(sc32[idx]);
        vi[r] = idx;
        v[r] = (ci < mc) ? (((lo16(k32) << 13) | (unsigned)(8191 - idx)) + 1u) : 0u;
    }
    unsigned tv = 1u;
    if (mc != need) {
        tv = 0u;
#pragma unroll 1
        for (int b = 29; b >= 0; --b) {
            const unsigned cand = tv | (1u << b);
            int c = 0;
#pragma unroll
            for (int r = 0; r < 4; ++r) c += __popcll(__ballot(v[r] >= cand));
            if (c >= need) tv = cand;
            if (c == need) break;
        }
    }
    int base = cgt;
#pragma unroll
    for (int r = 0; r < 4; ++r) {
        const bool take = v[r] >= tv;
        const unsigned long long tm = __ballot(take);
        const int pos = base + (int)__builtin_amdgcn_mbcnt_hi((unsigned)(tm >> 32), __builtin_amdgcn_mbcnt_lo((unsigned)tm, 0u));
        if (take) sel[pos & 255] = (unsigned short)vi[r];
        base += __popcll(tm);
    }
}

template <int MODE>
__device__ __forceinline__ void dsa_item(LAS unsigned char* lds, const bf16_t* P, const bf16_t* IKC, float* scr, unsigned short* scr16, bf16_t* AOb, int t0, int wv) {
    const int tid = tid_of(wv);
    const int lane = tid & 63, w = wv; (void)tid;
    const bool need_sel = (t0 >= 256);
    if (need_sel && (MODE & 1)) {
        const int g = w & 3, c = lane & 31, hh = lane >> 5;
        const int nkb = (t0 + 16 + 31) / 32;
        const int qiA = 2 * ((c >> 2) & 1) + (c >> 4), hdA = 4 * ((c >> 3) & 1) + (c & 3);
        bf16x8 af[4];
#pragma unroll
        for (int ds = 0; ds < 4; ++ds) af[ds] = *(const bf16x8*)(P + (size_t)(t0 + 4 * g + qiA) * NIN + C_IQ + hdA * 64 + 16 * ds + 8 * hh);
        float wq[2][8];
#pragma unroll
        for (int qq = 0; qq < 2; ++qq) {
            float tmp[8]; unpack8(*(const u32x4*)(P + (size_t)(t0 + 4 * g + 2 * hh + qq) * NIN + C_IW), tmp);
#pragma unroll
            for (int h = 0; h < 8; ++h) wq[qq][h] = tmp[h] * 0.044194173824159216f;
        }
        const bf16_t* ikp = IKC + (size_t)lane * 8;
        bf16x8 bc[4], bn[4], bm[4];
        const int kbw = (w >> 2);
        {
            const int kb1 = min(kbw + 2, nkb - 1);
#pragma unroll
            for (int ds = 0; ds < 4; ++ds) { bc[ds] = *(const bf16x8*)(ikp + (size_t)kbw * 2048 + 512 * ds); bn[ds] = *(const bf16x8*)(ikp + (size_t)kb1 * 2048 + 512 * ds); }
        }
#pragma unroll 1
        for (int kc = kbw; kc < nkb; kc += 16) {
            float ra[8][2];
#pragma unroll
            for (int i = 0; i < 8; ++i) {
                const int kn = min(kc + 2 * i + 4, nkb - 1);
#pragma unroll
                for (int ds = 0; ds < 4; ++ds) bm[ds] = *(const bf16x8*)(ikp + (size_t)kn * 2048 + 512 * ds);
                f32x16 s;
#pragma unroll
                for (int r = 0; r < 16; ++r) s[r] = 0.f;
#pragma unroll
                for (int ds = 0; ds < 4; ++ds) s = __builtin_amdgcn_mfma_f32_32x32x16_bf16(af[ds], bc[ds], s, 0, 0, 0);
#pragma unroll
                for (int qq = 0; qq < 2; ++qq) {
                    float a = 0.f;
#pragma unroll
                    for (int h = 0; h < 8; ++h) a += wq[qq][h] * fmaxf(s[8 * qq + h], 0.f);
                    ra[i][qq] = a;
                }
#pragma unroll
                for (int ds = 0; ds < 4; ++ds) { bc[ds] = bn[ds]; bn[ds] = bm[ds]; }
            }
#pragma unroll
            for (int i = 0; i < 8; ++i) {
                const int kb = kc + 2 * i;
                if (kb < nkb) {
#pragma unroll
                    for (int qq = 0; qq < 2; ++qq) {
                        const size_t o = (size_t)(4 * g + 2 * hh + qq) * SEQ + 32 * kb + c;
                        __builtin_nontemporal_store(ra[i][qq], scr + o);
                        scr16[o] = (unsigned short)(fkey(ra[i][qq]) >> 16);
                    }
                }
            }
        }
    }
    __syncthreads();
    LAS unsigned char* wl = lds + w * 8192;
    LAS float* pl = (LAS float*)wl;
    LAS unsigned short* sel = (LAS unsigned short*)(wl + 4096);
    LAS unsigned short* bl = (LAS unsigned short*)(wl + 4096 + 512);
    typedef float f32x4_t __attribute__((ext_vector_type(4)));
    const int n16 = lane & 15, g4 = lane >> 4;
#pragma unroll 1
    for (int qq = 0; qq < 2; ++qq) {
        const int ql = 2 * w + qq, t = t0 + ql;
        int nsel;
        if (need_sel && (MODE & 2)) {
            const float* sc = scr + (size_t)ql * SEQ;
            const unsigned* sc16 = (const unsigned*)(scr16 + (size_t)ql * SEQ);
            const int nr2 = (t >> 7) + 1;
            if (nr2 <= 16) topk_select16<16>(sc16, sc, t, sel, bl, lane);
            else if (nr2 <= 32) topk_select16<32>(sc16, sc, t, sel, bl, lane);
            else if (nr2 <= 48) topk_select16<48>(sc16, sc, t, sel, bl, lane);
            else topk_select16<64>(sc16, sc, t, sel, bl, lane);
            nsel = 256;
        } else {
            nsel = t + 1;
#pragma unroll
            for (int i = 0; i < 4; ++i) sel[lane + 64 * i] = (unsigned short)(lane + 64 * i);
        }
        if (!(MODE & 4)) { if (lane == 0) AOb[(size_t)t * DM] = sel[17]; continue; }
        LDS_WAIT(); asm volatile("" ::: "memory");
        bf16x8 qa[4];
#pragma unroll
        for (int ks = 0; ks < 4; ++ks) qa[ks] = *(const bf16x8*)(P + (size_t)t * NIN + C_BQ + (n16 & 3) * 128 + 32 * ks + 8 * g4);
        float sl[4][4];
#pragma unroll
        for (int i = 0; i < 4; ++i)
#pragma unroll
            for (int h = 0; h < 4; ++h) sl[i][h] = 0.f;
#pragma unroll
        for (int kb = 0; kb < 16; ++kb) {
            const int idx = (int)sel[16 * kb + n16];
            const bf16_t* kr = P + (size_t)idx * NIN + C_BK + 8 * g4;
            bf16x8 kf[4];
#pragma unroll
            for (int ks = 0; ks < 4; ++ks) kf[ks] = *(const bf16x8*)(kr + 32 * ks);
            f32x4 acc = (f32x4){0.f, 0.f, 0.f, 0.f};
#pragma unroll
            for (int ks = 0; ks < 4; ++ks) acc = __builtin_amdgcn_mfma_f32_16x16x32_bf16(qa[ks], kf[ks], acc, 0, 0, 0);
            const bool mine = (g4 == (kb & 3));
#pragma unroll
            for (int h = 0; h < 4; ++h) sl[kb >> 2][h] = mine ? acc[h] : sl[kb >> 2][h];
            if ((kb & 3) == 3) __builtin_amdgcn_sched_barrier(0);
        }
        float linv[4];
#pragma unroll
        for (int i = 0; i < 4; ++i) {
            const bool val = (16 * (4 * i + g4) + n16) < nsel;
#pragma unroll
            for (int h = 0; h < 4; ++h) sl[i][h] = val ? sl[i][h] : -INFINITY;
        }
#pragma unroll
        for (int h = 0; h < 4; ++h) {
            float mx = fmaxf(fmaxf(sl[0][h], sl[1][h]), fmaxf(sl[2][h], sl[3][h]));
            mx = wave_max_dpp(mx);
            float ps = 0.f;
#pragma unroll
            for (int i = 0; i < 4; ++i) { sl[i][h] = fexp2(sl[i][h] - mx); ps += sl[i][h]; }
            ps = wave_sum_dpp(ps);
            linv[h] = 1.f / ps;
        }
#pragma unroll
        for (int i = 0; i < 4; ++i) *(LAS f32x4*)(pl + 4 * (16 * (4 * i + g4) + n16)) = (f32x4){sl[i][0], sl[i][1], sl[i][2], sl[i][3]};
        LDS_WAIT(); asm volatile("" ::: "memory");
        typedef float f32x2_t __attribute__((ext_vector_type(2)));
        f32x2_t oacc[4][4];
#pragma unroll
        for (int h = 0; h < 4; ++h)
#pragma unroll
            for (int d = 0; d < 4; ++d) oacc[h][d] = (f32x2_t){0.f, 0.f};
        const bf16_t* vb = P + C_BV + 8 * n16;
        const int nj = (nsel + 15) & ~15;
        u32x4 vw[4], vn[4];
#pragma unroll
        for (int u = 0; u < 4; ++u) vw[u] = *(const u32x4*)(vb + (size_t)((int)sel[4 * u + g4]) * NIN);
#pragma unroll 1
        for (int j0 = 0; j0 < nj; j0 += 16) {
            const int jn = (j0 + 16 < nj) ? j0 + 16 : j0;
#pragma unroll
            for (int u = 0; u < 4; ++u) vn[u] = *(const u32x4*)(vb + (size_t)((int)sel[jn + 4 * u + g4]) * NIN);
#pragma unroll
            for (int u = 0; u < 4; ++u) {
                const f32x4 pq = *(const LAS f32x4*)(pl + 4 * (j0 + 4 * u + g4));
                float vx[8]; unpack8(vw[u], vx);
#pragma unroll
                for (int h = 0; h < 4; ++h)
#pragma unroll
                    for (int d = 0; d < 4; ++d) oacc[h][d] += (f32x2_t){vx[2 * d], vx[2 * d + 1]} * pq[h];
            }
#pragma unroll
            for (int u = 0; u < 4; ++u) vw[u] = vn[u];
        }
#pragma unroll
        for (int h = 0; h < 4; ++h) {
            float r[8];
#pragma unroll
            for (int d = 0; d < 4; ++d) {
                float a0 = oacc[h][d].x, a1 = oacc[h][d].y;
                a0 += swz_xor<16>(a0); a1 += swz_xor<16>(a1);
                a0 = xhalf_sum(a0); a1 = xhalf_sum(a1);
                r[2 * d] = a0 * linv[h]; r[2 * d + 1] = a1 * linv[h];
            }
            if (g4 == 0) {
                u32x4 w; w.x = cvt_pk_bf16(r[0], r[1]); w.y = cvt_pk_bf16(r[2], r[3]); w.z = cvt_pk_bf16(r[4], r[5]); w.w = cvt_pk_bf16(r[6], r[7]);
                *(u32x4*)(AOb + (size_t)t * DM + h * 128 + 8 * n16) = w;
            }
        }
        LDS_WAIT(); asm volatile("" ::: "memory");
    }
    __syncthreads();
}

struct Args { const float* in[19]; float* out; unsigned char* ws; };
constexpr int TAB_OFF = MISC_OFF + 256;
__device__ __forceinline__ unsigned long long tabp_(LAS unsigned char* lds, int i) {
    volatile LAS unsigned* p = (volatile LAS unsigned*)(lds + TAB_OFF + 8 * i);
    const unsigned lo = __builtin_amdgcn_readfirstlane(p[0]), hi = __builtin_amdgcn_readfirstlane(p[1]);
    return ((unsigned long long)hi << 32) | lo;
}
#define tabp(i) tabp_(lds, (i))
#define INP(i) ((const float*)(const GAS float*)tabp(i))
#define WSP(T, off) ((T*)(GAS T*)(tabp(20) + (off)))
#define GRID_BAR() do { XcdBarrier b_; b_.bar = WSP(unsigned, WS_CTL) + CW_BAR; b_.x = xb_xcc_id(); b_.st = (volatile LAS unsigned*)(lds + MISC_OFF) + 8; xcd_barrier(b_, wv); } while (0)

#define PHASE_VARS const int tid = tid_of(wv); const int lane = tid & 63, wave = wv; \
    int bx = blockIdx.x; asm volatile("" : "+s"(bx)); const int GW = bx * 8 + wave, NGW = (int)gridDim.x * 8; LAS float* wscr = (LAS float*)(lds + wave * 8448); \
    (void)lane; (void)GW; (void)NGW; (void)wscr; (void)tid;
#define DENSE_ORDER 0
__device__ __forceinline__ unsigned dense_order(int i) {
    static constexpr unsigned char tab[64] = {31, 30, 29, 28, 27, 26, 25, 24, 23, 22, 21, 20, 19, 159, 18, 158, 17, 157, 156, 16, 155, 154, 15, 153, 14, 152, 151, 13, 150, 149, 12, 148, 11, 147, 146, 10, 145, 144, 9, 143, 8, 142, 141, 7, 140, 139, 6, 138, 5, 137, 136, 4, 135, 134, 3, 133, 2, 132, 131, 1, 130, 129, 0, 128};
    return tab[i];
}
template <int L> __device__ __forceinline__ void layer_fwd(LAS unsigned char* lds, const int wv) {

        {
            PHASE_VARS
            constexpr int I_IN = 32 * 352, I_KVB = 8 * 64, I_BR = 32 * 64, I_OUT = 32 * 64, I_GU = 32 * 352, I_DN = 88 * 64;
            constexpr int NITEMS = I_IN + I_KVB + I_BR + I_OUT + I_GU + I_DN;
#pragma unroll 1
            for (int it = GW; it < NITEMS; it += NGW) {
                int r = it;
                if (r < I_IN) { tr_item(INP(2) + (size_t)L * DM * INW, INW, DM, WSP(bf16_t, WS_WIN), 1, INP(1) + (size_t)L * DM, wscr, r, 352, lane); continue; } r -= I_IN;
                if (r < I_KVB) { tr_item(INP(12) + (size_t)L * 512 * 2048, 2048, 512, WSP(bf16_t, WS_WKVB), 0, nullptr, wscr, r, 64, lane); continue; } r -= I_KVB;
                if (r < I_BR) { tr_item(INP(14) + (size_t)L * DM * DM, DM, DM, WSP(bf16_t, WS_WBR), 0, nullptr, wscr, r, 64, lane); continue; } r -= I_BR;
                if (r < I_OUT) { tr_item(INP(15) + (size_t)L * DM * DM, DM, DM, WSP(bf16_t, WS_WOUT), 0, nullptr, wscr, r, 64, lane); continue; } r -= I_OUT;
                if (r < I_GU) { tr_item(INP(17) + (size_t)L * DM * 2 * DFF, 2 * DFF, DM, WSP(bf16_t, WS_WGU), 2, INP(16) + (size_t)L * DM, wscr, r, 352, lane); continue; } r -= I_GU;
                tr_item(INP(18) + (size_t)L * DFF * DM, DM, DFF, WSP(bf16_t, WS_WDN), 0, nullptr, wscr, r, 64, lane);
            }
            if (L == 0) {
                const float* x_in = INP(0); bf16_t* XB = WSP(bf16_t, WS_XB); float* ssq_attn = WSP(float, WS_CTL) + CW_SSQ;
#pragma unroll 1
                for (int t = GW; t < SEQ; t += NGW) {
                    const float* xr = x_in + (size_t)t * DM; float ss = 0.f;
#pragma unroll
                    for (int j = 0; j < 4; ++j) {
                        const int e = 8 * (lane + 64 * j);
                        const f32x4 a = *(const f32x4*)(xr + e), b = *(const f32x4*)(xr + e + 4);
                        ss += a[0] * a[0] + a[1] * a[1] + a[2] * a[2] + a[3] * a[3] + b[0] * b[0] + b[1] * b[1] + b[2] * b[2] + b[3] * b[3];
                        u32x4 wv; wv.x = pk2(a[0], a[1]); wv.y = pk2(a[2], a[3]); wv.z = pk2(b[0], b[1]); wv.w = pk2(b[2], b[3]);
                        *(u32x4*)(XB + (size_t)t * DM + e) = wv;
                    }
                    ss = wave_sum(ss);
                    if (lane == 0) ssq_attn[t] = ss;
                }
            }
        }
        if (L == 0) { asm volatile("s_waitcnt vmcnt(0)" ::: "memory"); __threadfence(); cg::this_grid().sync(); } else GRID_BAR();

        {
            pg8::Gemm g{WSP(bf16_t, WS_XB), WSP(bf16_t, WS_WIN), SEQ, NIN, DM, DM, DM}; pg8::StaticOrder S; { int bx_ = blockIdx.x; asm volatile("" : "+s"(bx_)); S.init(SEQ, NIN, gridDim.x, bx_); }
            pg8::Epi E{}; E.mode = pg8::EPI_INPROJ; E.obf = WSP(bf16_t, WS_P); E.ldo = NIN; E.f1 = WSP(float, WS_CTL) + CW_SSQ + (2 * L) * SEQ;
            pg8::gemm_phase(lds, g, S, E, wv);
        }
        GRID_BAR();

#ifdef PROBE_P1
        {
            pg8::Gemm g{WSP(bf16_t, WS_XB), WSP(bf16_t, WS_WIN), SEQ, NIN, DM, DM, DM}; pg8::StaticOrder S; { int bx_ = blockIdx.x; asm volatile("" : "+s"(bx_)); S.init(SEQ, NIN, gridDim.x, bx_); }
            pg8::Epi E{}; E.mode = pg8::EPI_INPROJ; E.obf = WSP(bf16_t, WS_P); E.ldo = NIN; E.f1 = WSP(float, WS_CTL) + CW_SSQ + (2 * L) * SEQ;
            pg8::gemm_phase(lds, g, S, E, wv);
        }
        GRID_BAR();

#endif
        {
            PHASE_VARS
            bf16_t* P = WSP(bf16_t, WS_P);
#pragma unroll 1
            for (int t = GW; t < SEQ; t += NGW) {
                bf16_t* pr = P + (size_t)t * NIN;
                LAS float* tab = wscr;
                bf16_t* hb = pr + C_CQ + (lane >> 3) * 192; const int c8 = lane & 7;
                const u32x4 l_aq = *(const u32x4*)(pr + C_AQ + 8 * lane), l_ak = *(const u32x4*)(pr + C_AK + 8 * lane), l_bq = *(const u32x4*)(pr + C_BQ + 8 * lane);
                const u32x4 l_bk = *(const u32x4*)(pr + C_BK + 8 * (lane & 15)), l_iq = *(const u32x4*)(pr + C_IQ + 8 * lane), l_ik = *(const u32x4*)(pr + C_IK + 8 * c8);
                const u32x4 l_kv = *(const u32x4*)(pr + C_CKV + 8 * lane);
                const u32x4 l_c0 = *(const u32x4*)(hb + 8 * c8), l_c1 = *(const u32x4*)(hb + 64 + 8 * c8), l_c2 = *(const u32x4*)(hb + 128 + 8 * c8);
                rope_table(tab, (float)t, lane);
                pp_chunk<64, 16, true>(l_aq, pr + C_AQ + 8 * lane, lane & 7, true, INP(3) + L * 64, tab, 0.125f * LOG2E);
                pp_chunk<64, 16, true>(l_ak, pr + C_AK + 8 * lane, lane & 7, true, INP(4) + L * 64, tab, 1.f);
                pp_chunk<128, 32, true>(l_bq, pr + C_BQ + 8 * lane, lane & 15, true, INP(7) + L * 128, tab + 8, 0.08838834764831845f * LOG2E);
                pp_chunk<128, 32, true>(l_bk, pr + C_BK + 8 * (lane & 15), lane & 15, lane < 16, INP(8) + L * 128, tab + 8, 1.f);
                pp_chunk<64, 16, false>(l_iq, pr + C_IQ + 8 * lane, lane & 7, true, nullptr, tab, 1.f);
                pp_chunk<64, 16, true>(l_ik, WSP(bf16_t, WS_IKC) + ((size_t)(((t >> 5) * 4 + (c8 >> 1)) * 64 + (c8 & 1) * 32 + (t & 31))) * 8, c8, lane < 8, INP(9) + L * 64, tab, 1.f);
                pp_chunk<512, 0, true>(l_kv, pr + C_CKV + 8 * lane, lane, true, INP(11) + L * 512, tab, 1.f);
                pp_head192(l_c0, l_c1, l_c2, hb, c8, INP(10) + L * 192, tab + 24, 0.07216878364870323f * LOG2E);
                LDS_WAIT(); asm volatile("" ::: "memory");
            }
            bf16_t* VTA = WSP(bf16_t, WS_VTA);
#pragma unroll 1
            for (int it = GW; it < 128 * 8; it += NGW) {
                const int tb = it >> 3, cb = it & 7;
                trb_item(P + (size_t)(64 * tb) * NIN + C_AV + 64 * cb, NIN, VTA + (size_t)(64 * cb) * SEQ + 64 * tb, SEQ, (LAS unsigned short*)wscr, lane);
            }
        }
        GRID_BAR();

        {
            pg8::Gemm g{WSP(bf16_t, WS_P) + C_CKV, WSP(bf16_t, WS_WKVB), SEQ, 2048, 512, NIN, 512}; pg8::StaticOrder S; { int bx_ = blockIdx.x; asm volatile("" : "+s"(bx_)); S.init(SEQ, 2048, gridDim.x, bx_); }
            pg8::Epi E{}; E.mode = pg8::EPI_PLAIN; E.obf = WSP(bf16_t, WS_KVB); E.ldo = 2048;
            pg8::gemm_phase(lds, g, S, E, wv);
        }
        GRID_BAR();

        {
            PHASE_VARS
            const bf16_t* P = WSP(bf16_t, WS_P); const bf16_t* KVB = WSP(bf16_t, WS_KVB); bf16_t* KC = WSP(bf16_t, WS_KC); bf16_t* VTC = WSP(bf16_t, WS_VTC);
            const float* c_k_norm = INP(13) + L * 192;
#pragma unroll 1
            for (int t = GW; t < SEQ; t += NGW) {
                const int h = lane >> 3, ci = lane & 7;
                const bf16_t* kv = KVB + (size_t)t * 2048 + h * 256;
                const u32x4 a0 = *(const u32x4*)(P + (size_t)t * NIN + C_CKR + 8 * ci), a1 = *(const u32x4*)(kv + 8 * ci), a2 = *(const u32x4*)(kv + 64 + 8 * ci);
                LAS float* tab = wscr;
                rope_table(tab, (float)t, lane);
                pp_head192(a0, a1, a2, KC + (size_t)t * 1536 + h * 192, ci, c_k_norm, tab + 24, 1.f);
                LDS_WAIT(); asm volatile("" ::: "memory");
            }
#pragma unroll 1
            for (int it = GW; it < 128 * 16; it += NGW) {
                const int tb = it >> 4, cb = it & 15, h = cb >> 1, d0 = (cb & 1) * 64;
                trb_item(KVB + (size_t)(64 * tb) * 2048 + h * 256 + 128 + d0, 2048, VTC + (size_t)(h * 128 + d0) * SEQ + 64 * tb, SEQ, (LAS unsigned short*)wscr, lane);
            }
        }
        GRID_BAR();

#define RUN_P5(QSLOT, ITEM_LO, ITEM_HI, DSAMODE) { \
            const int xq = (int)(xb_xcc_id() & 7u);       \
            int dx = ((ITEM_LO) == 0) ? 0 : 8;             \
            _Pragma("unroll 1") for (;;) { \
                PHASE_VARS \
                volatile LAS unsigned* MISC = (volatile LAS unsigned*)(lds + MISC_OFF); \
                int item = -1, dj = 0, dqb = 0; \
                while (dx < 8) { \
                    const int xs = (xq + dx) & 7; \
                    __syncthreads(); \
                    if (tid == 0) MISC[16] = atomicAdd(WSP(unsigned, WS_CTL) + CW_Q + 64 * (16 + 8 * (QSLOT) + xs), 1u); \
                    __syncthreads(); \
                    const int di = (int)__builtin_amdgcn_readfirstlane(MISC[16]); \
                    if (di < 64) { const unsigned e = dense_order(di); dj = (e >> 7) ? 8 + xs : xs; dqb = (int)(e & 31u); item = 0; break; } \
                    ++dx; \
                } \
                if (item < 0) { \
                    __syncthreads(); \
                    if (tid == 0) MISC[16] = atomicAdd(WSP(unsigned, WS_CTL) + CW_Q + 64 * (QSLOT), 1u); \
                    __syncthreads(); \
                    item = 512 + (int)__builtin_amdgcn_readfirstlane(MISC[16]); \
                    if (item >= (ITEM_HI)) break; \
                } \
                bf16_t* P = WSP(bf16_t, WS_P); bf16_t* AO = WSP(bf16_t, WS_AO); \
                if (item < 512) { \
                    const int qb = dqb, j = dj; \
                    if (j < 8) attn_unit<192>(lds, P + C_CQ + j * 192, NIN, WSP(bf16_t, WS_KC) + j * 192, 1536, WSP(bf16_t, WS_VTC) + (size_t)j * 128 * SEQ, qb, nullptr, 0, AO + 1024 + j * 128, DM, wv); \
                    else { const int hm = j - 8; attn_unit<64>(lds, P + C_AQ + hm * 64, NIN, P + C_AK + hm * 64, NIN, WSP(bf16_t, WS_VTA) + (size_t)(hm >> 1) * 128 * SEQ, qb, WSP(float, WS_OA32) + hm * 128, 1024, nullptr, 0, wv); } \
                } else { \
                    const int t0 = (511 - (item - 512)) * 16; \
                    dsa_item<DSAMODE>(lds, P, WSP(bf16_t, WS_IKC), WSP(float, WS_SCR) + (size_t)bx * 16 * SEQ, WSP(unsigned short, WS_SCR16) + (size_t)bx * 16 * SEQ, (DSAMODE == 15 ? AO + 512 : WSP(bf16_t, WS_OA32)), t0, wv); \
                } \
            } \
        }
        RUN_P5(L, 0, 1024, 15)
#ifdef PROBE_DENSE
        GRID_BAR();
        RUN_P5(L + 2, 0, 512, 15)
#endif
#ifdef PROBE_P5
        GRID_BAR();
        RUN_P5(L + 6, 0, 1024, 15)
#endif
#ifdef PROBE_DSA
        GRID_BAR();
        RUN_P5(L + 4, 512, 1024, PROBE_DSA)
#endif
        GRID_BAR();

        {
            PHASE_VARS
            const float lam_init = (L == 0) ? 0.2f : (0.8f - 0.6f * 0.7408182206817179f);
            const float* a_lambda = INP(5) + L * 256; const float* a_sub_norm = INP(6) + L * 128;
            const float* OA32 = WSP(float, WS_OA32); bf16_t* AO = WSP(bf16_t, WS_AO);
            float lam;
            { const float a = a_lambda[lane] * a_lambda[64 + lane], b = a_lambda[128 + lane] * a_lambda[192 + lane];
              lam = expf(wave_sum(a)) - expf(wave_sum(b)) + lam_init; }
            const float g0 = a_sub_norm[2 * lane], g1 = a_sub_norm[2 * lane + 1];
#pragma unroll 1
            for (int t = GW; t < SEQ; t += NGW) {
                float a1[4][2], a2[4][2];
#pragma unroll
                for (int h = 0; h < 4; ++h) {
                    const float* o1 = OA32 + (size_t)t * 1024 + (2 * h) * 128 + 2 * lane;
                    a1[h][0] = o1[0]; a1[h][1] = o1[1]; a2[h][0] = o1[128]; a2[h][1] = o1[129];
                }
#pragma unroll
                for (int h = 0; h < 4; ++h) {
                    const float d0 = a1[h][0] - lam * a2[h][0], d1 = a1[h][1] - lam * a2[h][1];
                    const float ss = wave_sum(d0 * d0 + d1 * d1);
                    const float r = (1.0f / sqrtf(ss * (1.f / 128.f) + NORM_EPS)) * (1.f - lam_init);
                    *(unsigned*)(AO + (size_t)t * DM + h * 128 + 2 * lane) = pk2(d0 * r * g0, d1 * r * g1);
                }
            }
        }
        GRID_BAR();

#pragma unroll 1
        for (int br = 0; br < 3; ++br) {
            pg8::StaticOrder S; { int bx_ = blockIdx.x; asm volatile("" : "+s"(bx_)); S.init(SEQ, DM, gridDim.x, bx_); }
            const int ko = (br == 2) ? 1024 : 512 * br;
            pg8::Gemm g{WSP(bf16_t, WS_AO) + ko, WSP(bf16_t, WS_WBR) + ko, SEQ, DM, (br == 2) ? 1024 : 512, DM, DM};
            pg8::Epi E{}; E.mode = pg8::EPI_BR0 + br; E.gate = WSP(bf16_t, WS_P) + C_G + br * DM; E.ldg = NIN; E.f0 = WSP(float, WS_SCR); E.obf = WSP(bf16_t, WS_MG); E.ldo = DM;
            pg8::gemm_phase(lds, g, S, E, wv);
        }
        GRID_BAR();

        {
            pg8::Gemm g{WSP(bf16_t, WS_MG), WSP(bf16_t, WS_WOUT), SEQ, DM, DM, DM, DM}; pg8::StaticOrder S; { int bx_ = blockIdx.x; asm volatile("" : "+s"(bx_)); S.init(SEQ, DM, gridDim.x, bx_); }
            pg8::Epi E{}; E.mode = pg8::EPI_RESID; E.f1 = (L == 0) ? INP(0) : (const float*)(const GAS float*)tabp(19); E.f0 = (float*)(GAS float*)tabp(19); E.obf = WSP(bf16_t, WS_XB); E.ldo = DM;
            E.f2 = WSP(float, WS_CTL) + CW_SSQ + (2 * L + 1) * SEQ;
            pg8::gemm_phase(lds, g, S, E, wv);
        }
        GRID_BAR();

        {
            pg8::Gemm g{WSP(bf16_t, WS_XB), WSP(bf16_t, WS_WGU), SEQ, NGU, DM, DM, DM}; pg8::StaticOrder S; { int bx_ = blockIdx.x; asm volatile("" : "+s"(bx_)); S.init(SEQ, NGU, gridDim.x, bx_); }
            pg8::Epi E{}; E.mode = pg8::EPI_SWIGLU; E.obf = WSP(bf16_t, WS_P); E.ldo = DFF; E.f1 = WSP(float, WS_CTL) + CW_SSQ + (2 * L + 1) * SEQ;
            pg8::gemm_phase(lds, g, S, E, wv);
        }
        GRID_BAR();

#ifdef PROBE_P9
        {
            pg8::Gemm g{WSP(bf16_t, WS_XB), WSP(bf16_t, WS_WGU), SEQ, NGU, DM, DM, DM}; pg8::StaticOrder S; { int bx_ = blockIdx.x; asm volatile("" : "+s"(bx_)); S.init(SEQ, NGU, gridDim.x, bx_); }
            pg8::Epi E{}; E.mode = pg8::EPI_SWIGLU; E.obf = WSP(bf16_t, WS_P); E.ldo = DFF; E.f1 = WSP(float, WS_CTL) + CW_SSQ + (2 * L + 1) * SEQ;
            pg8::gemm_phase(lds, g, S, E, wv);
        }
        GRID_BAR();

#endif
        {
            pg8::Gemm g{WSP(bf16_t, WS_P), WSP(bf16_t, WS_WDN), SEQ, DM, DFF, DFF, DFF}; pg8::StaticOrder S; { int bx_ = blockIdx.x; asm volatile("" : "+s"(bx_)); S.init(SEQ, DM, gridDim.x, bx_); }
            pg8::Epi E{}; E.mode = pg8::EPI_RESID; E.f1 = (const float*)(const GAS float*)tabp(19); E.f0 = (float*)(GAS float*)tabp(19); E.obf = WSP(bf16_t, WS_XB); E.ldo = DM;
            E.f2 = WSP(float, WS_CTL) + CW_SSQ + (2 * L + 2) * SEQ;
            pg8::gemm_phase(lds, g, S, E, wv);
        }
        GRID_BAR();

}

__global__ void __launch_bounds__(512) fwd_kernel(Args args) {
    extern __shared__ __attribute__((aligned(16))) unsigned char lds_raw[];
    LAS unsigned char* lds = (LAS unsigned char*)lds_raw;
    const int wv = __builtin_amdgcn_readfirstlane((int)(threadIdx.x >> 6));
    {
        const int tid = tid_of(wv);
        volatile LAS unsigned* MISC = (volatile LAS unsigned*)(lds + MISC_OFF);
        for (int u = tid; u < 64; u += 512) MISC[u] = 0u;
        if (tid < 21) {
            const unsigned long long v = (tid < 19) ? (unsigned long long)args.in[tid] : (tid == 19 ? (unsigned long long)args.out : (unsigned long long)args.ws);
            volatile LAS unsigned* p = (volatile LAS unsigned*)(lds + TAB_OFF + 8 * tid);
            p[0] = (unsigned)v; p[1] = (unsigned)(v >> 32);
        }
        __syncthreads();
        (void)xcd_barrier_post(WSP(unsigned, WS_CTL) + CW_BAR, MISC + 8);
    }

    layer_fwd<0>(lds, wv);
    layer_fwd<1>(lds, wv);
}

extern "C" void kernel_launch(void* const* d_in, const int* in_sizes, int n_in, void* d_out, int out_size, void* d_ws, size_t ws_size, hipStream_t stream) {
    static int grid = 0;
    if (grid == 0) {
        if (n_in != 19 || ws_size < WS_END) { fprintf(stderr, "kernel_launch: unexpected inputs (n_in %d, ws %zu, need %zu)\n", n_in, ws_size, (size_t)WS_END); grid = -1; return; }
        int dev = 0, cus = 0, per_cu = 0;
        hipGetDevice(&dev);
        hipDeviceGetAttribute(&cus, hipDeviceAttributeMultiprocessorCount, dev);
        hipFuncSetAttribute((const void*)fwd_kernel, hipFuncAttributeMaxDynamicSharedMemorySize, LDS_BYTES);
        hipOccupancyMaxActiveBlocksPerMultiprocessor(&per_cu, (const void*)fwd_kernel, 512, LDS_BYTES);
        (void)hipGetLastError();
        if (per_cu < 1) per_cu = 1;
        grid = cus;
        if (grid > 256) grid = 256;
    }
    if (grid < 0) return;
    hipMemsetAsync((char*)d_ws + WS_CTL, 0, CTL_BYTES, stream);
    Args a{};
    for (int i = 0; i < 19; ++i) a.in[i] = (const float*)d_in[i];
    a.out = (float*)d_out; a.ws = (unsigned char*)d_ws;
    void* kargs[] = {&a};
    hipError_t e = hipLaunchCooperativeKernel((const void*)fwd_kernel, dim3(grid), dim3(512), kargs, LDS_BYTES, stream);
    if (e != hipSuccess) fprintf(stderr, "cooperative launch failed: %s (grid %d)\n", hipGetErrorString(e), grid);
}
```

```cpp
#include <hip/hip_runtime.h>
#include <hip/hip_cooperative_groups.h>
#include <cstdio>
#include <cstdint>
namespace cg = cooperative_groups;

#define GAS __attribute__((address_space(1)))
#define LAS __attribute__((address_space(3)))
typedef unsigned short bf16_t;
typedef short bf16x8 __attribute__((ext_vector_type(8)));
typedef float f32x4 __attribute__((ext_vector_type(4)));
typedef float f32x16 __attribute__((ext_vector_type(16)));
typedef unsigned u32x4 __attribute__((ext_vector_type(4)));
typedef unsigned u32x2 __attribute__((ext_vector_type(2)));

constexpr int SEQ = 8192, DM = 2048, NIN = 11264, DFF = 5632, NGU = 11264, INW = 11144;
constexpr int C_AQ = 0, C_AK = 512, C_AV = 1024, C_BQ = 1536, C_BK = 2048, C_BV = 2176, C_IQ = 2304, C_IK = 2816, C_CKR = 2880,
              C_CQ = 2944, C_CKV = 4480, C_IW = 4992, C_G = 5120;
constexpr float NORM_EPS = 1e-6f;
constexpr float LOG2E = 1.4426950408889634f;
constexpr float LOG2_THETA = 18.931568569324174f;

constexpr size_t MiB = 1u << 20;
constexpr size_t WS_CTL = 0, CTL_BYTES = 1 * MiB;
constexpr size_t WS_WIN = 1 * MiB;
constexpr size_t WS_WKVB = WS_WIN + 44 * MiB;
constexpr size_t WS_WBR = WS_WKVB + 2 * MiB;
constexpr size_t WS_WOUT = WS_WBR + 8 * MiB;
constexpr size_t WS_WGU = WS_WOUT + 8 * MiB;
constexpr size_t WS_WDN = WS_WGU + 44 * MiB;
constexpr size_t WS_P = WS_WDN + 22 * MiB;
constexpr size_t WS_XB = WS_P + 176 * MiB;
constexpr size_t WS_AO = WS_XB + 32 * MiB;
constexpr size_t WS_KC = WS_AO + 32 * MiB;
constexpr size_t WS_VTC = WS_KC + 24 * MiB;
constexpr size_t WS_VTA = WS_VTC + 16 * MiB;
constexpr size_t WS_KVB = WS_VTA + 8 * MiB;
constexpr size_t WS_MG = WS_KVB + 32 * MiB;
constexpr size_t WS_OA32 = WS_MG + 32 * MiB;
constexpr size_t WS_SCR = WS_OA32 + 32 * MiB;
constexpr size_t WS_IKC = WS_SCR + 128 * MiB;
constexpr size_t WS_SCR16 = WS_KVB;
constexpr size_t WS_END = WS_IKC + 1 * MiB;
static_assert(WS_END <= 704 * MiB, "workspace");
constexpr int CW_BAR = 4096;
constexpr int CW_Q = 8192;
constexpr int CW_SSQ = 16384;

__device__ __forceinline__ unsigned f2bf(float f) { unsigned u = __builtin_bit_cast(unsigned, f); return (u + 0x7fffu + ((u >> 16) & 1u)) >> 16; }
__device__ __forceinline__ unsigned pk2(float lo, float hi) { return f2bf(lo) | (f2bf(hi) << 16); }
__device__ __forceinline__ float bf2f(unsigned short b) { return __builtin_bit_cast(float, (unsigned)b << 16); }
__device__ __forceinline__ unsigned cvt_pk_bf16(float lo, float hi) { unsigned r; asm volatile("v_cvt_pk_bf16_f32 %0, %1, %2" : "=v"(r) : "v"(lo), "v"(hi)); return r; }
__device__ __forceinline__ void unpack8(u32x4 w, float* x) {
    x[0] = __builtin_bit_cast(float, w.x << 16); x[1] = __builtin_bit_cast(float, w.x & 0xffff0000u);
    x[2] = __builtin_bit_cast(float, w.y << 16); x[3] = __builtin_bit_cast(float, w.y & 0xffff0000u);
    x[4] = __builtin_bit_cast(float, w.z << 16); x[5] = __builtin_bit_cast(float, w.z & 0xffff0000u);
    x[6] = __builtin_bit_cast(float, w.w << 16); x[7] = __builtin_bit_cast(float, w.w & 0xffff0000u);
}
__device__ __forceinline__ u32x4 pack8(const float* x) { u32x4 w; w.x = pk2(x[0], x[1]); w.y = pk2(x[2], x[3]); w.z = pk2(x[4], x[5]); w.w = pk2(x[6], x[7]); return w; }
__device__ __forceinline__ float wave_sum_dpp(float x);
__device__ __forceinline__ float wave_sum(float v) { return wave_sum_dpp(v); }


template <int CTRL> __device__ __forceinline__ float dppf(float x) { return __builtin_bit_cast(float, __builtin_amdgcn_update_dpp(0, __builtin_bit_cast(int, x), CTRL, 0xf, 0xf, false)); }
__device__ __forceinline__ float rdl(float x, int l) { return __builtin_bit_cast(float, __builtin_amdgcn_readlane(__builtin_bit_cast(int, x), l)); }
__device__ __forceinline__ float wave_max_dpp(float x) {
    x = fmaxf(x, dppf<0xB1>(x)); x = fmaxf(x, dppf<0x4E>(x)); x = fmaxf(x, dppf<0x141>(x)); x = fmaxf(x, dppf<0x140>(x));
    return fmaxf(fmaxf(rdl(x, 0), rdl(x, 16)), fmaxf(rdl(x, 32), rdl(x, 48)));
}
__device__ __forceinline__ float wave_sum_dpp(float x) {
    x += dppf<0xB1>(x); x += dppf<0x4E>(x); x += dppf<0x141>(x); x += dppf<0x140>(x);
    return (rdl(x, 0) + rdl(x, 16)) + (rdl(x, 32) + rdl(x, 48));
}
__device__ __forceinline__ float xhalf_max(float m) {
    unsigned a = __builtin_bit_cast(unsigned, m), b = a; asm volatile("" : "+v"(b));
    auto rr = __builtin_amdgcn_permlane32_swap(a, b, false, false);
    unsigned r0 = rr[0], r1 = rr[1]; asm volatile("" : "+v"(r0), "+v"(r1));
    return fmaxf(__builtin_bit_cast(float, r0), __builtin_bit_cast(float, r1)); }
__device__ __forceinline__ float xhalf_sum(float m) {
    unsigned a = __builtin_bit_cast(unsigned, m), b = a; asm volatile("" : "+v"(b));
    auto rr = __builtin_amdgcn_permlane32_swap(a, b, false, false);
    unsigned r0 = rr[0], r1 = rr[1]; asm volatile("" : "+v"(r0), "+v"(r1));
    return __builtin_bit_cast(float, r0) + __builtin_bit_cast(float, r1); }
template <int O> __device__ __forceinline__ float swz_xor(float x) { return __builtin_bit_cast(float, __builtin_amdgcn_ds_swizzle(__builtin_bit_cast(int, x), 0x1F | (O << 10))); }
__device__ __forceinline__ float fexp2(float x) { return __builtin_amdgcn_exp2f(x); }
__device__ __forceinline__ int tid_of(int wv) { int l = (int)__builtin_amdgcn_mbcnt_hi(~0u, __builtin_amdgcn_mbcnt_lo(~0u, 0u)); asm volatile("" : "+v"(l)); return wv * 64 + l; }
#define LDS_WAIT() asm volatile("s_waitcnt lgkmcnt(0)" ::: "memory")

namespace pg8 {
constexpr int BM = 256, BK = 64, HALF = 128, HTB = HALF * BK * 2, STAGE_BYTES = 8 * HTB, NXCD = 8, WGM = 8;
__host__ __device__ __forceinline__ int lds_byte(int r, int c) { const int st = (r >> 4) * 2 + (c >> 5), rr = r & 15, cc = c & 31, ob = rr * 64 + cc * 2; return st * 1024 + (ob ^ (((ob >> 9) & 1) << 5)); }
__host__ __device__ __forceinline__ void stage_rc(int b, int& R, int& C) { const int st = b / 1024, sb = b % 1024, swz = sb ^ (((sb >> 9) & 1) << 5); R = (st >> 1) * 16 + swz / 64; C = (st & 1) * 32 + (swz % 64) / 2; }
__host__ __device__ __forceinline__ int perm32(int rho) { const int n = rho >> 4, i = rho & 15; return 8 * (i >> 2) + 4 * n + (i & 3); }
struct Unit { int pm, pn; };
struct Gemm { const bf16_t* A; const bf16_t* Bt; int M, N, K, lda, ldb; };
struct StaticOrder {
    int nM, nN, nwg, G, c;
    __device__ void init(int M, int N, int G_, int c_) { nM = M / BM; nN = N / BM; nwg = nM * nN; G = G_; c = c_; }
    __device__ bool next(int i, Unit& u) const {
        const long L = (long)i * G + c; if (L >= nwg) return false;
        int wgid = (int)L; { const int q = nwg / NXCD, r = nwg % NXCD, xcd = wgid % NXCD, off = wgid / NXCD; wgid = (xcd < r ? xcd * (q + 1) : r * (q + 1) + (xcd - r) * q) + off; }
        const int nig = WGM * nN, gid = wgid / nig, fm = gid * WGM, gsz = (nM - fm) < WGM ? (nM - fm) : WGM;
        u.pm = fm + ((wgid % nig) % gsz); u.pn = (wgid % nig) / gsz; return true;
    }
};

enum { EPI_INPROJ = 0, EPI_PLAIN = 1, EPI_BR0 = 2, EPI_BR1 = 3, EPI_BR2 = 4, EPI_RESID = 5, EPI_SWIGLU = 6 };
struct Epi {
    int mode, ldo, ldg;
    bf16_t* obf;
    const bf16_t* gate;
    float* f0;
    const float* f1;
    float* f2;
    __device__ __forceinline__ void operator()(const f32x4 (&acc)[2][2][4][2], const Unit& u, int wr, int wc, int fr, int fq) const {
        const int row0 = u.pm * BM + wr * 64 + fr;
        const int colt = u.pn * BM + wc * 32 + 8 * fq;
        if (mode == EPI_INPROJ || mode == EPI_PLAIN) {
            const bool sg = (mode == EPI_INPROJ) && (u.pn * BM >= C_G);
            float rs[2][4];
#pragma unroll
            for (int ai = 0; ai < 2; ++ai)
#pragma unroll
                for (int m = 0; m < 4; ++m) rs[ai][m] = (mode == EPI_INPROJ) ? f1[row0 + ai * HALF + m * 16] : 0.f;
#pragma unroll
            for (int ai = 0; ai < 2; ++ai)
#pragma unroll
                for (int m = 0; m < 4; ++m) {
                    const int row = row0 + ai * HALF + m * 16;
                    float r = 1.f;
                    if (mode == EPI_INPROJ) r = __builtin_amdgcn_rsqf(rs[ai][m] * (1.f / DM) + NORM_EPS);
#pragma unroll
                    for (int bj = 0; bj < 2; ++bj) {
                        float v[8];
#pragma unroll
                        for (int j = 0; j < 4; ++j) { v[j] = acc[ai][bj][m][0][j] * r; v[4 + j] = acc[ai][bj][m][1][j] * r; }
                        if (sg) {
#pragma unroll
                            for (int j = 0; j < 8; ++j) v[j] = __builtin_amdgcn_rcpf(1.f + __expf(-v[j]));
                        }
                        u32x4 w; w.x = cvt_pk_bf16(v[0], v[1]); w.y = cvt_pk_bf16(v[2], v[3]); w.z = cvt_pk_bf16(v[4], v[5]); w.w = cvt_pk_bf16(v[6], v[7]);
                        *(u32x4*)(obf + (size_t)row * ldo + colt + bj * HALF) = w;
                    }
                }
        } else if (mode == EPI_BR0 || mode == EPI_BR1 || mode == EPI_BR2) {
#pragma unroll
            for (int ai = 0; ai < 2; ++ai)
#pragma unroll
                for (int mh = 0; mh < 2; ++mh) {
                    u32x4 gw[2][2], pw[2][2];
#pragma unroll
                    for (int mm = 0; mm < 2; ++mm)
#pragma unroll
                        for (int bj = 0; bj < 2; ++bj) {
                            const int row = row0 + ai * HALF + (2 * mh + mm) * 16, col = colt + bj * HALF;
                            gw[mm][bj] = *(const u32x4*)(gate + (size_t)row * ldg + col);
                            if (mode != EPI_BR0) pw[mm][bj] = *(const u32x4*)((const bf16_t*)f0 + (size_t)row * DM + col);
                        }
#pragma unroll
                    for (int mm = 0; mm < 2; ++mm)
#pragma unroll
                        for (int bj = 0; bj < 2; ++bj) {
                            const int m = 2 * mh + mm;
                            const int row = row0 + ai * HALF + m * 16, col = colt + bj * HALF;
                            float g[8]; unpack8(gw[mm][bj], g);
                            float v[8];
#pragma unroll
                            for (int j = 0; j < 4; ++j) { v[j] = acc[ai][bj][m][0][j] * g[j]; v[4 + j] = acc[ai][bj][m][1][j] * g[4 + j]; }
                            if (mode != EPI_BR0) {
                                float pp[8]; unpack8(pw[mm][bj], pp);
#pragma unroll
                                for (int j = 0; j < 8; ++j) v[j] += pp[j];
                            }
                            u32x4 w; w.x = cvt_pk_bf16(v[0], v[1]); w.y = cvt_pk_bf16(v[2], v[3]); w.z = cvt_pk_bf16(v[4], v[5]); w.w = cvt_pk_bf16(v[6], v[7]);
                            if (mode == EPI_BR2) *(u32x4*)(obf + (size_t)row * ldo + col) = w;
                            else *(u32x4*)((bf16_t*)f0 + (size_t)row * DM + col) = w;
                        }
                }
        } else if (mode == EPI_RESID) {
#pragma unroll
            for (int ai = 0; ai < 2; ++ai)
#pragma unroll
                for (int mh = 0; mh < 2; ++mh) {
                    f32x4 x0[2][2], x1[2][2];
#pragma unroll
                    for (int mm = 0; mm < 2; ++mm)
#pragma unroll
                        for (int bj = 0; bj < 2; ++bj) {
                            const float* xp = f1 + (size_t)(row0 + ai * HALF + (2 * mh + mm) * 16) * DM + colt + bj * HALF;
                            x0[mm][bj] = *(const f32x4*)xp; x1[mm][bj] = *(const f32x4*)(xp + 4);
                        }
#pragma unroll
                    for (int mm = 0; mm < 2; ++mm) {
                        const int m = 2 * mh + mm;
                        const int row = row0 + ai * HALF + m * 16;
                        float ss = 0.f;
#pragma unroll
                        for (int bj = 0; bj < 2; ++bj) {
                            const int col = colt + bj * HALF;
                            float v[8];
#pragma unroll
                            for (int j = 0; j < 4; ++j) { v[j] = acc[ai][bj][m][0][j] + x0[mm][bj][j]; v[4 + j] = acc[ai][bj][m][1][j] + x1[mm][bj][j]; }
#pragma unroll
                            for (int j = 0; j < 8; ++j) ss += v[j] * v[j];
                            float* op = f0 + (size_t)row * DM + col;
                            *(f32x4*)op = (f32x4){v[0], v[1], v[2], v[3]}; *(f32x4*)(op + 4) = (f32x4){v[4], v[5], v[6], v[7]};
                            u32x4 w; w.x = cvt_pk_bf16(v[0], v[1]); w.y = cvt_pk_bf16(v[2], v[3]); w.z = cvt_pk_bf16(v[4], v[5]); w.w = cvt_pk_bf16(v[6], v[7]);
                            *(u32x4*)(obf + (size_t)row * ldo + col) = w;
                        }
                        ss += swz_xor<16>(ss); ss = xhalf_sum(ss);
                        if (fq == 0) atomicAdd(f2 + row, ss);
                    }
                }
        } else {
            const int colh = u.pn * HALF + wc * 32 + 8 * fq;
            float rs[2][4];
#pragma unroll
            for (int ai = 0; ai < 2; ++ai)
#pragma unroll
                for (int m = 0; m < 4; ++m) rs[ai][m] = f1[row0 + ai * HALF + m * 16];
#pragma unroll
            for (int ai = 0; ai < 2; ++ai)
#pragma unroll
                for (int m = 0; m < 4; ++m) {
                    const int row = row0 + ai * HALF + m * 16;
                    const float r = __builtin_amdgcn_rsqf(rs[ai][m] * (1.f / DM) + NORM_EPS);
                    float v[8];
#pragma unroll
                    for (int n = 0; n < 2; ++n)
#pragma unroll
                        for (int j = 0; j < 4; ++j) {
                            const float g = acc[ai][0][m][n][j] * r, up = acc[ai][1][m][n][j] * r;
                            v[4 * n + j] = g * __builtin_amdgcn_rcpf(1.f + __expf(-g)) * up;
                        }
                    u32x4 w; w.x = cvt_pk_bf16(v[0], v[1]); w.y = cvt_pk_bf16(v[2], v[3]); w.z = cvt_pk_bf16(v[4], v[5]); w.w = cvt_pk_bf16(v[6], v[7]);
                    *(u32x4*)(obf + (size_t)row * ldo + colh) = w;
                }
        }
    }
};

__device__ __forceinline__ void gemm_phase(LAS unsigned char* lds, const Gemm g, const StaticOrder& S, const Epi& E, int wv) {
    const int tid = tid_of(wv);
    const int wid = __builtin_amdgcn_readfirstlane(tid >> 6), lane = tid & 63, wr = wid >> 2, wc = wid & 3, fr = lane & 15, fq = lane >> 4;
    const int K = g.K, nt = K / BK;
    unsigned voffA[2], voffB[2];
#pragma unroll
    for (int i = 0; i < 2; ++i) { int R, C; stage_rc(tid * 16 + i * 8192, R, C); const int Rb = (R & ~31) + perm32(R & 31);
        voffA[i] = (unsigned)(R * g.lda + C) * 2u; voffB[i] = (unsigned)(Rb * g.ldb + C) * 2u; }
    const size_t kstep = (size_t)(BK * 2);
    const size_t hstepA = (size_t)HALF * g.lda * 2, hstepB = (size_t)HALF * g.ldb * 2;
    const size_t tstepA = 2 * hstepA, tstepB = 2 * hstepB;
    const unsigned ldsw = (unsigned)wid * 1024u;
    const int aoff = lds_byte(wr * 64 + fr, fq * 8), boff = lds_byte(wc * 32 + fr, fq * 8);
#define PG8_SA(b, h) (((b) * 2 + (h)) * HTB)
#define PG8_SB(b, h) ((4 + (b) * 2 + (h)) * HTB)
#define PG8_STAGE(bufoff, gbase, voff) do { _Pragma("unroll") for (int _i = 0; _i < 2; ++_i) \
        __builtin_amdgcn_global_load_lds((const unsigned*)((const char*)(gbase) + (voff)[_i]), (LAS unsigned*)(lds + (bufoff) + ldsw + _i * 8192), 16, 0, 0); } while (0)
#define PG8_LDA(dst, b, h) do { _Pragma("unroll") for (int m = 0; m < 4; ++m) _Pragma("unroll") for (int k = 0; k < 2; ++k) dst[m][k] = *(const LAS bf16x8*)(lds + PG8_SA(b, h) + aoff + m * 2048 + k * 1024); } while (0)
#define PG8_LDB(dst, b, h) do { _Pragma("unroll") for (int n = 0; n < 2; ++n) _Pragma("unroll") for (int k = 0; k < 2; ++k) dst[n][k] = *(const LAS bf16x8*)(lds + PG8_SB(b, h) + boff + n * 2048 + k * 1024); } while (0)
#define PG8_MMA(ai, bj, At, Bt) do { __builtin_amdgcn_s_setprio(1); _Pragma("unroll") for (int m = 0; m < 4; ++m) _Pragma("unroll") for (int n = 0; n < 2; ++n) _Pragma("unroll") for (int k = 0; k < 2; ++k) \
        acc[ai][bj][m][n] = __builtin_amdgcn_mfma_f32_16x16x32_bf16(Bt[n][k], At[m][k], acc[ai][bj][m][n], 0, 0, 0); __builtin_amdgcn_s_setprio(0); } while (0)
#define PG8_WAIT_V(n) asm volatile("s_waitcnt vmcnt(" #n ")" ::: "memory")
#define PG8_WAIT_L(n) asm volatile("s_waitcnt lgkmcnt(" #n ")" ::: "memory")
#define PG8_BAR __builtin_amdgcn_s_barrier()
#define PG8_SCHED __builtin_amdgcn_sched_barrier(0)
    Unit cur, nxt; int ui = 0;
    if (!S.next(0, cur)) return;
    f32x4 acc[2][2][4][2];
#pragma unroll
    for (int a = 0; a < 2; ++a)
#pragma unroll
        for (int b = 0; b < 2; ++b)
#pragma unroll
            for (int m = 0; m < 4; ++m)
#pragma unroll
                for (int n = 0; n < 2; ++n) acc[a][b][m][n] = (f32x4){0.f, 0.f, 0.f, 0.f};
    bf16x8 At[4][2], B0[2][2], B1[2][2];
    const char* cA = (const char*)g.A + (size_t)cur.pm * tstepA; const char* cB = (const char*)g.Bt + (size_t)cur.pn * tstepB;
    PG8_STAGE(PG8_SB(0, 0), cB, voffB); PG8_STAGE(PG8_SB(0, 1), cB + hstepB, voffB); PG8_STAGE(PG8_SA(0, 0), cA, voffA); PG8_STAGE(PG8_SA(0, 1), cA + hstepA, voffA);
    if (wr == 1) PG8_BAR;
    PG8_WAIT_V(2); PG8_BAR;
    PG8_STAGE(PG8_SB(1, 0), cB + kstep, voffB); PG8_STAGE(PG8_SA(1, 0), cA + kstep, voffA); PG8_STAGE(PG8_SB(1, 1), cB + hstepB + kstep, voffB);
    PG8_WAIT_V(6); PG8_BAR;
    for (;;) {
        const bool has_next = S.next(ui + 1, nxt);
        const char* nA = has_next ? (const char*)g.A + (size_t)nxt.pm * tstepA : cA; const char* nB = has_next ? (const char*)g.Bt + (size_t)nxt.pn * tstepB : cB;
        for (int t = 0; t < nt; t += 2) {
            const bool last = (t == nt - 2);
            const char* a1 = cA + (size_t)(t + 1) * kstep;
            const char* a2 = last ? nA : cA + (size_t)(t + 2) * kstep; const char* b2 = last ? nB : cB + (size_t)(t + 2) * kstep;
            const char* a3 = a2 + kstep; const char* b3 = b2 + kstep;
            PG8_LDB(B0, 0, 0); PG8_LDB(B1, 0, 1); PG8_SCHED; PG8_LDA(At, 0, 0); PG8_STAGE(PG8_SA(1, 1), a1 + hstepA, voffA);
            PG8_WAIT_V(8); PG8_WAIT_L(0); PG8_BAR; PG8_MMA(0, 0, At, B0); PG8_MMA(0, 1, At, B1); PG8_BAR; PG8_SCHED;
            PG8_LDA(At, 0, 1); PG8_STAGE(PG8_SB(0, 0), b2, voffB); PG8_STAGE(PG8_SB(0, 1), b2 + hstepB, voffB); PG8_STAGE(PG8_SA(0, 0), a2, voffA);
            PG8_WAIT_V(8); PG8_WAIT_L(0); PG8_BAR; PG8_MMA(1, 0, At, B0); PG8_MMA(1, 1, At, B1); PG8_BAR; PG8_SCHED;
            PG8_LDB(B0, 1, 0); PG8_LDB(B1, 1, 1); PG8_SCHED; PG8_LDA(At, 1, 0); PG8_STAGE(PG8_SA(0, 1), a2 + hstepA, voffA);
            PG8_WAIT_V(8); PG8_WAIT_L(0); PG8_BAR; PG8_MMA(0, 0, At, B0); PG8_MMA(0, 1, At, B1); PG8_BAR; PG8_SCHED;
            PG8_LDA(At, 1, 1); PG8_STAGE(PG8_SB(1, 0), b3, voffB); PG8_STAGE(PG8_SB(1, 1), b3 + hstepB, voffB); PG8_STAGE(PG8_SA(1, 0), a3, voffA);
            PG8_WAIT_V(8); PG8_WAIT_L(0); PG8_BAR; PG8_MMA(1, 0, At, B0); PG8_MMA(1, 1, At, B1); PG8_BAR; PG8_SCHED;
        }
        if (wr == 0) PG8_BAR;
        E(acc, cur, wr, wc, fr, fq);
        if (!has_next) break;
#pragma unroll
        for (int a = 0; a < 2; ++a)
#pragma unroll
            for (int b = 0; b < 2; ++b)
#pragma unroll
                for (int m = 0; m < 4; ++m)
#pragma unroll
                    for (int n = 0; n < 2; ++n) acc[a][b][m][n] = (f32x4){0.f, 0.f, 0.f, 0.f};
        cur = nxt; cA = nA; cB = nB; ++ui;
        if (wr == 1) PG8_BAR;
    }
    PG8_WAIT_V(0);
    PG8_BAR;
#undef PG8_SA
#undef PG8_SB
#undef PG8_STAGE
#undef PG8_LDA
#undef PG8_LDB
#undef PG8_MMA
#undef PG8_WAIT_V
#undef PG8_WAIT_L
#undef PG8_BAR
#undef PG8_SCHED
}
}

#define XB_TMO      128
#define XB_XCNT(j)  (256  + 64 * (j))
#define XB_XSUB(j)  (1280 + 64 * (j))
#define XB_XGEN(j)  (2304 + 64 * (j))
#define XB_TOP      3328
#define XB_TOPGEN   3392
#define XCD_BAR_WORDS 3456
#define XB_SPIN_CAP (1u << 22)
__device__ __forceinline__ unsigned xb_ld(unsigned* p)              { return __hip_atomic_load(p, __ATOMIC_RELAXED, __HIP_MEMORY_SCOPE_AGENT); }
__device__ __forceinline__ unsigned xb_add(unsigned* p, unsigned v) { return __hip_atomic_fetch_add(p, v, __ATOMIC_RELAXED, __HIP_MEMORY_SCOPE_AGENT); }
__device__ __forceinline__ unsigned xb_xcc_id() { return (unsigned)__builtin_amdgcn_s_getreg((3 << 11) | 20) & 0xFu; }
#define XB_SPIN(cond, bar) do { unsigned _sp = 0; while (cond) { __builtin_amdgcn_s_sleep(1); \
    if ((++_sp & 255u) == 0u) { if (xb_ld(&(bar)[XB_TMO])) break; if (_sp > XB_SPIN_CAP) { atomicAdd(&(bar)[XB_TMO], 1u); break; } } } } while (0)
struct XcdBarrier { unsigned* bar; unsigned x; volatile LAS unsigned* st; };

__device__ __forceinline__ XcdBarrier xcd_barrier_post(unsigned* bar, volatile LAS unsigned* st) {
    XcdBarrier b; b.bar = bar; b.x = xb_xcc_id(); b.st = st;
    if (threadIdx.x == 0) (void)xb_add(&bar[XB_XCNT(b.x)], 1u);
    return b;
}
__device__ __forceinline__ void xcd_barrier_complete(unsigned* bar, unsigned x, unsigned& nloc, unsigned& nx) {
    const unsigned G = gridDim.x * gridDim.y * gridDim.z;
    unsigned sum, cnt, mine, sp = 0u;
    for (;;) {
        sum = 0u; cnt = 0u; mine = 0u;
#pragma unroll
        for (unsigned j = 0; j < 16; ++j) { const unsigned c = xb_ld(&bar[XB_XCNT(j)]); sum += c; cnt += (c > 0u) ? 1u : 0u; mine = (j == x) ? c : mine; }
        if (sum == G) break;
        __builtin_amdgcn_s_sleep(1);
        if ((++sp & 255u) == 0u) { if (xb_ld(&bar[XB_TMO])) break; if (sp > XB_SPIN_CAP) { atomicAdd(&bar[XB_TMO], 1u); break; } }
    }
    nloc = mine > 0u ? mine : 1u; nx = cnt > 0u ? cnt : 1u;
}
__device__ __forceinline__ void xcd_barrier(const XcdBarrier& b, int wv) {
    asm volatile("s_waitcnt vmcnt(0)" ::: "memory");
    __syncthreads();
    if (tid_of(wv) == 0) {
        unsigned* bar = b.bar;
        __builtin_amdgcn_s_waitcnt(0);
        unsigned nloc = b.st[0], nx = b.st[1];
        if (nloc == 0u) { xcd_barrier_complete(bar, b.x, nloc, nx); b.st[0] = nloc; b.st[1] = nx; }
        const unsigned old = xb_add(&bar[XB_XSUB(b.x)], 1u);
        const unsigned gen = old / nloc;
        if (old + 1u == (gen + 1u) * nloc) {
            __builtin_amdgcn_fence(__ATOMIC_RELEASE, "agent");
            asm volatile("s_waitcnt vmcnt(0)" ::: "memory");
            const unsigned og = xb_add(&bar[XB_TOP], 1u);
            const unsigned tg = og / nx;
            if (og + 1u == (tg + 1u) * nx) xb_add(&bar[XB_TOPGEN], 1u);
            else XB_SPIN(xb_ld(&bar[XB_TOPGEN]) == tg, bar);
            __builtin_amdgcn_fence(__ATOMIC_ACQUIRE, "agent");
            xb_add(&bar[XB_XGEN(b.x)], 1u);
            asm volatile("s_waitcnt vmcnt(0)" ::: "memory");
        } else {
            XB_SPIN(xb_ld(&bar[XB_XGEN(b.x)]) == gen, bar);
            __builtin_amdgcn_fence(__ATOMIC_ACQUIRE, "agent");
            asm volatile("s_waitcnt vmcnt(0)" ::: "memory");
        }
    }
    __syncthreads();
}

constexpr int RING_BYTES = 131072, MISC_OFF = RING_BYTES, LDS_BYTES = 147456;

__device__ __forceinline__ int srccol(int cmode, int nd) {
    if (cmode == 0) return nd;
    if (cmode == 1) {
        if (nd < 2880) return nd;
        if (nd < 2944) return 4936 + (nd - 2880);
        if (nd < 4480) return 2888 + (nd - 2944);
        if (nd < 4992) return 4424 + (nd - 4480);
        if (nd < 5000) return 2880 + (nd - 4992);
        if (nd < 5120) return -1;
        return 5000 + (nd - 5120);
    }
    const int p = nd >> 8, j = nd & 255;
    return (j < 128) ? (128 * p + j) : (DFF + 128 * p + (j - 128));
}
__device__ __forceinline__ void tr_item(const float* W, int ldw, int K, bf16_t* WT, int cmode, const float* gain, LAS float* scr, int item, int nblk, int lane) {
    const int kb = item / nblk, nb = item % nblk, k0 = 64 * kb, n0 = 32 * nb;
    const int sc = srccol(cmode, n0 + (lane & 31));
    float v[32];
    const float* wp = W + (size_t)(k0 + (lane >> 5)) * ldw + (sc >= 0 ? sc : 0);
#pragma unroll
    for (int i = 0; i < 32; ++i) v[i] = __builtin_nontemporal_load(wp + (size_t)(2 * i) * ldw);
    if (gain) {
        const float* gp = gain + k0 + (lane >> 5);
#pragma unroll
        for (int i = 0; i < 32; ++i) v[i] *= gp[2 * i];
    }
    if (sc < 0) {
#pragma unroll
        for (int i = 0; i < 32; ++i) v[i] = 0.f;
    }
#pragma unroll
    for (int i = 0; i < 32; ++i) scr[(2 * i + (lane >> 5)) * 33 + (lane & 31)] = v[i];
    LDS_WAIT(); asm volatile("" ::: "memory");
    const int c = lane & 7;
#pragma unroll
    for (int j = 0; j < 4; ++j) { const int n = (lane >> 3) + 8 * j; const LAS float* s = scr + (8 * c) * 33 + n;
        u32x4 o; o.x = pk2(s[0 * 33], s[1 * 33]); o.y = pk2(s[2 * 33], s[3 * 33]); o.z = pk2(s[4 * 33], s[5 * 33]); o.w = pk2(s[6 * 33], s[7 * 33]);
        *(u32x4*)(WT + (size_t)(n0 + n) * K + k0 + 8 * c) = o; }
    LDS_WAIT(); asm volatile("" ::: "memory");
}
__device__ __forceinline__ void trb_item(const bf16_t* src, int lds_, bf16_t* dst, int ldd, LAS unsigned short* scr, int lane) {
#pragma unroll
    for (int i = 0; i < 8; ++i) {
        const int id = lane + 64 * i, row = id >> 3, cc = id & 7;
        const u32x4 w = *(const u32x4*)(src + (size_t)row * lds_ + 8 * cc);
        LAS unsigned* d = (LAS unsigned*)(scr + row * 66 + 8 * cc);
        d[0] = w.x; d[1] = w.y; d[2] = w.z; d[3] = w.w;
    }
    LDS_WAIT(); asm volatile("" ::: "memory");
#pragma unroll
    for (int i = 0; i < 8; ++i) {
        const int id = lane + 64 * i, c = id >> 3, tc = id & 7;
        const LAS unsigned short* s = scr + (8 * tc) * 66 + c;
        u32x4 o;
        o.x = (unsigned)s[0] | ((unsigned)s[66] << 16); o.y = (unsigned)s[2 * 66] | ((unsigned)s[3 * 66] << 16);
        o.z = (unsigned)s[4 * 66] | ((unsigned)s[5 * 66] << 16); o.w = (unsigned)s[6 * 66] | ((unsigned)s[7 * 66] << 16);
        *(u32x4*)(dst + (size_t)c * ldd + 8 * tc) = o;
    }
    LDS_WAIT(); asm volatile("" ::: "memory");
}

__device__ __forceinline__ float inv_freq(int fi, int rot) { return exp2f(-((float)fi * 2.0f / (float)rot) * LOG2_THETA); }
template <int HD, int ROT, bool NORM>
__device__ __forceinline__ void pp_chunk(u32x4 xin, bf16_t* dst, int ci, bool act, const float* gain, const LAS float* tab, float oscale) {
    float x[8]; unpack8(xin, x);
    if (NORM) {
        float ss = 0.f;
#pragma unroll
        for (int j = 0; j < 8; ++j) ss += x[j] * x[j];
        if (HD == 512) ss = wave_sum_dpp(ss);
        else { ss += dppf<0xB1>(ss); ss += dppf<0x4E>(ss); ss += dppf<0x141>(ss); if (HD == 128) ss += dppf<0x140>(ss); }
        const float r = 1.0f / sqrtf(ss * (1.f / HD) + NORM_EPS);
#pragma unroll
        for (int j = 0; j < 8; ++j) x[j] = x[j] * r * gain[8 * ci + j];
    }
    if (ROT > 0) {
        float oth[8];
#pragma unroll
        for (int j = 0; j < 8; ++j) oth[j] = swz_xor<(ROT / 16)>(x[j]);
        if (ci < ROT / 8) {
            const bool first = ci < ROT / 16;
#pragma unroll
            for (int j = 0; j < 8; ++j) {
                const int fi = 8 * (ci & (ROT / 16 - 1)) + j;
                const float cs = tab[fi], sn = tab[64 + fi];
                x[j] = first ? (x[j] * cs - oth[j] * sn) : (x[j] * cs + oth[j] * sn);
            }
        }
    }
#pragma unroll
    for (int j = 0; j < 8; ++j) x[j] *= oscale;
    if (act) *(u32x4*)dst = pack8(x);
}
__device__ __forceinline__ void pp_head192(u32x4 a0, u32x4 a1, u32x4 a2, bf16_t* d, int ci, const float* gain, const LAS float* tab, float oscale) {
    float x0[8], x1[8], x2[8];
    unpack8(a0, x0); unpack8(a1, x1); unpack8(a2, x2);
    float ss = 0.f;
#pragma unroll
    for (int j = 0; j < 8; ++j) ss += x0[j] * x0[j] + x1[j] * x1[j] + x2[j] * x2[j];
    ss += dppf<0xB1>(ss); ss += dppf<0x4E>(ss); ss += dppf<0x141>(ss);
    const float r = 1.0f / sqrtf(ss * (1.f / 192.f) + NORM_EPS);
#pragma unroll
    for (int j = 0; j < 8; ++j) { x0[j] = x0[j] * r * gain[8 * ci + j]; x1[j] = x1[j] * r * gain[64 + 8 * ci + j]; x2[j] = x2[j] * r * gain[128 + 8 * ci + j]; }
    float oth[8];
#pragma unroll
    for (int j = 0; j < 8; ++j) oth[j] = swz_xor<4>(x0[j]);
    const bool first = ci < 4;
#pragma unroll
    for (int j = 0; j < 8; ++j) {
        const int fi = 8 * (ci & 3) + j;
        const float cs = tab[fi], sn = tab[64 + fi];
        x0[j] = first ? (x0[j] * cs - oth[j] * sn) : (x0[j] * cs + oth[j] * sn);
    }
#pragma unroll
    for (int j = 0; j < 8; ++j) { x0[j] *= oscale; x1[j] *= oscale; x2[j] *= oscale; }
    *(u32x4*)(d + 8 * ci) = pack8(x0); *(u32x4*)(d + 64 + 8 * ci) = pack8(x1); *(u32x4*)(d + 128 + 8 * ci) = pack8(x2);
}
__device__ __forceinline__ void rope_table(LAS float* tab, float pos, int lane) {
    int rot = 64, fi = lane - 24;
    if (lane < 8) { rot = 16; fi = lane; } else if (lane < 24) { rot = 32; fi = lane - 8; }
    if (fi > 31) fi = 31;
    float sn, cs; sincosf(pos * inv_freq(fi, rot), &sn, &cs);
    tab[lane] = cs; tab[64 + lane] = sn;
    LDS_WAIT(); asm volatile("" ::: "memory");
}

__device__ __forceinline__ int pi32(int r) { return (r & ~12) | ((r & 4) << 1) | ((r & 8) >> 1); }
template <int DQK>
__device__ __forceinline__ void attn_unit(LAS unsigned char* lds, const bf16_t* Q, int ldq, const bf16_t* K, int ldk, const bf16_t* VT, int qb,
                                          float* of32, int ldo32, bf16_t* obf, int ldo, int wv) {
    constexpr int KS = DQK * 2 + 16, VS = 144, KBYTES = 64 * KS, BUF = KBYTES + 128 * VS, NDS = DQK / 16, CPR = DQK / 8, NKC = 64 * CPR / 512;
    const int tid = tid_of(wv);
    const int lane = tid & 63, w = wv, qi = lane & 31, hh = lane >> 5;
    const int q0 = qb * 256 + w * 32, NT = 4 * qb + 4, ntw = (q0 + 31) / 64 + 1;
    bf16x8 qf[NDS];
#pragma unroll
    for (int ds = 0; ds < NDS; ++ds) qf[ds] = *(const bf16x8*)(Q + (size_t)(q0 + qi) * ldq + 16 * ds + 8 * hh);
    f32x16 o[4];
#pragma unroll
    for (int d = 0; d < 4; ++d)
#pragma unroll
        for (int r = 0; r < 16; ++r) o[d][r] = 0.f;
    float mrun = -INFINITY, lsum = 0.f;
    u32x4 kst[NKC], vst[2];
    int krow[NKC], kcc[NKC];
#pragma unroll
    for (int i = 0; i < NKC; ++i) { const int id = tid + 512 * i; krow[i] = id / CPR; kcc[i] = id % CPR; }
    const int vd0 = tid >> 3, vcc = tid & 7;
#define ATT_LOAD(kt) do { _Pragma("unroll") for (int i = 0; i < NKC; ++i) kst[i] = *(const u32x4*)(K + (size_t)(64 * (kt) + krow[i]) * ldk + 8 * kcc[i]); \
        _Pragma("unroll") for (int i = 0; i < 2; ++i) vst[i] = *(const u32x4*)(VT + (size_t)(vd0 + 64 * i) * SEQ + 64 * (kt) + 8 * vcc); } while (0)
#define ATT_WRITE(b) do { LAS unsigned char* base = lds + (b) * BUF; \
        _Pragma("unroll") for (int i = 0; i < NKC; ++i) *(LAS u32x4*)(base + krow[i] * KS + 16 * kcc[i]) = kst[i]; \
        _Pragma("unroll") for (int i = 0; i < 2; ++i) *(LAS u32x4*)(base + KBYTES + (vd0 + 64 * i) * VS + 16 * vcc) = vst[i]; } while (0)
    ATT_LOAD(0); ATT_WRITE(0);
    __syncthreads();
    const int kro = pi32(qi) * KS + 16 * hh;
    const int vro = KBYTES + qi * VS + 16 * hh;
    for (int kt = 0; kt < NT; ++kt) {
        const bool more = (kt + 1 < NT);
        if (more) ATT_LOAD(kt + 1);
        if (kt < ntw) {
            const LAS unsigned char* base = lds + (kt & 1) * BUF;
#pragma unroll
            for (int kb = 0; kb < 2; ++kb) {
                f32x16 s;
#pragma unroll
                for (int r = 0; r < 16; ++r) s[r] = 0.f;
#pragma unroll
                for (int ds = 0; ds < NDS; ++ds) {
                    const bf16x8 kf = *(const LAS bf16x8*)(base + kro + kb * 32 * KS + ds * 32);
                    s = __builtin_amdgcn_mfma_f32_32x32x16_bf16(kf, qf[ds], s, 0, 0, 0);
                }
                const int kbase = 64 * kt + 32 * kb;
                if (kbase + 31 > q0) {
                    const int qq = q0 + qi;
#pragma unroll
                    for (int r = 0; r < 16; ++r) { const int key = kbase + (r & 7) + 8 * hh + 16 * (r >> 3); if (key > qq) s[r] = -INFINITY; }
                }
                float mx = s[0];
#pragma unroll
                for (int r = 1; r < 16; ++r) mx = fmaxf(mx, s[r]);
                mx = xhalf_max(mx);
                if (__builtin_amdgcn_ballot_w64(mx > mrun + 8.f) != 0ull) {
                    const float mnew = fmaxf(mrun, mx);
                    const float alpha = fexp2(mrun - mnew);
                    mrun = mnew;
                    lsum *= alpha;
#pragma unroll
                    for (int d = 0; d < 4; ++d)
#pragma unroll
                        for (int r = 0; r < 16; ++r) o[d][r] *= alpha;
                }
                float ps = 0.f;
#pragma unroll
                for (int r = 0; r < 16; ++r) { s[r] = fexp2(s[r] - mrun); ps += s[r]; }
                lsum += ps;
                __builtin_amdgcn_iglp_opt(0);
                bf16x8 pf[2];
#pragma unroll
                for (int s2 = 0; s2 < 2; ++s2) {
                    u32x4 pw; pw.x = cvt_pk_bf16(s[8 * s2 + 0], s[8 * s2 + 1]); pw.y = cvt_pk_bf16(s[8 * s2 + 2], s[8 * s2 + 3]);
                    pw.z = cvt_pk_bf16(s[8 * s2 + 4], s[8 * s2 + 5]); pw.w = cvt_pk_bf16(s[8 * s2 + 6], s[8 * s2 + 7]);
                    pf[s2] = __builtin_bit_cast(bf16x8, pw);
                }
#pragma unroll
                for (int d = 0; d < 4; ++d)
#pragma unroll
                    for (int s2 = 0; s2 < 2; ++s2) {
                        const bf16x8 vf = *(const LAS bf16x8*)(base + vro + d * 32 * VS + (32 * kb + 16 * s2) * 2);
                        o[d] = __builtin_amdgcn_mfma_f32_32x32x16_bf16(vf, pf[s2], o[d], 0, 0, 0);
                    }
            }
        }
        if (more) ATT_WRITE((kt + 1) & 1);
        __syncthreads();
    }
#undef ATT_LOAD
#undef ATT_WRITE
    const float l = xhalf_sum(lsum);
    const float inv = 1.f / l;
    const size_t row = (size_t)(q0 + qi);
#pragma unroll
    for (int d = 0; d < 4; ++d)
#pragma unroll
        for (int g = 0; g < 4; ++g) {
            const int dim = 32 * d + 8 * g + 4 * hh;
            const float v0 = o[d][4 * g] * inv, v1 = o[d][4 * g + 1] * inv, v2 = o[d][4 * g + 2] * inv, v3 = o[d][4 * g + 3] * inv;
            if (of32) *(f32x4*)(of32 + row * ldo32 + dim) = (f32x4){v0, v1, v2, v3};
            else { u32x2 wv; wv.x = cvt_pk_bf16(v0, v1); wv.y = cvt_pk_bf16(v2, v3); *(u32x2*)(obf + row * ldo + dim) = wv; }
        }
}

__device__ __forceinline__ unsigned fkey(float f) { const unsigned u = __builtin_bit_cast(unsigned, f); return (u & 0x80000000u) ? ~u : (u | 0x80000000u); }
template <int NR>
__device__ __forceinline__ void topk_select(const float* sc, int t, LAS unsigned short* sel, int lane) {
    unsigned key[NR];
    const float* scl = sc + lane;
#pragma unroll
    for (int i = 0; i < NR; ++i) { const int e = 64 * i + lane; const unsigned kv = fkey(scl[64 * i]); key[i] = kv & (unsigned)((e - t - 1) >> 31); }
    unsigned thr = 0u;
    for (int b = 31; b >= 0; --b) {
        const unsigned cand = thr | (1u << b);
        int c = 0;
#pragma unroll
        for (int i = 0; i < NR; ++i) c += __popcll(__ballot(key[i] >= cand));
        if (c >= 256) thr = cand;
        if (c == 256) break;
    }
    int cgt = 0;
    unsigned thr1 = thr + 1u; asm volatile("" : "+v"(thr1));
#pragma unroll
    for (int i = 0; i < NR; ++i) cgt += __popcll(__ballot(key[i] >= thr1));
    const int need = 256 - cgt;
    int base = 0, eqbase = 0;
#pragma unroll
    for (int i = 0; i < NR; ++i) {
        const bool gt = key[i] > thr, eq = key[i] == thr;
        const unsigned long long em = __ballot(eq);
        const int erank = eqbase + (int)__builtin_amdgcn_mbcnt_hi((unsigned)(em >> 32), __builtin_amdgcn_mbcnt_lo((unsigned)em, 0u));
        const bool take = gt || (eq && erank < need);
        const unsigned long long tm = __ballot(take);
        const int pos = base + (int)__builtin_amdgcn_mbcnt_hi((unsigned)(tm >> 32), __builtin_amdgcn_mbcnt_lo((unsigned)tm, 0u));
        if (take) sel[pos & 255] = (unsigned short)(64 * i + lane);
        base += __popcll(tm); eqbase += __popcll(em);
        __builtin_amdgcn_sched_barrier(0);
    }
}

__device__ __forceinline__ unsigned lo16(unsigned x) { return __builtin_amdgcn_ubfe(x, 0u, 16u); }
__device__ __forceinline__ int row_sum16(int x) {
    x += __builtin_amdgcn_update_dpp(0, x, 0xB1, 0xf, 0xf, false);
    x += __builtin_amdgcn_update_dpp(0, x, 0x4E, 0xf, 0xf, false);
    x += __builtin_amdgcn_update_dpp(0, x, 0x141, 0xf, 0xf, false);
    x += __builtin_amdgcn_update_dpp(0, x, 0x140, 0xf, 0xf, false);
    return x;
}
__device__ __forceinline__ int wave_total(int x) {
    x = row_sum16(x);
    return __builtin_amdgcn_readlane(x, 0) + __builtin_amdgcn_readlane(x, 16) + __builtin_amdgcn_readlane(x, 32) + __builtin_amdgcn_readlane(x, 48);
}
__device__ __forceinline__ unsigned pk_cnt(unsigned acc, unsigned R, unsigned C, unsigned ONE) {
    unsigned d, f;
    asm("v_pk_sub_u16 %0, %1, %2 clamp" : "=v"(d) : "v"(R), "s"(C));
    asm("v_pk_min_u16 %0, %1, %2" : "=v"(f) : "v"(d), "s"(ONE));
    asm("v_pk_add_u16 %0, %0, %1" : "+v"(acc) : "v"(f));
    return acc;
}
template <int NR2>
__device__ __forceinline__ void topk_select16(const unsigned* sc16, const float* sc32, int t, LAS unsigned short* sel, LAS unsigned short* bl, int lane) {
    unsigned R[NR2];
    const unsigned* p16 = sc16 + lane;
#pragma unroll
    for (int i = 0; i < NR2; ++i) {
        const int e0 = 128 * i + 2 * lane;
        const unsigned m = lo16((unsigned)((e0 - t - 1) >> 31)) | ((unsigned)((e0 - t) >> 31) << 16);
        R[i] = __builtin_nontemporal_load(p16 + 64 * i) & m;
    }
    const unsigned ONE = 0x00010001u;
    unsigned thr = 0u;
#pragma unroll 1
    for (int b = 15; b >= 0; --b) {
        const unsigned cand = thr | (1u << b), cm1 = cand - 1u, C = cm1 | (cm1 << 16);
        unsigned acc = 0u;
#pragma unroll
        for (int i = 0; i < NR2; ++i) acc = pk_cnt(acc, R[i], C, ONE);
        const int c = wave_total((int)(lo16(acc) + (acc >> 16)));
        if (c >= 256) thr = cand;
        if (c == 256) break;
    }
    unsigned ag = 0u, ae = 0u;
    {
        const unsigned Cg = thr | (thr << 16), tm1 = thr - 1u, Ce = tm1 | (tm1 << 16);
#pragma unroll
        for (int i = 0; i < NR2; ++i) { ag = pk_cnt(ag, R[i], Cg, ONE); ae = pk_cnt(ae, R[i], Ce, ONE); }
    }
    const int cg_l = (int)(lo16(ag) + (ag >> 16)), ce_l = (int)(lo16(ae) + (ae >> 16)) - cg_l;
    int sc = cg_l | (ce_l << 16);
    const int mine = sc;
    sc += __builtin_amdgcn_update_dpp(0, sc, 0x111, 0xf, 0xf, false);
    sc += __builtin_amdgcn_update_dpp(0, sc, 0x112, 0xf, 0xf, false);
    sc += __builtin_amdgcn_update_dpp(0, sc, 0x114, 0xf, 0xf, false);
    sc += __builtin_amdgcn_update_dpp(0, sc, 0x118, 0xf, 0xf, false);
    const int r0 = __builtin_amdgcn_readlane(sc, 15), r1 = __builtin_amdgcn_readlane(sc, 31), r2 = __builtin_amdgcn_readlane(sc, 47), r3 = __builtin_amdgcn_readlane(sc, 63);
    const int rowi = lane >> 4;
    sc += (rowi > 0 ? r0 : 0) + (rowi > 1 ? r1 : 0) + (rowi > 2 ? r2 : 0);
    const int tot = r0 + r1 + r2 + r3;
    const int cgt = (int)lo16((unsigned)tot), meq = tot >> 16, need = 256 - cgt;
    sc -= mine;
    int og = (int)lo16((unsigned)sc), oe = sc >> 16;
#pragma unroll
    for (int i = 0; i < NR2; ++i) {
        const int e0 = 128 * i + 2 * lane;
        const unsigned lo = lo16(R[i]), hi = R[i] >> 16;
        if (lo > thr) { sel[og & 255] = (unsigned short)e0; ++og; }
        else if (lo == thr) { if (oe < 256) bl[oe] = (unsigned short)e0; ++oe; }
        if (hi > thr) { sel[og & 255] = (unsigned short)(e0 + 1); ++og; }
        else if (hi == thr) { if (oe < 256) bl[oe] = (unsigned short)(e0 + 1); ++oe; }
    }
    LDS_WAIT(); asm volatile("" ::: "memory");
    const int mc = meq < 256 ? meq : 256;
    unsigned v[4]; int vi[4];
#pragma unroll
    for (int r = 0; r < 4; ++r) {
        const int ci = lane + 64 * r;
        const int idx = (int)bl[ci < mc ? ci : mc - 1];
        const unsigned k32 = fkey(sc32[idx]);
        vi[r] = idx;
        v[r] = (ci < mc) ? (((lo16(k32) << 13) | (unsigned)(8191 - idx)) + 1u) : 0u;
    }
    unsigned tv = 1u;
    if (mc != need) {
        tv = 0u;
#pragma unroll 1
        for (int b = 29; b >= 0; --b) {
            const unsigned cand = tv | (1u << b);
            int c = 0;
#pragma unroll
            for (int r = 0; r < 4; ++r) c += __popcll(__ballot(v[r] >= cand));
            if (c >= need) tv = cand;
            if (c == need) break;
        }
    }
    int base = cgt;
#pragma unroll
    for (int r = 0; r < 4; ++r) {
        const bool take = v[r] >= tv;
        const unsigned long long tm = __ballot(take);
        const int pos = base + (int)__builtin_amdgcn_mbcnt_hi((unsigned)(tm >> 32), __builtin_amdgcn_mbcnt_lo((unsigned)tm, 0u));
        if (take) sel[pos & 255] = (unsigned short)vi[r];
        base += __popcll(tm);
    }
}

template <int MODE>
__device__ __forceinline__ void dsa_item(LAS unsigned char* lds, const bf16_t* P, const bf16_t* IKC, float* scr, unsigned short* scr16, bf16_t* AOb, int t0, int wv) {
    const int tid = tid_of(wv);
    const int lane = tid & 63, w = wv; (void)tid;
    const bool need_sel = (t0 >= 256);
    if (need_sel && (MODE & 1)) {
        const int g = w & 3, c = lane & 31, hh = lane >> 5;
        const int nkb = (t0 + 16 + 31) / 32;
        const int qiA = 2 * ((c >> 2) & 1) + (c >> 4), hdA = 4 * ((c >> 3) & 1) + (c & 3);
        bf16x8 af[4];
#pragma unroll
        for (int ds = 0; ds < 4; ++ds) af[ds] = *(const bf16x8*)(P + (size_t)(t0 + 4 * g + qiA) * NIN + C_IQ + hdA * 64 + 16 * ds + 8 * hh);
        float wq[2][8];
#pragma unroll
        for (int qq = 0; qq < 2; ++qq) {
            float tmp[8]; unpack8(*(const u32x4*)(P + (size_t)(t0 + 4 * g + 2 * hh + qq) * NIN + C_IW), tmp);
#pragma unroll
            for (int h = 0; h < 8; ++h) wq[qq][h] = tmp[h] * 0.044194173824159216f;
        }
        const bf16_t* ikp = IKC + (size_t)lane * 8;
        bf16x8 bc[4], bn[4], bm[4];
        const int kbw = (w >> 2);
        {
            const int kb1 = min(kbw + 2, nkb - 1);
#pragma unroll
            for (int ds = 0; ds < 4; ++ds) { bc[ds] = *(const bf16x8*)(ikp + (size_t)kbw * 2048 + 512 * ds); bn[ds] = *(const bf16x8*)(ikp + (size_t)kb1 * 2048 + 512 * ds); }
        }
#pragma unroll 1
        for (int kc = kbw; kc < nkb; kc += 16) {
            float ra[8][2];
#pragma unroll
            for (int i = 0; i < 8; ++i) {
                const int kn = min(kc + 2 * i + 4, nkb - 1);
#pragma unroll
                for (int ds = 0; ds < 4; ++ds) bm[ds] = *(const bf16x8*)(ikp + (size_t)kn * 2048 + 512 * ds);
                f32x16 s;
#pragma unroll
                for (int r = 0; r < 16; ++r) s[r] = 0.f;
#pragma unroll
                for (int ds = 0; ds < 4; ++ds) s = __builtin_amdgcn_mfma_f32_32x32x16_bf16(af[ds], bc[ds], s, 0, 0, 0);
#pragma unroll
                for (int qq = 0; qq < 2; ++qq) {
                    float a = 0.f;
#pragma unroll
                    for (int h = 0; h < 8; ++h) a += wq[qq][h] * fmaxf(s[8 * qq + h], 0.f);
                    ra[i][qq] = a;
                }
#pragma unroll
                for (int ds = 0; ds < 4; ++ds) { bc[ds] = bn[ds]; bn[ds] = bm[ds]; }
            }
#pragma unroll
            for (int i = 0; i < 8; ++i) {
                const int kb = kc + 2 * i;
                if (kb < nkb) {
#pragma unroll
                    for (int qq = 0; qq < 2; ++qq) {
                        const size_t o = (size_t)(4 * g + 2 * hh + qq) * SEQ + 32 * kb + c;
                        __builtin_nontemporal_store(ra[i][qq], scr + o);
                        scr16[o] = (unsigned short)(fkey(ra[i][qq]) >> 16);
                    }
                }
            }
        }
    }
    __syncthreads();
    LAS unsigned char* wl = lds + w * 8192;
    LAS float* pl = (LAS float*)wl;
    LAS unsigned short* sel = (LAS unsigned short*)(wl + 4096);
    LAS unsigned short* bl = (LAS unsigned short*)(wl + 4096 + 512);
    typedef float f32x4_t __attribute__((ext_vector_type(4)));
    const int n16 = lane & 15, g4 = lane >> 4;
#pragma unroll 1
    for (int qq = 0; qq < 2; ++qq) {
        const int ql = 2 * w + qq, t = t0 + ql;
        int nsel;
        if (need_sel && (MODE & 2)) {
            const float* sc = scr + (size_t)ql * SEQ;
            const unsigned* sc16 = (const unsigned*)(scr16 + (size_t)ql * SEQ);
            const int nr2 = (t >> 7) + 1;
            if (nr2 <= 16) topk_select16<16>(sc16, sc, t, sel, bl, lane);
            else if (nr2 <= 32) topk_select16<32>(sc16, sc, t, sel, bl, lane);
            else if (nr2 <= 48) topk_select16<48>(sc16, sc, t, sel, bl, lane);
            else topk_select16<64>(sc16, sc, t, sel, bl, lane);
            nsel = 256;
        } else {
            nsel = t + 1;
#pragma unroll
            for (int i = 0; i < 4; ++i) sel[lane + 64 * i] = (unsigned short)(lane + 64 * i);
        }
        if (!(MODE & 4)) { if (lane == 0) AOb[(size_t)t * DM] = sel[17]; continue; }
        LDS_WAIT(); asm volatile("" ::: "memory");
        bf16x8 qa[4];
#pragma unroll
        for (int ks = 0; ks < 4; ++ks) qa[ks] = *(const bf16x8*)(P + (size_t)t * NIN + C_BQ + (n16 & 3) * 128 + 32 * ks + 8 * g4);
        float sl[4][4];
#pragma unroll
        for (int i = 0; i < 4; ++i)
#pragma unroll
            for (int h = 0; h < 4; ++h) sl[i][h] = 0.f;
#pragma unroll
        for (int kb = 0; kb < 16; ++kb) {
            const int idx = (int)sel[16 * kb + n16];
            const bf16_t* kr = P + (size_t)idx * NIN + C_BK + 8 * g4;
            bf16x8 kf[4];
#pragma unroll
            for (int ks = 0; ks < 4; ++ks) kf[ks] = *(const bf16x8*)(kr + 32 * ks);
            f32x4 acc = (f32x4){0.f, 0.f, 0.f, 0.f};
#pragma unroll
            for (int ks = 0; ks < 4; ++ks) acc = __builtin_amdgcn_mfma_f32_16x16x32_bf16(qa[ks], kf[ks], acc, 0, 0, 0);
            const bool mine = (g4 == (kb & 3));
#pragma unroll
            for (int h = 0; h < 4; ++h) sl[kb >> 2][h] = mine ? acc[h] : sl[kb >> 2][h];
            if ((kb & 3) == 3) __builtin_amdgcn_sched_barrier(0);
        }
        float linv[4];
#pragma unroll
        for (int i = 0; i < 4; ++i) {
            const bool val = (16 * (4 * i + g4) + n16) < nsel;
#pragma unroll
            for (int h = 0; h < 4; ++h) sl[i][h] = val ? sl[i][h] : -INFINITY;
        }
#pragma unroll
        for (int h = 0; h < 4; ++h) {
            float mx = fmaxf(fmaxf(sl[0][h], sl[1][h]), fmaxf(sl[2][h], sl[3][h]));
            mx = wave_max_dpp(mx);
            float ps = 0.f;
#pragma unroll
            for (int i = 0; i < 4; ++i) { sl[i][h] = fexp2(sl[i][h] - mx); ps += sl[i][h]; }
            ps = wave_sum_dpp(ps);
            linv[h] = 1.f / ps;
        }
#pragma unroll
        for (int i = 0; i < 4; ++i) *(LAS f32x4*)(pl + 4 * (16 * (4 * i + g4) + n16)) = (f32x4){sl[i][0], sl[i][1], sl[i][2], sl[i][3]};
        LDS_WAIT(); asm volatile("" ::: "memory");
        typedef float f32x2_t __attribute__((ext_vector_type(2)));
        f32x2_t oacc[4][4];
#pragma unroll
        for (int h = 0; h < 4; ++h)
#pragma unroll
            for (int d = 0; d < 4; ++d) oacc[h][d] = (f32x2_t){0.f, 0.f};
        const bf16_t* vb = P + C_BV + 8 * n16;
        const int nj = (nsel + 15) & ~15;
        u32x4 vw[4], vn[4];
#pragma unroll
        for (int u = 0; u < 4; ++u) vw[u] = *(const u32x4*)(vb + (size_t)((int)sel[4 * u + g4]) * NIN);
#pragma unroll 1
        for (int j0 = 0; j0 < nj; j0 += 16) {
            const int jn = (j0 + 16 < nj) ? j0 + 16 : j0;
#pragma unroll
            for (int u = 0; u < 4; ++u) vn[u] = *(const u32x4*)(vb + (size_t)((int)sel[jn + 4 * u + g4]) * NIN);
#pragma unroll
            for (int u = 0; u < 4; ++u) {
                const f32x4 pq = *(const LAS f32x4*)(pl + 4 * (j0 + 4 * u + g4));
                float vx[8]; unpack8(vw[u], vx);
#pragma unroll
                for (int h = 0; h < 4; ++h)
#pragma unroll
                    for (int d = 0; d < 4; ++d) oacc[h][d] += (f32x2_t){vx[2 * d], vx[2 * d + 1]} * pq[h];
            }
#pragma unroll
            for (int u = 0; u < 4; ++u) vw[u] = vn[u];
        }
#pragma unroll
        for (int h = 0; h < 4; ++h) {
            float r[8];
#pragma unroll
            for (int d = 0; d < 4; ++d) {
                float a0 = oacc[h][d].x, a1 = oacc[h][d].y;
                a0 += swz_xor<16>(a0); a1 += swz_xor<16>(a1);
                a0 = xhalf_sum(a0); a1 = xhalf_sum(a1);
                r[2 * d] = a0 * linv[h]; r[2 * d + 1] = a1 * linv[h];
            }
            if (g4 == 0) {
                u32x4 w; w.x = cvt_pk_bf16(r[0], r[1]); w.y = cvt_pk_bf16(r[2], r[3]); w.z = cvt_pk_bf16(r[4], r[5]); w.w = cvt_pk_bf16(r[6], r[7]);
                *(u32x4*)(AOb + (size_t)t * DM + h * 128 + 8 * n16) = w;
            }
        }
        LDS_WAIT(); asm volatile("" ::: "memory");
    }
    __syncthreads();
}

struct Args { const float* in[19]; float* out; unsigned char* ws; };
constexpr int TAB_OFF = MISC_OFF + 256;
__device__ __forceinline__ unsigned long long tabp_(LAS unsigned char* lds, int i) {
    volatile LAS unsigned* p = (volatile LAS unsigned*)(lds + TAB_OFF + 8 * i);
    const unsigned lo = __builtin_amdgcn_readfirstlane(p[0]), hi = __builtin_amdgcn_readfirstlane(p[1]);
    return ((unsigned long long)hi << 32) | lo;
}
#define tabp(i) tabp_(lds, (i))
#define INP(i) ((const float*)(const GAS float*)tabp(i))
#define WSP(T, off) ((T*)(GAS T*)(tabp(20) + (off)))
#define GRID_BAR() do { XcdBarrier b_; b_.bar = WSP(unsigned, WS_CTL) + CW_BAR; b_.x = xb_xcc_id(); b_.st = (volatile LAS unsigned*)(lds + MISC_OFF) + 8; xcd_barrier(b_, wv); } while (0)

#define PHASE_VARS const int tid = tid_of(wv); const int lane = tid & 63, wave = wv; \
    int bx = blockIdx.x; asm volatile("" : "+s"(bx)); const int GW = bx * 8 + wave, NGW = (int)gridDim.x * 8; LAS float* wscr = (LAS float*)(lds + wave * 8448); \
    (void)lane; (void)GW; (void)NGW; (void)wscr; (void)tid;
#define DENSE_ORDER 0
__device__ __forceinline__ unsigned dense_order(int i) {
    static constexpr unsigned char tab[64] = {31, 30, 29, 28, 27, 26, 25, 24, 23, 22, 21, 20, 19, 159, 18, 158, 17, 157, 156, 16, 155, 154, 15, 153, 14, 152, 151, 13, 150, 149, 12, 148, 11, 147, 146, 10, 145, 144, 9, 143, 8, 142, 141, 7, 140, 139, 6, 138, 5, 137, 136, 4, 135, 134, 3, 133, 2, 132, 131, 1, 130, 129, 0, 128};
    return tab[i];
}
template <int L> __device__ __forceinline__ void layer_fwd(LAS unsigned char* lds, const int wv) {

        {
            PHASE_VARS
            constexpr int I_IN = 32 * 352, I_KVB = 8 * 64, I_BR = 32 * 64, I_OUT = 32 * 64, I_GU = 32 * 352, I_DN = 88 * 64;
            constexpr int NITEMS = I_IN + I_KVB + I_BR + I_OUT + I_GU + I_DN;
#pragma unroll 1
            for (int it = GW; it < NITEMS; it += NGW) {
                int r = it;
                if (r < I_IN) { tr_item(INP(2) + (size_t)L * DM * INW, INW, DM, WSP(bf16_t, WS_WIN), 1, INP(1) + (size_t)L * DM, wscr, r, 352, lane); continue; } r -= I_IN;
                if (r < I_KVB) { tr_item(INP(12) + (size_t)L * 512 * 2048, 2048, 512, WSP(bf16_t, WS_WKVB), 0, nullptr, wscr, r, 64, lane); continue; } r -= I_KVB;
                if (r < I_BR) { tr_item(INP(14) + (size_t)L * DM * DM, DM, DM, WSP(bf16_t, WS_WBR), 0, nullptr, wscr, r, 64, lane); continue; } r -= I_BR;
                if (r < I_OUT) { tr_item(INP(15) + (size_t)L * DM * DM, DM, DM, WSP(bf16_t, WS_WOUT), 0, nullptr, wscr, r, 64, lane); continue; } r -= I_OUT;
                if (r < I_GU) { tr_item(INP(17) + (size_t)L * DM * 2 * DFF, 2 * DFF, DM, WSP(bf16_t, WS_WGU), 2, INP(16) + (size_t)L * DM, wscr, r, 352, lane); continue; } r -= I_GU;
                tr_item(INP(18) + (size_t)L * DFF * DM, DM, DFF, WSP(bf16_t, WS_WDN), 0, nullptr, wscr, r, 64, lane);
            }
            if (L == 0) {
                const float* x_in = INP(0); bf16_t* XB = WSP(bf16_t, WS_XB); float* ssq_attn = WSP(float, WS_CTL) + CW_SSQ;
#pragma unroll 1
                for (int t = GW; t < SEQ; t += NGW) {
                    const float* xr = x_in + (size_t)t * DM; float ss = 0.f;
#pragma unroll
                    for (int j = 0; j < 4; ++j) {
                        const int e = 8 * (lane + 64 * j);
                        const f32x4 a = *(const f32x4*)(xr + e), b = *(const f32x4*)(xr + e + 4);
                        ss += a[0] * a[0] + a[1] * a[1] + a[2] * a[2] + a[3] * a[3] + b[0] * b[0] + b[1] * b[1] + b[2] * b[2] + b[3] * b[3];
                        u32x4 wv; wv.x = pk2(a[0], a[1]); wv.y = pk2(a[2], a[3]); wv.z = pk2(b[0], b[1]); wv.w = pk2(b[2], b[3]);
                        *(u32x4*)(XB + (size_t)t * DM + e) = wv;
                    }
                    ss = wave_sum(ss);
                    if (lane == 0) ssq_attn[t] = ss;
                }
            }
        }
        if (L == 0) { asm volatile("s_waitcnt vmcnt(0)" ::: "memory"); __threadfence(); cg::this_grid().sync(); } else GRID_BAR();

        {
            pg8::Gemm g{WSP(bf16_t, WS_XB), WSP(bf16_t, WS_WIN), SEQ, NIN, DM, DM, DM}; pg8::StaticOrder S; { int bx_ = blockIdx.x; asm volatile("" : "+s"(bx_)); S.init(SEQ, NIN, gridDim.x, bx_); }
            pg8::Epi E{}; E.mode = pg8::EPI_INPROJ; E.obf = WSP(bf16_t, WS_P); E.ldo = NIN; E.f1 = WSP(float, WS_CTL) + CW_SSQ + (2 * L) * SEQ;
            pg8::gemm_phase(lds, g, S, E, wv);
        }
        GRID_BAR();

#ifdef PROBE_P1
        {
            pg8::Gemm g{WSP(bf16_t, WS_XB), WSP(bf16_t, WS_WIN), SEQ, NIN, DM, DM, DM}; pg8::StaticOrder S; { int bx_ = blockIdx.x; asm volatile("" : "+s"(bx_)); S.init(SEQ, NIN, gridDim.x, bx_); }
            pg8::Epi E{}; E.mode = pg8::EPI_INPROJ; E.obf = WSP(bf16_t, WS_P); E.ldo = NIN; E.f1 = WSP(float, WS_CTL) + CW_SSQ + (2 * L) * SEQ;
            pg8::gemm_phase(lds, g, S, E, wv);
        }
        GRID_BAR();

#endif
        {
            PHASE_VARS
            bf16_t* P = WSP(bf16_t, WS_P);
#pragma unroll 1
            for (int t = GW; t < SEQ; t += NGW) {
                bf16_t* pr = P + (size_t)t * NIN;
                LAS float* tab = wscr;
                bf16_t* hb = pr + C_CQ + (lane >> 3) * 192; const int c8 = lane & 7;
                const u32x4 l_aq = *(const u32x4*)(pr + C_AQ + 8 * lane), l_ak = *(const u32x4*)(pr + C_AK + 8 * lane), l_bq = *(const u32x4*)(pr + C_BQ + 8 * lane);
                const u32x4 l_bk = *(const u32x4*)(pr + C_BK + 8 * (lane & 15)), l_iq = *(const u32x4*)(pr + C_IQ + 8 * lane), l_ik = *(const u32x4*)(pr + C_IK + 8 * c8);
                const u32x4 l_kv = *(const u32x4*)(pr + C_CKV + 8 * lane);
                const u32x4 l_c0 = *(const u32x4*)(hb + 8 * c8), l_c1 = *(const u32x4*)(hb + 64 + 8 * c8), l_c2 = *(const u32x4*)(hb + 128 + 8 * c8);
                rope_table(tab, (float)t, lane);
                pp_chunk<64, 16, true>(l_aq, pr + C_AQ + 8 * lane, lane & 7, true, INP(3) + L * 64, tab, 0.125f * LOG2E);
                pp_chunk<64, 16, true>(l_ak, pr + C_AK + 8 * lane, lane & 7, true, INP(4) + L * 64, tab, 1.f);
                pp_chunk<128, 32, true>(l_bq, pr + C_BQ + 8 * lane, lane & 15, true, INP(7) + L * 128, tab + 8, 0.08838834764831845f * LOG2E);
                pp_chunk<128, 32, true>(l_bk, pr + C_BK + 8 * (lane & 15), lane & 15, lane < 16, INP(8) + L * 128, tab + 8, 1.f);
                pp_chunk<64, 16, false>(l_iq, pr + C_IQ + 8 * lane, lane & 7, true, nullptr, tab, 1.f);
                pp_chunk<64, 16, true>(l_ik, WSP(bf16_t, WS_IKC) + ((size_t)(((t >> 5) * 4 + (c8 >> 1)) * 64 + (c8 & 1) * 32 + (t & 31))) * 8, c8, lane < 8, INP(9) + L * 64, tab, 1.f);
                pp_chunk<512, 0, true>(l_kv, pr + C_CKV + 8 * lane, lane, true, INP(11) + L * 512, tab, 1.f);
                pp_head192(l_c0, l_c1, l_c2, hb, c8, INP(10) + L * 192, tab + 24, 0.07216878364870323f * LOG2E);
                LDS_WAIT(); asm volatile("" ::: "memory");
            }
            bf16_t* VTA = WSP(bf16_t, WS_VTA);
#pragma unroll 1
            for (int it = GW; it < 128 * 8; it += NGW) {
                const int tb = it >> 3, cb = it & 7;
                trb_item(P + (size_t)(64 * tb) * NIN + C_AV + 64 * cb, NIN, VTA + (size_t)(64 * cb) * SEQ + 64 * tb, SEQ, (LAS unsigned short*)wscr, lane);
            }
        }
        GRID_BAR();

        {
            pg8::Gemm g{WSP(bf16_t, WS_P) + C_CKV, WSP(bf16_t, WS_WKVB), SEQ, 2048, 512, NIN, 512}; pg8::StaticOrder S; { int bx_ = blockIdx.x; asm volatile("" : "+s"(bx_)); S.init(SEQ, 2048, gridDim.x, bx_); }
            pg8::Epi E{}; E.mode = pg8::EPI_PLAIN; E.obf = WSP(bf16_t, WS_KVB); E.ldo = 2048;
            pg8::gemm_phase(lds, g, S, E, wv);
        }
        GRID_BAR();

        {
            PHASE_VARS
            const bf16_t* P = WSP(bf16_t, WS_P); const bf16_t* KVB = WSP(bf16_t, WS_KVB); bf16_t* KC = WSP(bf16_t, WS_KC); bf16_t* VTC = WSP(bf16_t, WS_VTC);
            const float* c_k_norm = INP(13) + L * 192;
#pragma unroll 1
            for (int t = GW; t < SEQ; t += NGW) {
                const int h = lane >> 3, ci = lane & 7;
                const bf16_t* kv = KVB + (size_t)t * 2048 + h * 256;
                const u32x4 a0 = *(const u32x4*)(P + (size_t)t * NIN + C_CKR + 8 * ci), a1 = *(const u32x4*)(kv + 8 * ci), a2 = *(const u32x4*)(kv + 64 + 8 * ci);
                LAS float* tab = wscr;
                rope_table(tab, (float)t, lane);
                pp_head192(a0, a1, a2, KC + (size_t)t * 1536 + h * 192, ci, c_k_norm, tab + 24, 1.f);
                LDS_WAIT(); asm volatile("" ::: "memory");
            }
#pragma unroll 1
            for (int it = GW; it < 128 * 16; it += NGW) {
                const int tb = it >> 4, cb = it & 15, h = cb >> 1, d0 = (cb & 1) * 64;
                trb_item(KVB + (size_t)(64 * tb) * 2048 + h * 256 + 128 + d0, 2048, VTC + (size_t)(h * 128 + d0) * SEQ + 64 * tb, SEQ, (LAS unsigned short*)wscr, lane);
            }
        }
        GRID_BAR();

#define RUN_P5(QSLOT, ITEM_LO, ITEM_HI, DSAMODE) { \
            const int xq = (int)(xb_xcc_id() & 7u);       \
            int dx = ((ITEM_LO) == 0) ? 0 : 8;             \
            _Pragma("unroll 1") for (;;) { \
                PHASE_VARS \
                volatile LAS unsigned* MISC = (volatile LAS unsigned*)(lds + MISC_OFF); \
                int item = -1, dj = 0, dqb = 0; \
                while (dx < 8) { \
                    const int xs = (xq + dx) & 7; \
                    __syncthreads(); \
                    if (tid == 0) MISC[16] = atomicAdd(WSP(unsigned, WS_CTL) + CW_Q + 64 * (16 + 8 * (QSLOT) + xs), 1u); \
                    __syncthreads(); \
                    const int di = (int)__builtin_amdgcn_readfirstlane(MISC[16]); \
                    if (di < 64) { const unsigned e = dense_order(di); dj = (e >> 7) ? 8 + xs : xs; dqb = (int)(e & 31u); item = 0; break; } \
                    ++dx; \
                } \
                if (item < 0) { \
                    __syncthreads(); \
                    if (tid == 0) MISC[16] = atomicAdd(WSP(unsigned, WS_CTL) + CW_Q + 64 * (QSLOT), 1u); \
                    __syncthreads(); \
                    item = 512 + (int)__builtin_amdgcn_readfirstlane(MISC[16]); \
                    if (item >= (ITEM_HI)) break; \
                } \
                bf16_t* P = WSP(bf16_t, WS_P); bf16_t* AO = WSP(bf16_t, WS_AO); \
                if (item < 512) { \
                    const int qb = dqb, j = dj; \
                    if (j < 8) attn_unit<192>(lds, P + C_CQ + j * 192, NIN, WSP(bf16_t, WS_KC) + j * 192, 1536, WSP(bf16_t, WS_VTC) + (size_t)j * 128 * SEQ, qb, nullptr, 0, AO + 1024 + j * 128, DM, wv); \
                    else { const int hm = j - 8; attn_unit<64>(lds, P + C_AQ + hm * 64, NIN, P + C_AK + hm * 64, NIN, WSP(bf16_t, WS_VTA) + (size_t)(hm >> 1) * 128 * SEQ, qb, WSP(float, WS_OA32) + hm * 128, 1024, nullptr, 0, wv); } \
                } else { \
                    const int t0 = (511 - (item - 512)) * 16; \
                    dsa_item<DSAMODE>(lds, P, WSP(bf16_t, WS_IKC), WSP(float, WS_SCR) + (size_t)bx * 16 * SEQ, WSP(unsigned short, WS_SCR16) + (size_t)bx * 16 * SEQ, (DSAMODE == 15 ? AO + 512 : WSP(bf16_t, WS_OA32)), t0, wv); \
                } \
            } \
        }
        RUN_P5(L, 0, 1024, 15)
#ifdef PROBE_DENSE
        GRID_BAR();
        RUN_P5(L + 2, 0, 512, 15)
#endif
#ifdef PROBE_P5
        GRID_BAR();
        RUN_P5(L + 6, 0, 1024, 15)
#endif
#ifdef PROBE_DSA
        GRID_BAR();
        RUN_P5(L + 4, 512, 1024, PROBE_DSA)
#endif
        GRID_BAR();

        {
            PHASE_VARS
            const float lam_init = (L == 0) ? 0.2f : (0.8f - 0.6f * 0.7408182206817179f);
            const float* a_lambda = INP(5) + L * 256; const float* a_sub_norm = INP(6) + L * 128;
            const float* OA32 = WSP(float, WS_OA32); bf16_t* AO = WSP(bf16_t, WS_AO);
            float lam;
            { const float a = a_lambda[lane] * a_lambda[64 + lane], b = a_lambda[128 + lane] * a_lambda[192 + lane];
              lam = expf(wave_sum(a)) - expf(wave_sum(b)) + lam_init; }
            const float g0 = a_sub_norm[2 * lane], g1 = a_sub_norm[2 * lane + 1];
#pragma unroll 1
            for (int t = GW; t < SEQ; t += NGW) {
                float a1[4][2], a2[4][2];
#pragma unroll
                for (int h = 0; h < 4; ++h) {
                    const float* o1 = OA32 + (size_t)t * 1024 + (2 * h) * 128 + 2 * lane;
                    a1[h][0] = o1[0]; a1[h][1] = o1[1]; a2[h][0] = o1[128]; a2[h][1] = o1[129];
                }
#pragma unroll
                for (int h = 0; h < 4; ++h) {
                    const float d0 = a1[h][0] - lam * a2[h][0], d1 = a1[h][1] - lam * a2[h][1];
                    const float ss = wave_sum(d0 * d0 + d1 * d1);
                    const float r = (1.0f / sqrtf(ss * (1.f / 128.f) + NORM_EPS)) * (1.f - lam_init);
                    *(unsigned*)(AO + (size_t)t * DM + h * 128 + 2 * lane) = pk2(d0 * r * g0, d1 * r * g1);
                }
            }
        }
        GRID_BAR();

#pragma unroll 1
        for (int br = 0; br < 3; ++br) {
            pg8::StaticOrder S; { int bx_ = blockIdx.x; asm volatile("" : "+s"(bx_)); S.init(SEQ, DM, gridDim.x, bx_); }
            const int ko = (br == 2) ? 1024 : 512 * br;
            pg8::Gemm g{WSP(bf16_t, WS_AO) + ko, WSP(bf16_t, WS_WBR) + ko, SEQ, DM, (br == 2) ? 1024 : 512, DM, DM};
            pg8::Epi E{}; E.mode = pg8::EPI_BR0 + br; E.gate = WSP(bf16_t, WS_P) + C_G + br * DM; E.ldg = NIN; E.f0 = WSP(float, WS_SCR); E.obf = WSP(bf16_t, WS_MG); E.ldo = DM;
            pg8::gemm_phase(lds, g, S, E, wv);
        }
        GRID_BAR();

        {
            pg8::Gemm g{WSP(bf16_t, WS_MG), WSP(bf16_t, WS_WOUT), SEQ, DM, DM, DM, DM}; pg8::StaticOrder S; { int bx_ = blockIdx.x; asm volatile("" : "+s"(bx_)); S.init(SEQ, DM, gridDim.x, bx_); }
            pg8::Epi E{}; E.mode = pg8::EPI_RESID; E.f1 = (L == 0) ? INP(0) : (const float*)(const GAS float*)tabp(19); E.f0 = (float*)(GAS float*)tabp(19); E.obf = WSP(bf16_t, WS_XB); E.ldo = DM;
            E.f2 = WSP(float, WS_CTL) + CW_SSQ + (2 * L + 1) * SEQ;
            pg8::gemm_phase(lds, g, S, E, wv);
        }
        GRID_BAR();

        {
            pg8::Gemm g{WSP(bf16_t, WS_XB), WSP(bf16_t, WS_WGU), SEQ, NGU, DM, DM, DM}; pg8::StaticOrder S; { int bx_ = blockIdx.x; asm volatile("" : "+s"(bx_)); S.init(SEQ, NGU, gridDim.x, bx_); }
            pg8::Epi E{}; E.mode = pg8::EPI_SWIGLU; E.obf = WSP(bf16_t, WS_P); E.ldo = DFF; E.f1 = WSP(float, WS_CTL) + CW_SSQ + (2 * L + 1) * SEQ;
            pg8::gemm_phase(lds, g, S, E, wv);
        }
        GRID_BAR();

#ifdef PROBE_P9
        {
            pg8::Gemm g{WSP(bf16_t, WS_XB), WSP(bf16_t, WS_WGU), SEQ, NGU, DM, DM, DM}; pg8::StaticOrder S; { int bx_ = blockIdx.x; asm volatile("" : "+s"(bx_)); S.init(SEQ, NGU, gridDim.x, bx_); }
            pg8::Epi E{}; E.mode = pg8::EPI_SWIGLU; E.obf = WSP(bf16_t, WS_P); E.ldo = DFF; E.f1 = WSP(float, WS_CTL) + CW_SSQ + (2 * L + 1) * SEQ;
            pg8::gemm_phase(lds, g, S, E, wv);
        }
        GRID_BAR();

#endif
        {
            pg8::Gemm g{WSP(bf16_t, WS_P), WSP(bf16_t, WS_WDN), SEQ, DM, DFF, DFF, DFF}; pg8::StaticOrder S; { int bx_ = blockIdx.x; asm volatile("" : "+s"(bx_)); S.init(SEQ, DM, gridDim.x, bx_); }
            pg8::Epi E{}; E.mode = pg8::EPI_RESID; E.f1 = (const float*)(const GAS float*)tabp(19); E.f0 = (float*)(GAS float*)tabp(19); E.obf = WSP(bf16_t, WS_XB); E.ldo = DM;
            E.f2 = WSP(float, WS_CTL) + CW_SSQ + (2 * L + 2) * SEQ;
            pg8::gemm_phase(lds, g, S, E, wv);
        }
        GRID_BAR();

}

__global__ void __launch_bounds__(512) fwd_kernel(Args args) {
    extern __shared__ __attribute__((aligned(16))) unsigned char lds_raw[];
    LAS unsigned char* lds = (LAS unsigned char*)lds_raw;
    const int wv = __builtin_amdgcn_readfirstlane((int)(threadIdx.x >> 6));
    {
        const int tid = tid_of(wv);
        volatile LAS unsigned* MISC = (volatile LAS unsigned*)(lds + MISC_OFF);
        for (int u = tid; u < 64; u += 512) MISC[u] = 0u;
        if (tid < 21) {
            const unsigned long long v = (tid < 19) ? (unsigned long long)args.in[tid] : (tid == 19 ? (unsigned long long)args.out : (unsigned long long)args.ws);
            volatile LAS unsigned* p = (volatile LAS unsigned*)(lds + TAB_OFF + 8 * tid);
            p[0] = (unsigned)v; p[1] = (unsigned)(v >> 32);
        }
        __syncthreads();
        (void)xcd_barrier_post(WSP(unsigned, WS_CTL) + CW_BAR, MISC + 8);
    }

    layer_fwd<0>(lds, wv);
    layer_fwd<1>(lds, wv);
}

extern "C" void kernel_launch(void* const* d_in, const int* in_sizes, int n_in, void* d_out, int out_size, void* d_ws, size_t ws_size, hipStream_t stream) {
    static int grid = 0;
    if (grid == 0) {
        if (n_in != 19 || ws_size < WS_END) { fprintf(stderr, "kernel_launch: unexpected inputs (n_in %d, ws %zu, need %zu)\n", n_in, ws_size, (size_t)WS_END); grid = -1; return; }
        int dev = 0, cus = 0, per_cu = 0;
        hipGetDevice(&dev);
        hipDeviceGetAttribute(&cus, hipDeviceAttributeMultiprocessorCount, dev);
        hipFuncSetAttribute((const void*)fwd_kernel, hipFuncAttributeMaxDynamicSharedMemorySize, LDS_BYTES);
        hipOccupancyMaxActiveBlocksPerMultiprocessor(&per_cu, (const void*)fwd_kernel, 512, LDS_BYTES);
        (void)hipGetLastError();
        if (per_cu < 1) per_cu = 1;
        grid = cus;
        if (grid > 256) grid = 256;
    }
    if (grid < 0) return;
    hipMemsetAsync((char*)d_ws + WS_CTL, 0, CTL_BYTES, stream);
    Args a{};
    for (int i = 0; i < 19; ++i) a.in[i] = (const float*)d_in[i];
    a.out = (float*)d_out; a.ws = (unsigned char*)d_ws;
    void* kargs[] = {&a};
    hipError_t e = hipLaunchCooperativeKernel((const void*)fwd_kernel, dim3(grid), dim3(512), kargs, LDS_BYTES, stream);
    if (e != hipSuccess) fprintf(stderr, "cooperative launch failed: %s (grid %d)\n", hipGetErrorString(e), grid);
}
```
